# Optimizing an MI355X kernel written in HIP

```python
import jax, jax.numpy as jnp
from jax import lax
import numpy as np

D_MODEL = 1024
BATCH = 2
SEQ = 16384
DEPTH = 1
DEC_BATCH = 1
DEC_SEQ = 16384
PAST_LEN = 128

MIX_WIDTH = D_MODEL
HEAD_DIM = 64
ATTN_WIDTH = MIX_WIDTH // 2
N_HEADS = ATTN_WIDTH // HEAD_DIM
N_KV_HEADS = N_HEADS // 4
GQA_GROUP = N_HEADS // N_KV_HEADS
KV_WIDTH = N_KV_HEADS * HEAD_DIM
FOURIER_WIDTH = MIX_WIDTH - ATTN_WIDTH
FOURIER_GROUP_DIM = 64
N_FOURIER_GROUPS = FOURIER_WIDTH // FOURIER_GROUP_DIM
IN_WIDTH = ATTN_WIDTH + 2 * KV_WIDTH + FOURIER_WIDTH
WINDOW = 128
BLOCK = 128
ROPE_THETA = 500000.0
ROT_DIM = HEAD_DIM // 4
D_FF = 2816
CONV_WIDTH = 3
PLE_DIM = 256
EPS = 1e-6

kernel_name = "hymba_swa_fnet_convffn_encoder"


def rmsnorm(x, g):
    xf = x.astype(jnp.float32)
    y = xf * lax.rsqrt(jnp.mean(xf * xf, axis=-1, keepdims=True) + EPS) * g.astype(jnp.float32)
    return y.astype(x.dtype)


def partial_rope(x):
    S = x.shape[1]
    half = ROT_DIM // 2
    inv_freq = ROPE_THETA ** (-jnp.arange(0, ROT_DIM, 2, dtype=jnp.float32) / ROT_DIM)
    ang = jnp.arange(S, dtype=jnp.float32)[:, None] * inv_freq[None, :]
    cos = jnp.cos(ang)[None, :, None, :]
    sin = jnp.sin(ang)[None, :, None, :]
    xr = x[..., :ROT_DIM].astype(jnp.float32)
    x1, x2 = xr[..., :half], xr[..., half:]
    rot = jnp.concatenate([x1 * cos - x2 * sin, x2 * cos + x1 * sin], axis=-1)
    return jnp.concatenate([rot.astype(x.dtype), x[..., ROT_DIM:]], axis=-1)


def window_attention(q, k, v, sink):
    B, S = q.shape[0], q.shape[1]
    nb = S // BLOCK
    qb = q.reshape(B, nb, BLOCK, N_KV_HEADS, GQA_GROUP, HEAD_DIM)
    pad = ((0, 0), (BLOCK, BLOCK), (0, 0), (0, 0))

    def neighbours(t):
        tp = jnp.pad(t, pad).reshape(B, nb + 2, BLOCK, N_KV_HEADS, HEAD_DIM)
        return jnp.concatenate([tp[:, :-2], tp[:, 1:-1], tp[:, 2:]], axis=2)

    kw = neighbours(k)
    vw = neighbours(v)
    scale = HEAD_DIM ** -0.5
    s = jnp.einsum('bnqhgd,bnkhd->bnhgqk', qb, kw, preferred_element_type=jnp.float32) * scale
    blk = jnp.arange(nb)[:, None, None]
    qpos = blk * BLOCK + jnp.arange(BLOCK)[None, :, None]
    kpos = (blk - 1) * BLOCK + jnp.arange(3 * BLOCK)[None, None, :]
    mask = (jnp.abs(qpos - kpos) <= WINDOW) & (kpos >= 0) & (kpos < S)
    s = jnp.where(mask[None, :, None, None], s, -jnp.inf)
    sk = sink.astype(jnp.float32).reshape(1, 1, N_KV_HEADS, GQA_GROUP, 1, 1)
    m = jnp.maximum(jnp.max(s, axis=-1, keepdims=True), sk)
    p = jnp.exp(s - m)
    denom = jnp.sum(p, axis=-1, keepdims=True) + jnp.exp(sk - m)
    p = (p / denom).astype(v.dtype)
    o = jnp.einsum('bnhgqk,bnkhd->bnqhgd', p, vw, preferred_element_type=jnp.float32)
    return o.astype(q.dtype).reshape(B, S, ATTN_WIDTH)


def fourier_mix(u, w_fourier):
    B, S = u.shape[0], u.shape[1]
    ug = u.reshape(B, S, N_FOURIER_GROUPS, FOURIER_GROUP_DIM).astype(jnp.float32)
    f = jnp.fft.fftn(ug, axes=(1, 3), norm='ortho').real.astype(u.dtype)
    y = jnp.einsum('bsgc,gce->bsge', f, w_fourier)
    return y.reshape(B, S, FOURIER_WIDTH)


def encoder_layer(x, p, attn_norm, w_in, q_norm, k_norm, sink, w_fourier, attn_out_norm,
                  fourier_out_norm, w_out, ffn_norm, w_up, conv_w, conv_b, w_down,
                  w_ple, ple_norm, w_ple_gate, b_ple_gate):
    B, S, _ = x.shape
    h = rmsnorm(x, attn_norm)
    z = h @ w_in
    q, k, v, u = jnp.split(z, [ATTN_WIDTH, ATTN_WIDTH + KV_WIDTH, ATTN_WIDTH + 2 * KV_WIDTH], axis=-1)
    q = partial_rope(rmsnorm(q.reshape(B, S, N_HEADS, HEAD_DIM), q_norm))
    k = partial_rope(rmsnorm(k.reshape(B, S, N_KV_HEADS, HEAD_DIM), k_norm))
    v = v.reshape(B, S, N_KV_HEADS, HEAD_DIM)
    a = window_attention(q, k, v, sink)
    f = fourier_mix(u, w_fourier)
    mixed = jnp.concatenate([rmsnorm(a, attn_out_norm), rmsnorm(f, fourier_out_norm)], axis=-1)
    x = x + mixed @ w_out
    h = rmsnorm(x, ffn_norm)
    hu = h @ w_up
    hp = jnp.pad(hu, ((0, 0), (1, 1), (0, 0)))
    hc = hp[:, :-2] * conv_w[0] + hp[:, 1:-1] * conv_w[1] + hp[:, 2:] * conv_w[2] + conv_b
    g, up = jnp.split(hc, 2, axis=-1)
    x = x + (jax.nn.silu(g) * up) @ w_down
    e = rmsnorm(p @ w_ple, ple_norm)
    gate = jax.nn.sigmoid(x @ w_ple_gate + b_ple_gate)
    return x + gate * e


def setup_inputs(seed: int = 0) -> dict:
    key = jax.random.key(seed)
    ks = jax.random.split(key, 24)
    f32 = jnp.float32

    def nrm(k, shape, scale):
        return jax.random.normal(k, shape, f32) * scale

    def gain(k, shape):
        return 1.0 + 0.02 * jax.random.normal(k, shape, f32)

    return {
        "x_prompt": nrm(ks[0], (BATCH, SEQ, D_MODEL), 1.0),
        "x_sample": nrm(ks[1], (DEC_BATCH, DEC_SEQ, D_MODEL), 1.0),
        "p_prompt": nrm(ks[2], (DEPTH, BATCH, SEQ, PLE_DIM), 1.0),
        "p_sample": nrm(ks[3], (DEPTH, DEC_BATCH, DEC_SEQ, PLE_DIM), 1.0),
        "attn_norm": gain(ks[4], (DEPTH, D_MODEL)),
        "w_in": nrm(ks[5], (DEPTH, D_MODEL, IN_WIDTH), D_MODEL ** -0.5),
        "q_norm": gain(ks[6], (DEPTH, HEAD_DIM)),
        "k_norm": gain(ks[7], (DEPTH, HEAD_DIM)),
        "sink": nrm(ks[8], (DEPTH, N_HEADS), 1.0),
        "w_fourier": nrm(ks[9], (DEPTH, N_FOURIER_GROUPS, FOURIER_GROUP_DIM, FOURIER_GROUP_DIM), FOURIER_GROUP_DIM ** -0.5),
        "attn_out_norm": gain(ks[10], (DEPTH, ATTN_WIDTH)),
        "fourier_out_norm": gain(ks[11], (DEPTH, FOURIER_WIDTH)),
        "w_out": nrm(ks[12], (DEPTH, MIX_WIDTH, D_MODEL), MIX_WIDTH ** -0.5),
        "ffn_norm": gain(ks[13], (DEPTH, D_MODEL)),
        "w_up": nrm(ks[14], (DEPTH, D_MODEL, 2 * D_FF), D_MODEL ** -0.5),
        "conv_w": nrm(ks[15], (DEPTH, CONV_WIDTH, 2 * D_FF), CONV_WIDTH ** -0.5),
        "conv_b": nrm(ks[16], (DEPTH, 2 * D_FF), 0.01),
        "w_down": nrm(ks[17], (DEPTH, D_FF, D_MODEL), D_FF ** -0.5),
        "w_ple": nrm(ks[18], (DEPTH, PLE_DIM, D_MODEL), PLE_DIM ** -0.5),
        "ple_norm": gain(ks[19], (DEPTH, D_MODEL)),
        "w_ple_gate": nrm(ks[20], (DEPTH, D_MODEL, D_MODEL), D_MODEL ** -0.5),
        "b_ple_gate": nrm(ks[21], (DEPTH, D_MODEL), 0.01),
    }


def reference(x_prompt, x_sample, p_prompt, p_sample, attn_norm, w_in, q_norm, k_norm, sink,
              w_fourier, attn_out_norm, fourier_out_norm, w_out, ffn_norm, w_up, conv_w, conv_b,
              w_down, w_ple, ple_norm, w_ple_gate, b_ple_gate):
    y_prompt = x_prompt
    y_sample = x_sample
    for i in range(DEPTH):
        params = (attn_norm[i], w_in[i], q_norm[i], k_norm[i], sink[i], w_fourier[i],
                  attn_out_norm[i], fourier_out_norm[i], w_out[i], ffn_norm[i], w_up[i],
                  conv_w[i], conv_b[i], w_down[i], w_ple[i], ple_norm[i], w_ple_gate[i],
                  b_ple_gate[i])
        y_prompt = encoder_layer(y_prompt, p_prompt[i], *params)
        y_sample = encoder_layer(y_sample, p_sample[i], *params)
    return (y_prompt, y_sample)
```

```cpp
#include <hip/hip_runtime.h>
#include <cstdint>
#include <cstdio>

constexpr int D = 1024, SEQ = 16384, NSEQ = 3, T = NSEQ * SEQ, INW = 1280, DFF = 2816, PLE = 256;
constexpr float EPS = 1e-6f;
constexpr size_t MiB = 1u << 20;

__device__ __forceinline__ float wave_sum(float v) {
#pragma unroll
    for (int o = 1; o < 64; o <<= 1) v += __shfl_xor(v, o);
    return v;
}
__device__ __forceinline__ float wave_max(float v) {
#pragma unroll
    for (int o = 1; o < 64; o <<= 1) v = fmaxf(v, __shfl_xor(v, o));
    return v;
}

__global__ void __launch_bounds__(256) k_rmsnorm(const float* in, int ldi, const float* g, float* out, int ldo, int rows, int n) {
    const int row = blockIdx.x * 4 + (threadIdx.x >> 6), lane = threadIdx.x & 63;
    if (row >= rows) return;
    const float* ip = in + (size_t)row * ldi; float* op = out + (size_t)row * ldo;
    float s = 0.f;
    for (int c = lane; c < n; c += 64) { const float v = ip[c]; s += v * v; }
    s = wave_sum(s);
    const float r = 1.0f / sqrtf(s / (float)n + EPS);
    for (int c = lane; c < n; c += 64) op[c] = ip[c] * r * g[c];
}

__global__ void __launch_bounds__(256) k_sgemm(const float* __restrict__ A, int lda, long a_row0, long vlo, long vhi,
                                               const float* __restrict__ B, int ldb, const float* R, int ldr, float* C, int ldc, int M, int N, int K) {
    __shared__ float As[16][68];
    __shared__ float Bs[16][68];
    const int tx = threadIdx.x & 15, ty = threadIdx.x >> 4;
    const int m0 = blockIdx.y * 64, n0 = blockIdx.x * 64;
    float acc[4][4];
#pragma unroll
    for (int i = 0; i < 4; ++i)
#pragma unroll
        for (int j = 0; j < 4; ++j) acc[i][j] = 0.f;
    const int ar = threadIdx.x >> 2, ak = (threadIdx.x & 3) * 4;
    const long ga = a_row0 + m0 + ar;
    const bool aval = (m0 + ar < M) && ga >= vlo && ga < vhi;
    const int bk = threadIdx.x >> 4, bn = (threadIdx.x & 15) * 4;
    for (int k0 = 0; k0 < K; k0 += 16) {
        float4 av = make_float4(0.f, 0.f, 0.f, 0.f);
        if (aval) av = *(const float4*)(A + ga * lda + k0 + ak);
        As[ak][ar] = av.x; As[ak + 1][ar] = av.y; As[ak + 2][ar] = av.z; As[ak + 3][ar] = av.w;
        *(float4*)&Bs[bk][bn] = *(const float4*)(B + (size_t)(k0 + bk) * ldb + n0 + bn);
        __syncthreads();
#pragma unroll
        for (int kk = 0; kk < 16; ++kk) {
            const float4 a = *(const float4*)&As[kk][ty * 4];
            const float4 b = *(const float4*)&Bs[kk][tx * 4];
            const float aa[4] = {a.x, a.y, a.z, a.w}, bb[4] = {b.x, b.y, b.z, b.w};
#pragma unroll
            for (int i = 0; i < 4; ++i)
#pragma unroll
                for (int j = 0; j < 4; ++j) acc[i][j] += aa[i] * bb[j];
        }
        __syncthreads();
    }
#pragma unroll
    for (int i = 0; i < 4; ++i) {
        const int m = m0 + ty * 4 + i;
        if (m < M) {
            float4 o = make_float4(acc[i][0], acc[i][1], acc[i][2], acc[i][3]);
            if (R) { const float4 r = *(const float4*)(R + (size_t)m * ldr + n0 + tx * 4); o.x += r.x; o.y += r.y; o.z += r.z; o.w += r.w; }
            *(float4*)(C + (size_t)m * ldc + n0 + tx * 4) = o;
        }
    }
}

__constant__ float c_invf[8] = {1.0f, 0.19392274474868576f, 0.03760603093086393f, 0.007292664737217109f, 0.001414213562373095f, 0.0002742481756762073f, 5.318295896944988e-05f, 1.031338537721246e-05f};

__global__ void __launch_bounds__(256) k_qknorm_rope(float* z, const float* qg, const float* kg) {
    const int w = blockIdx.x * 4 + (threadIdx.x >> 6), lane = threadIdx.x & 63;
    const int token = w / 10, head = w % 10;
    if (token >= T) return;
    float* p = z + (size_t)token * INW + head * 64;
    const float v = p[lane];
    const float ss = wave_sum(v * v);
    const float g = head < 8 ? qg[lane] : kg[lane];
    float y = v * (1.0f / sqrtf(ss * (1.0f / 64.0f) + EPS)) * g;
    const int partner = lane < 8 ? lane + 8 : (lane < 16 ? lane - 8 : lane);
    const float y2 = __shfl(y, partner);
    if (lane < 16) {
        const int pos = token % SEQ;
        const float ang = (float)pos * c_invf[lane & 7];
        const double a = (double)ang;
        const double rr = a - 6.283185307179586476925 * rint(a * 0.15915494309189533577);
        float sn, cs; sincospif((float)(rr * 0.31830988618379067154), &sn, &cs);
        y = lane < 8 ? (y * cs - y2 * sn) : (y * cs + y2 * sn);
    }
    p[lane] = y;
}

__global__ void __launch_bounds__(256) k_attn(float* z, const float* sink) {
    const int w = blockIdx.x * 4 + (threadIdx.x >> 6), lane = threadIdx.x & 63;
    const int token = w >> 3, head = w & 7;
    if (token >= T) return;
    const int seq = token / SEQ, pos = token % SEQ, kvh = head >> 2;
    const float qv = z[(size_t)token * INW + head * 64 + lane] * 0.125f;
    const int jlo = pos - 128 < 0 ? 0 : pos - 128, jhi = pos + 128 > SEQ - 1 ? SEQ - 1 : pos + 128;
    const float* kb = z + (size_t)seq * SEQ * INW + 512 + kvh * 64 + lane;
    const float* vb = kb + 128;
    float sc[5];
#pragma unroll
    for (int c = 0; c < 5; ++c) {
        sc[c] = -INFINITY;
        for (int jj = 0; jj < 64; ++jj) {
            const int j = jlo + c * 64 + jj;
            if (j > jhi) break;
            const float s = wave_sum(qv * kb[(size_t)j * INW]);
            if (jj == lane) sc[c] = s;
        }
    }
    const float sk = sink[head];
    float m = sk;
#pragma unroll
    for (int c = 0; c < 5; ++c) m = fmaxf(m, sc[c]);
    m = wave_max(m);
    float psum = 0.f;
#pragma unroll
    for (int c = 0; c < 5; ++c) { sc[c] = expf(sc[c] - m); psum += sc[c]; }
    psum = wave_sum(psum) + expf(sk - m);
    float o = 0.f;
#pragma unroll
    for (int c = 0; c < 5; ++c) {
        for (int jj = 0; jj < 64; ++jj) {
            const int j = jlo + c * 64 + jj;
            if (j > jhi) break;
            o += __shfl(sc[c], jj) * vb[(size_t)j * INW];
        }
    }
    z[(size_t)token * INW + head * 64 + lane] = o / psum;
}

__global__ void __launch_bounds__(256) k_cdft(const float* z, float2* U1, int b) {
    __shared__ float tc[64], ts[64];
    if (threadIdx.x < 64) { float s, c; sincospif(2.0f * (float)threadIdx.x / 64.0f, &s, &c); tc[threadIdx.x] = c; ts[threadIdx.x] = s; }
    __syncthreads();
    const int idx = blockIdx.x * 256 + threadIdx.x;
    const int n = idx >> 9, ch = idx & 511, g = ch >> 6, e = ch & 63;
    const float* u = z + ((size_t)b * SEQ + n) * INW + 768 + g * 64;
    float re = 0.f, im = 0.f;
    for (int c = 0; c < 64; ++c) { const int k = (c * e) & 63; const float v = u[c]; re += v * tc[k]; im -= v * ts[k]; }
    U1[idx] = make_float2(re, im);
}
__global__ void __launch_bounds__(256) k_s1(const float2* U1, float2* Y) {
    __shared__ float tc[128], ts[128];
    if (threadIdx.x < 128) { float s, c; sincospif(2.0f * (float)threadIdx.x / 128.0f, &s, &c); tc[threadIdx.x] = c; ts[threadIdx.x] = s; }
    __syncthreads();
    const int idx = blockIdx.x * 256 + threadIdx.x;
    const int ch = idx & 511, n2 = (idx >> 9) & 127, k1 = idx >> 16;
    float re = 0.f, im = 0.f;
    for (int n1 = 0; n1 < 128; ++n1) {
        const int k = (k1 * n1) & 127; const float c = tc[k], s = ts[k];
        const float2 x = U1[(size_t)(128 * n1 + n2) * 512 + ch];
        re += x.x * c + x.y * s; im += x.y * c - x.x * s;
    }
    float s, c; sincospif(2.0f * (float)(k1 * n2) / 16384.0f, &s, &c);
    Y[idx] = make_float2(re * c + im * s, im * c - re * s);
}
__global__ void __launch_bounds__(256) k_s2(const float2* Y, float* FR) {
    __shared__ float tc[128], ts[128];
    if (threadIdx.x < 128) { float s, c; sincospif(2.0f * (float)threadIdx.x / 128.0f, &s, &c); tc[threadIdx.x] = c; ts[threadIdx.x] = s; }
    __syncthreads();
    const int idx = blockIdx.x * 256 + threadIdx.x;
    const int ch = idx & 511, k2 = (idx >> 9) & 127, k1 = idx >> 16;
    float re = 0.f;
    for (int n2 = 0; n2 < 128; ++n2) {
        const int k = (k2 * n2) & 127;
        const float2 y = Y[(size_t)(k1 * 128 + n2) * 512 + ch];
        re += y.x * tc[k] + y.y * ts[k];
    }
    FR[(size_t)(k1 + 128 * k2) * 512 + ch] = re * (1.0f / 1024.0f);
}
__global__ void __launch_bounds__(256) k_fmap(const float* FR, const float* Wf, float* z, int b) {
    const int idx = blockIdx.x * 256 + threadIdx.x;
    const int n = idx >> 9, ch = idx & 511, g = ch >> 6, e = ch & 63;
    const float* f = FR + (size_t)n * 512 + g * 64; const float* w = Wf + (size_t)g * 4096 + e;
    float s = 0.f;
    for (int c = 0; c < 64; ++c) s += f[c] * w[c * 64];
    z[((size_t)b * SEQ + n) * INW + 768 + ch] = s;
}

__global__ void __launch_bounds__(256) k_convact(const float* HU, const float* cw, const float* cb, float* ACT, int rows) {
    const size_t idx = (size_t)blockIdx.x * 256 + threadIdx.x;
    const int r = (int)(idx / DFF), c = (int)(idx % DFF);
    if (r >= rows) return;
    const float* h = HU + (size_t)r * (2 * DFF);
    const float g = h[c] * cw[c] + h[2 * DFF + c] * cw[2 * DFF + c] + h[4 * DFF + c] * cw[4 * DFF + c] + cb[c];
    const int c2 = DFF + c;
    const float u = h[c2] * cw[c2] + h[2 * DFF + c2] * cw[2 * DFF + c2] + h[4 * DFF + c2] * cw[4 * DFF + c2] + cb[c2];
    ACT[idx] = g / (1.0f + expf(-g)) * u;
}

__global__ void __launch_bounds__(256) k_final(float* out, const float* pe, const float* xg, const float* g, const float* bg) {
    const int row = blockIdx.x * 4 + (threadIdx.x >> 6), lane = threadIdx.x & 63;
    if (row >= T) return;
    const float* pp = pe + (size_t)row * D; const float* xp = xg + (size_t)row * D; float* op = out + (size_t)row * D;
    float s = 0.f;
    for (int c = lane; c < D; c += 64) { const float v = pp[c]; s += v * v; }
    s = wave_sum(s);
    const float r = 1.0f / sqrtf(s / (float)D + EPS);
    for (int c = lane; c < D; c += 64) {
        const float e = pp[c] * r * g[c];
        const float gate = 1.0f / (1.0f + expf(-(xp[c] + bg[c])));
        op[c] = op[c] + gate * e;
    }
}

static void sgemm(hipStream_t st, const float* A, int lda, long a_row0, long vlo, long vhi, const float* B, int ldb, const float* R, int ldr, float* C, int ldc, int M, int N, int K) {
    dim3 grid(N / 64, (M + 63) / 64);
    hipLaunchKernelGGL(k_sgemm, grid, dim3(256), 0, st, A, lda, a_row0, vlo, vhi, B, ldb, R, ldr, C, ldc, M, N, K);
}

extern "C" void kernel_launch(void* const* d_in, const int* in_sizes, int n_in, void* d_out, int out_size, void* d_ws, size_t ws_size, hipStream_t stream) {
    if (n_in != 22 || ws_size < 440 * MiB) { fprintf(stderr, "kernel_launch: unexpected inputs (%d) or workspace (%zu)\n", n_in, ws_size); return; }
    const float* xin[2] = {(const float*)d_in[0], (const float*)d_in[1]};
    const float* pin[2] = {(const float*)d_in[2], (const float*)d_in[3]};
    const float *attn_norm = (const float*)d_in[4], *w_in = (const float*)d_in[5], *q_norm = (const float*)d_in[6], *k_norm = (const float*)d_in[7], *sink = (const float*)d_in[8],
                *w_fourier = (const float*)d_in[9], *ao_norm = (const float*)d_in[10], *fo_norm = (const float*)d_in[11], *w_out = (const float*)d_in[12], *ffn_norm = (const float*)d_in[13],
                *w_up = (const float*)d_in[14], *conv_w = (const float*)d_in[15], *conv_b = (const float*)d_in[16], *w_down = (const float*)d_in[17], *w_ple = (const float*)d_in[18],
                *ple_norm = (const float*)d_in[19], *w_gate = (const float*)d_in[20], *b_gate = (const float*)d_in[21];
    float* out = (float*)d_out;
    unsigned char* ws = (unsigned char*)d_ws;
    float* R0 = (float*)ws;
    float* Z = (float*)(ws + 192 * MiB);
    const int rows_seg[2] = {2 * SEQ, SEQ}; const int row0_seg[2] = {0, 2 * SEQ};

    for (int s = 0; s < 2; ++s) hipLaunchKernelGGL(k_rmsnorm, dim3(rows_seg[s] / 4), dim3(256), 0, stream, xin[s], D, attn_norm, R0 + (size_t)row0_seg[s] * D, D, rows_seg[s], D);
    sgemm(stream, R0, D, 0, 0, T, w_in, INW, nullptr, 0, Z, INW, T, INW, D);
    hipLaunchKernelGGL(k_qknorm_rope, dim3(T * 10 / 4), dim3(256), 0, stream, Z, q_norm, k_norm);
    hipLaunchKernelGGL(k_attn, dim3(T * 8 / 4), dim3(256), 0, stream, Z, sink);
    float2* U1 = (float2*)ws; float2* Y = (float2*)(ws + 64 * MiB); float* FR = (float*)(ws + 128 * MiB);
    for (int b = 0; b < NSEQ; ++b) {
        hipLaunchKernelGGL(k_cdft, dim3(SEQ * 512 / 256), dim3(256), 0, stream, Z, U1, b);
        hipLaunchKernelGGL(k_s1, dim3(SEQ * 512 / 256), dim3(256), 0, stream, U1, Y);
        hipLaunchKernelGGL(k_s2, dim3(SEQ * 512 / 256), dim3(256), 0, stream, Y, FR);
        hipLaunchKernelGGL(k_fmap, dim3(SEQ * 512 / 256), dim3(256), 0, stream, FR, w_fourier, Z, b);
    }
    hipLaunchKernelGGL(k_rmsnorm, dim3(T / 4), dim3(256), 0, stream, Z, INW, ao_norm, R0, D, T, 512);
    hipLaunchKernelGGL(k_rmsnorm, dim3(T / 4), dim3(256), 0, stream, Z + 768, INW, fo_norm, R0 + 512, D, T, 512);
    for (int s = 0; s < 2; ++s) sgemm(stream, R0 + (size_t)row0_seg[s] * D, D, 0, 0, rows_seg[s], w_out, D, xin[s], D, out + (size_t)row0_seg[s] * D, D, rows_seg[s], D, D);
    hipLaunchKernelGGL(k_rmsnorm, dim3(T / 4), dim3(256), 0, stream, out, D, ffn_norm, R0, D, T, D);
    float* HU = Z; float* ACT = (float*)((unsigned char*)Z + 96 * MiB);
    constexpr int CH = 4096;
    for (int sq = 0; sq < NSEQ; ++sq)
        for (int c0 = 0; c0 < SEQ; c0 += CH) {
            const long g0 = (long)sq * SEQ + c0;
            sgemm(stream, R0, D, g0 - 1, (long)sq * SEQ, (long)(sq + 1) * SEQ, w_up, 2 * DFF, nullptr, 0, HU, 2 * DFF, CH + 2, 2 * DFF, D);
            hipLaunchKernelGGL(k_convact, dim3((unsigned)(((size_t)CH * DFF + 255) / 256)), dim3(256), 0, stream, HU, conv_w, conv_b, ACT, CH);
            sgemm(stream, ACT, DFF, 0, 0, CH, w_down, D, out + (size_t)g0 * D, D, out + (size_t)g0 * D, D, CH, D, DFF);
        }
    float* PE = Z;
    for (int s = 0; s < 2; ++s) sgemm(stream, pin[s], PLE, 0, 0, rows_seg[s], w_ple, D, nullptr, 0, PE + (size_t)row0_seg[s] * D, D, rows_seg[s], D, PLE);
    sgemm(stream, out, D, 0, 0, T, w_gate, D, nullptr, 0, R0, D, T, D, D);
    hipLaunchKernelGGL(k_final, dim3(T / 4), dim3(256), 0, stream, out, PE, R0, ple_norm, b_gate);
}
```

```cpp
#include <hip/hip_runtime.h>
#include <cstdio>
#include <cstdint>
#include <cmath>
namespace pg8 {
#define PG8_LAS __attribute__((address_space(3)))
typedef unsigned short bf16_t;
typedef short bf16x8 __attribute__((ext_vector_type(8)));
typedef float f32x4 __attribute__((ext_vector_type(4)));
typedef unsigned u32x4 __attribute__((ext_vector_type(4)));
typedef unsigned u32x2 __attribute__((ext_vector_type(2)));
constexpr int BM = 256, BK = 64, HALF = 128, HTB = HALF * BK * 2  , STAGE_BYTES = 8 * HTB, NXCD = 8, WGM = 8;

__host__ __device__ __forceinline__ int lds_byte(int r, int c) { const int st = (r >> 4) * 2 + (c >> 5), rr = r & 15, cc = c & 31, ob = rr * 64 + cc * 2; return st * 1024 + (ob ^ (((ob >> 9) & 1) << 5)); }
__host__ __device__ __forceinline__ void stage_rc(int b, int& R, int& C) { const int st = b / 1024, sb = b % 1024, swz = sb ^ (((sb >> 9) & 1) << 5); R = (st >> 1) * 16 + swz / 64; C = (st & 1) * 32 + (swz % 64) / 2; }
__host__ __device__ __forceinline__ int perm32(int rho) { const int n = rho >> 4, i = rho & 15; return 8 * (i >> 2) + 4 * n + (i & 3); }

struct Unit { int pm, pn; };
struct Geom { int K; unsigned rsA, rsB, hsA, hsB; };

struct TileOrder {
    int nM, nN, nwg, G, c;
    __device__ void init(int nM_, int nN_, int G_, int c_) { nM = nM_; nN = nN_; nwg = nM * nN; G = G_; c = c_; }
    __device__ bool next(int i, Unit& u) const {
        const long L = (long)i * G + c; if (L >= nwg) return false;
        int wgid = (int)L; { const int q = nwg / NXCD, r = nwg % NXCD, xcd = wgid % NXCD, off = wgid / NXCD; wgid = (xcd < r ? xcd * (q + 1) : r * (q + 1) + (xcd - r) * q) + off; }
        const int nig = WGM * nN, gid = wgid / nig, fm = gid * WGM, gsz = (nM - fm) < WGM ? (nM - fm) : WGM;
        u.pm = fm + ((wgid % nig) % gsz); u.pn = (wgid % nig) / gsz; return true;
    }
};

__device__ __forceinline__ unsigned cvt_pk_bf16(float lo, float hi) { unsigned r; asm volatile("v_cvt_pk_bf16_f32 %0, %1, %2" : "=v"(r) : "v"(lo), "v"(hi)); return r; }
__device__ __forceinline__ u32x4 pack8(const f32x4 a, const f32x4 b) { u32x4 w; w.x = cvt_pk_bf16(a[0], a[1]); w.y = cvt_pk_bf16(a[2], a[3]); w.z = cvt_pk_bf16(b[0], b[1]); w.w = cvt_pk_bf16(b[2], b[3]); return w; }
__device__ __forceinline__ u32x2 pack4(const f32x4 a) { u32x2 w; w.x = cvt_pk_bf16(a[0], a[1]); w.y = cvt_pk_bf16(a[2], a[3]); return w; }

template <class Epi, class Sched, bool ALIGN_EPI>
__device__ __forceinline__ void gemm_phase(PG8_LAS unsigned char* lds, PG8_LAS unsigned char* lds_epi, const Geom g, const Sched& S, const Epi& E) {
    const int tid = threadIdx.x, wid = __builtin_amdgcn_readfirstlane(tid >> 6), lane = tid & 63, wr = wid >> 2, wc = wid & 3, fr = lane & 15, fq = lane >> 4;
    const int K = g.K, nt = K / BK;
    unsigned voffA[2], voffB[2];
#pragma unroll
    for (int i = 0; i < 2; ++i) { int R, C; stage_rc(tid * 16 + i * 8192, R, C); const int Rb = Epi::PERM ? ((R & ~31) + perm32(R & 31)) : R;
        voffA[i] = (unsigned)R * g.rsA + (unsigned)C * 2u; voffB[i] = (unsigned)Rb * g.rsB + (unsigned)C * 2u; }
    const size_t kstep = (size_t)(BK * 2);
    const size_t hsA = g.hsA, hsB = g.hsB;
    const unsigned ldsw = (unsigned)wid * 1024u;
    const int aoff = lds_byte(wr * 64 + fr, fq * 8), boff = lds_byte(wc * 32 + fr, fq * 8);
#define PG8_SA(b, h) (((b) * 2 + (h)) * HTB)
#define PG8_SB(b, h) ((4 + (b) * 2 + (h)) * HTB)
#define PG8_STAGE(bufoff, gbase, voff) do { _Pragma("unroll") for (int _i = 0; _i < 2; ++_i) \
        __builtin_amdgcn_global_load_lds((const unsigned*)((const char*)(gbase) + (voff)[_i]), (PG8_LAS unsigned*)(lds + (bufoff) + ldsw + _i * 8192), 16, 0, 0); } while (0)
#define PG8_LDA(dst, b, h) do { _Pragma("unroll") for (int m = 0; m < 4; ++m) _Pragma("unroll") for (int k = 0; k < 2; ++k) dst[m][k] = *(const PG8_LAS bf16x8*)(lds + PG8_SA(b, h) + aoff + m * 2048 + k * 1024); } while (0)
#define PG8_LDB(dst, b, h) do { _Pragma("unroll") for (int n = 0; n < 2; ++n) _Pragma("unroll") for (int k = 0; k < 2; ++k) dst[n][k] = *(const PG8_LAS bf16x8*)(lds + PG8_SB(b, h) + boff + n * 2048 + k * 1024); } while (0)
#define PG8_MMA(ai, bj, At, Bt) do { __builtin_amdgcn_s_setprio(1); _Pragma("unroll") for (int m = 0; m < 4; ++m) _Pragma("unroll") for (int n = 0; n < 2; ++n) _Pragma("unroll") for (int k = 0; k < 2; ++k) \
        acc[ai][bj][m][n] = __builtin_amdgcn_mfma_f32_16x16x32_bf16(Bt[n][k], At[m][k], acc[ai][bj][m][n], 0, 0, 0); __builtin_amdgcn_s_setprio(0); } while (0)
#define PG8_WAIT_V(n) asm volatile("s_waitcnt vmcnt(" #n ")" ::: "memory")
#define PG8_WAIT_L(n) asm volatile("s_waitcnt lgkmcnt(" #n ")" ::: "memory")
#define PG8_BAR __builtin_amdgcn_s_barrier()
#define PG8_SCHED __builtin_amdgcn_sched_barrier(0)
    Unit cur, nxt; int ui = 0;
    if (!S.next(0, cur)) return;
    f32x4 acc[2][2][4][2];
#pragma unroll
    for (int a = 0; a < 2; ++a)
#pragma unroll
        for (int b = 0; b < 2; ++b)
#pragma unroll
            for (int m = 0; m < 4; ++m)
#pragma unroll
                for (int n = 0; n < 2; ++n) acc[a][b][m][n] = (f32x4){0.f, 0.f, 0.f, 0.f};
    bf16x8 At[4][2], B0[2][2], B1[2][2];
    const char* cA = S.a_base(cur); const char* cB = S.b_base(cur);
    PG8_STAGE(PG8_SB(0, 0), cB, voffB); PG8_STAGE(PG8_SB(0, 1), cB + hsB, voffB); PG8_STAGE(PG8_SA(0, 0), cA, voffA); PG8_STAGE(PG8_SA(0, 1), cA + hsA, voffA);
    if (wr == 1) PG8_BAR;
    PG8_WAIT_V(2); PG8_BAR;
    PG8_STAGE(PG8_SB(1, 0), cB + kstep, voffB); PG8_STAGE(PG8_SA(1, 0), cA + kstep, voffA); PG8_STAGE(PG8_SB(1, 1), cB + hsB + kstep, voffB);
    PG8_WAIT_V(6); PG8_BAR;
    for (;;) {
        const bool has_next = S.next(ui + 1, nxt);
        const char* nA = has_next ? S.a_base(nxt) : cA; const char* nB = has_next ? S.b_base(nxt) : cB;
#pragma unroll 1
        for (int t = 0; t < nt; t += 2) {
            const bool last = (t == nt - 2);
            const char* a1 = cA + (size_t)(t + 1) * kstep;
            const char* a2 = last ? nA : cA + (size_t)(t + 2) * kstep; const char* b2 = last ? nB : cB + (size_t)(t + 2) * kstep;
            const char* a3 = a2 + kstep; const char* b3 = b2 + kstep;
            if constexpr (Epi::MIDK) { if (t == Epi::MIDK_T) E.midk(acc, cur, wr, wc, fr, fq); }
            PG8_LDB(B0, 0, 0); PG8_LDB(B1, 0, 1); PG8_SCHED; PG8_LDA(At, 0, 0); PG8_STAGE(PG8_SA(1, 1), a1 + hsA, voffA);
            PG8_WAIT_V(8); PG8_WAIT_L(0); PG8_BAR; PG8_MMA(0, 0, At, B0); PG8_MMA(0, 1, At, B1); PG8_BAR; PG8_SCHED;
            PG8_LDA(At, 0, 1); PG8_STAGE(PG8_SB(0, 0), b2, voffB); PG8_STAGE(PG8_SB(0, 1), b2 + hsB, voffB); PG8_STAGE(PG8_SA(0, 0), a2, voffA);
            PG8_WAIT_V(8); PG8_WAIT_L(0); PG8_BAR; PG8_MMA(1, 0, At, B0); PG8_MMA(1, 1, At, B1); PG8_BAR; PG8_SCHED;
            PG8_LDB(B0, 1, 0); PG8_LDB(B1, 1, 1); PG8_SCHED; PG8_LDA(At, 1, 0); PG8_STAGE(PG8_SA(0, 1), a2 + hsA, voffA);
            PG8_WAIT_V(8); PG8_WAIT_L(0); PG8_BAR; PG8_MMA(0, 0, At, B0); PG8_MMA(0, 1, At, B1); PG8_BAR; PG8_SCHED;
            PG8_LDA(At, 1, 1); PG8_STAGE(PG8_SB(1, 0), b3, voffB); PG8_STAGE(PG8_SB(1, 1), b3 + hsB, voffB); PG8_STAGE(PG8_SA(1, 0), a3, voffA);
            PG8_WAIT_V(8); PG8_WAIT_L(0); PG8_BAR; PG8_MMA(1, 0, At, B0); PG8_MMA(1, 1, At, B1); PG8_BAR; PG8_SCHED;
        }
        if constexpr (ALIGN_EPI) { if (wr == 0) PG8_BAR; }
        E(acc, cur, wr, wc, fr, fq, lds_epi);
        if (!has_next) break;
#pragma unroll
        for (int a = 0; a < 2; ++a)
#pragma unroll
            for (int b = 0; b < 2; ++b)
#pragma unroll
                for (int m = 0; m < 4; ++m)
#pragma unroll
                    for (int n = 0; n < 2; ++n) acc[a][b][m][n] = (f32x4){0.f, 0.f, 0.f, 0.f};
        cur = nxt; cA = nA; cB = nB; ++ui;
        if constexpr (ALIGN_EPI) { if (wr == 1) PG8_BAR; }
    }
    PG8_WAIT_V(0);
    if constexpr (!ALIGN_EPI) { if (wr == 0) PG8_BAR; }
    PG8_BAR;
#undef PG8_SA
#undef PG8_SB
#undef PG8_STAGE
#undef PG8_LDA
#undef PG8_LDB
#undef PG8_MMA
#undef PG8_WAIT_V
#undef PG8_WAIT_L
#undef PG8_BAR
#undef PG8_SCHED
}
}
constexpr int D = 1024, SEQ = 16384, NSEQ = 3, T = NSEQ * SEQ, DFF = 2816, PLE = 256, INW = 1280;
constexpr int XPAD = 16640;
constexpr int UP_TILES = 65;
constexpr float EPS = 1e-6f;
constexpr float LOG2E = 1.4426950408889634f;
constexpr float QSCALE = 0.125f * LOG2E;

namespace pg8 {
struct SchedPlain {
    TileOrder o; const char* A; const char* B; size_t tA, tB;
    __device__ __forceinline__ bool next(int i, Unit& u) const { return o.next(i, u); }
    __device__ __forceinline__ const char* a_base(const Unit& u) const { return A + (size_t)u.pm * tA; }
    __device__ __forceinline__ const char* b_base(const Unit& u) const { return B + (size_t)u.pn * tB; }
};
struct SchedTokGather {
    TileOrder o; const char* A; const char* HB; size_t tA;
    __device__ __forceinline__ bool next(int i, Unit& u) const { return o.next(i, u); }
    __device__ __forceinline__ const char* a_base(const Unit& u) const { return A + (size_t)u.pm * tA; }
    __device__ __forceinline__ const char* b_base(const Unit& u) const { return HB + ((size_t)(u.pn >> 6) * SEQ + 2 * (u.pn & 63)) * (D * 2); }
};
struct SchedHalo {
    TileOrder o; const char* X1B; const char* B; size_t tB;
    __device__ __forceinline__ bool next(int i, Unit& u) const { return o.next(i, u); }
    __device__ __forceinline__ const char* a_base(const Unit& u) const { const int s = u.pm / UP_TILES, ti = u.pm % UP_TILES; return X1B + ((size_t)s * XPAD + 254 * ti) * (D * 2); }
    __device__ __forceinline__ const char* b_base(const Unit& u) const { return B + (size_t)u.pn * tB; }
};

typedef f32x4 AccT[2][2][4][2];
__device__ __forceinline__ float sum4sq(const f32x4 v) { return (v[0] * v[0] + v[1] * v[1]) + (v[2] * v[2] + v[3] * v[3]); }
__device__ __forceinline__ float red_fq(float s) { s += __shfl_xor(s, 16); s += __shfl_xor(s, 32); return s; }
__device__ __forceinline__ float rsq(float ss, float inv_n) { return 1.0f / sqrtf(ss * inv_n + EPS); }

struct EpiQKV {
    static constexpr bool PERM = true, MIDK = false; static constexpr int MIDK_T = 0;
    bf16_t* MIX; bf16_t* KB; bf16_t* VB; const float* qg; const float* kg; const float* ropeC; const float* ropeS;
    __device__ __forceinline__ void midk(AccT&, const Unit&, int, int, int, int) const {}
    __device__ __forceinline__ void operator()(AccT& acc, const Unit& u, int wr, int wc, int fr, int fq, PG8_LAS unsigned char*) const {
        const int hh = u.pn * 4 + wc; const bool isq = hh < 8, nrm = hh < 10;
        f32x4 gn[2][2];
#pragma unroll
        for (int bj = 0; bj < 2; ++bj)
#pragma unroll
            for (int n = 0; n < 2; ++n) { gn[bj][n] = (f32x4){1.f, 1.f, 1.f, 1.f};
                if (nrm) { gn[bj][n] = *(const f32x4*)((isq ? qg : kg) + 32 * bj + 8 * fq + 4 * n); if (isq) gn[bj][n] = gn[bj][n] * QSCALE; } }
        bf16_t* dst; int pitch;
        if (isq) { dst = MIX + hh * 64; pitch = D; } else if (nrm) { dst = KB + (hh - 8) * 64; pitch = 128; } else { dst = VB + (hh - 10) * 64; pitch = 128; }
#pragma unroll
        for (int aim = 0; aim < 4; ++aim) {
            const int ai = aim >> 1;
            f32x4 cs[4][2], sn[4][2];
            if (nrm) {
#pragma unroll
                for (int m = 2 * (aim & 1); m < 2 * (aim & 1) + 2; ++m) { const int pos = (u.pm * BM + ai * HALF + wr * 64 + m * 16 + fr) & (SEQ - 1);
                    cs[m][0] = *(const f32x4*)(ropeC + pos * 8); cs[m][1] = *(const f32x4*)(ropeC + pos * 8 + 4);
                    sn[m][0] = *(const f32x4*)(ropeS + pos * 8); sn[m][1] = *(const f32x4*)(ropeS + pos * 8 + 4); }
            }
#pragma unroll
            for (int m = 2 * (aim & 1); m < 2 * (aim & 1) + 2; ++m) {
                const int row = u.pm * BM + ai * HALF + wr * 64 + m * 16 + fr;
                f32x4 v[2][2];
#pragma unroll
                for (int bj = 0; bj < 2; ++bj)
#pragma unroll
                    for (int n = 0; n < 2; ++n) v[bj][n] = acc[ai][bj][m][n];
                if (nrm) {
                    float ss = (sum4sq(v[0][0]) + sum4sq(v[0][1])) + (sum4sq(v[1][0]) + sum4sq(v[1][1]));
                    ss = red_fq(ss);
                    const float rstd = rsq(ss, 1.0f / 64.0f);
#pragma unroll
                    for (int bj = 0; bj < 2; ++bj)
#pragma unroll
                        for (int n = 0; n < 2; ++n) v[bj][n] = v[bj][n] * rstd * gn[bj][n];
#pragma unroll
                    for (int n = 0; n < 2; ++n)
#pragma unroll
                        for (int i = 0; i < 4; ++i) {
                            const float own = v[0][n][i], oth = __shfl_xor(own, 16);
                            const float r0 = own * cs[m][n][i] - oth * sn[m][n][i], r1 = own * cs[m][n][i] + oth * sn[m][n][i];
                            v[0][n][i] = fq == 0 ? r0 : (fq == 1 ? r1 : own);
                        }
                }
#pragma unroll
                for (int bj = 0; bj < 2; ++bj) *(u32x4*)(dst + (size_t)row * pitch + 32 * bj + 8 * fq) = pack8(v[bj][0], v[bj][1]);
            }
        }
    }
};

struct EpiAB {
    static constexpr bool PERM = true, MIDK = false; static constexpr int MIDK_T = 0;
    bf16_t* W1;
    __device__ __forceinline__ void midk(AccT&, const Unit&, int, int, int, int) const {}
    __device__ __forceinline__ void operator()(AccT& acc, const Unit& u, int wr, int wc, int fr, int fq, PG8_LAS unsigned char*) const {
        const int b = u.pn >> 6, j2 = u.pn & 63;
#pragma unroll
        for (int ai = 0; ai < 2; ++ai)
#pragma unroll
            for (int m = 0; m < 4; ++m) {
                const int r = u.pm * BM + ai * HALF + wr * 64 + m * 16 + fr, part = r >> 9, e = r & 511;
#pragma unroll
                for (int bj = 0; bj < 2; ++bj) {
                    const int n2 = 2 * j2 + bj;
                    bf16_t* dst = W1 + ((((size_t)(b * 512 + e) * 128 + n2) * 2 + part) * 128 + 32 * wc + 8 * fq);
                    *(u32x4*)dst = pack8(acc[ai][bj][m][0], acc[ai][bj][m][1]);
                }
            }
    }
};

struct EpiPle {
    static constexpr bool PERM = true, MIDK = false; static constexpr int MIDK_T = 0;
    bf16_t* ER; float* ssq;
    __device__ __forceinline__ void midk(AccT&, const Unit&, int, int, int, int) const {}
    __device__ __forceinline__ void operator()(AccT& acc, const Unit& u, int wr, int wc, int fr, int fq, PG8_LAS unsigned char*) const {
#pragma unroll
        for (int ai = 0; ai < 2; ++ai)
#pragma unroll
            for (int m = 0; m < 4; ++m) {
                const int row = u.pm * BM + ai * HALF + wr * 64 + m * 16 + fr;
                float s = (sum4sq(acc[ai][0][m][0]) + sum4sq(acc[ai][0][m][1])) + (sum4sq(acc[ai][1][m][0]) + sum4sq(acc[ai][1][m][1]));
                s = red_fq(s);
                if (fq == 0) ssq[(size_t)row * 16 + u.pn * 4 + wc] = s;
#pragma unroll
                for (int bj = 0; bj < 2; ++bj) *(u32x4*)(ER + (size_t)row * D + u.pn * BM + bj * HALF + wc * 32 + fq * 8) = pack8(acc[ai][bj][m][0], acc[ai][bj][m][1]);
            }
    }
};

struct EpiS1 {
    static constexpr bool PERM = true, MIDK = false; static constexpr int MIDK_T = 0;
    bf16_t* ZB; const float* twc; const float* tws;
    __device__ __forceinline__ void midk(AccT&, const Unit&, int, int, int, int) const {}
    __device__ __forceinline__ void operator()(AccT& acc, const Unit& u, int wr, int wc, int fr, int fq, PG8_LAS unsigned char*) const {
        const int b = u.pn >> 8, e0 = 2 * (u.pn & 255);
        f32x4 c[4][2], s[4][2];
#pragma unroll
        for (int m = 0; m < 4; ++m)
#pragma unroll
            for (int n = 0; n < 2; ++n) { const int k1 = wr * 64 + m * 16 + fr; c[m][n] = *(const f32x4*)(twc + k1 * 128 + 32 * wc + 8 * fq + 4 * n); s[m][n] = *(const f32x4*)(tws + k1 * 128 + 32 * wc + 8 * fq + 4 * n); }
#pragma unroll
        for (int m = 0; m < 4; ++m) {
            const int k1 = wr * 64 + m * 16 + fr;
#pragma unroll
            for (int bj = 0; bj < 2; ++bj) {
                f32x4 zr[2], zi[2];
#pragma unroll
                for (int n = 0; n < 2; ++n) { const f32x4 yr = acc[0][bj][m][n], yi = acc[1][bj][m][n]; zr[n] = yr * c[m][n] + yi * s[m][n]; zi[n] = yi * c[m][n] - yr * s[m][n]; }
                bf16_t* dst = ZB + ((((size_t)(b * 128 + k1) * 512 + (e0 + bj)) * 2) * 128 + 32 * wc + 8 * fq);
                *(u32x4*)dst = pack8(zr[0], zr[1]); *(u32x4*)(dst + 128) = pack8(zi[0], zi[1]);
            }
        }
    }
};

struct EpiS2 {
    static constexpr bool PERM = true, MIDK = false; static constexpr int MIDK_T = 0;
    bf16_t* MIX; float* ssq;
    __device__ __forceinline__ void midk(AccT&, const Unit&, int, int, int, int) const {}
    __device__ __forceinline__ void operator()(AccT& acc, const Unit& u, int wr, int wc, int fr, int fq, PG8_LAS unsigned char*) const {
        const int eh = u.pn & 1, k1 = (u.pn >> 1) & 127, b = u.pn >> 8;
#pragma unroll
        for (int m = 0; m < 4; ++m) {
            const int k2 = wr * 64 + m * 16 + fr; const size_t tok = (size_t)b * SEQ + k1 + 128 * k2;
            float s = (sum4sq(acc[0][0][m][0]) + sum4sq(acc[0][0][m][1])) + (sum4sq(acc[0][1][m][0]) + sum4sq(acc[0][1][m][1]));
            s = red_fq(s);
            if (fq == 0) ssq[tok * 8 + eh * 4 + wc] = s;
#pragma unroll
            for (int bj = 0; bj < 2; ++bj) *(u32x4*)(MIX + tok * D + 512 + eh * 256 + bj * HALF + wc * 32 + fq * 8) = pack8(acc[0][bj][m][0], acc[0][bj][m][1]);
        }
    }
};

struct EpiOut {
    static constexpr bool PERM = false, MIDK = true; static constexpr int MIDK_T = 8;
    const float* xp; const float* xs; float* out; bf16_t* X1B; const float* ssq_a; const float* ssq_f; float* ssq_x1;
    __device__ __forceinline__ float rs8(const float* p) const { const f32x4 a = *(const f32x4*)p, b = *(const f32x4*)(p + 4); return rsq((a[0] + a[1]) + (a[2] + a[3]) + (b[0] + b[1]) + (b[2] + b[3]), 1.0f / 512.0f); }
    __device__ __forceinline__ void midk(AccT& acc, const Unit& u, int wr, int wc, int fr, int fq) const {
        asm volatile("" : "+v"(fr));
#pragma unroll
        for (int ai = 0; ai < 2; ++ai)
#pragma unroll
            for (int m = 0; m < 4; ++m) {
                const size_t row = (size_t)u.pm * BM + ai * HALF + wr * 64 + m * 16 + fr;
                const float ratio = rs8(ssq_a + row * 8) / rs8(ssq_f + row * 8);
#pragma unroll
                for (int bj = 0; bj < 2; ++bj)
#pragma unroll
                    for (int n = 0; n < 2; ++n) acc[ai][bj][m][n] = acc[ai][bj][m][n] * ratio;
                asm volatile("" ::: "memory");
            }
    }
    __device__ __forceinline__ void operator()(AccT& acc, const Unit& u, int wr, int wc, int fr, int fq, PG8_LAS unsigned char*) const {
#pragma unroll
        for (int ai = 0; ai < 2; ++ai) {
            f32x4 xr[4][2][2]; float rf[4];
#pragma unroll
            for (int m = 0; m < 4; ++m) {
                const int row = u.pm * BM + ai * HALF + wr * 64 + m * 16 + fr;
                const float* xrow = row < 2 * SEQ ? xp + (size_t)row * D : xs + (size_t)(row - 2 * SEQ) * D;
                rf[m] = rs8(ssq_f + (size_t)row * 8);
#pragma unroll
                for (int bj = 0; bj < 2; ++bj)
#pragma unroll
                    for (int n = 0; n < 2; ++n) xr[m][bj][n] = *(const f32x4*)(xrow + u.pn * BM + bj * HALF + wc * 32 + n * 16 + fq * 4);
            }
#pragma unroll
            for (int m = 0; m < 4; ++m) {
                const int row = u.pm * BM + ai * HALF + wr * 64 + m * 16 + fr;
                const size_t prow = (size_t)(row >> 14) * XPAD + 1 + (row & (SEQ - 1));
                float s = 0.f;
#pragma unroll
                for (int bj = 0; bj < 2; ++bj)
#pragma unroll
                    for (int n = 0; n < 2; ++n) {
                        const int col = u.pn * BM + bj * HALF + wc * 32 + n * 16 + fq * 4;
                        const f32x4 x1 = xr[m][bj][n] + acc[ai][bj][m][n] * rf[m];
                        *(f32x4*)(out + (size_t)row * D + col) = x1;
                        *(u32x2*)(X1B + prow * D + col) = pack4(x1);
                        s += sum4sq(x1);
                    }
                s = red_fq(s);
                if (fq == 0) ssq_x1[(size_t)row * 16 + u.pn * 4 + wc] = s;
            }
        }
    }
};


template <int CTRL, bool BC> __device__ __forceinline__ float dpp_mov(float oldv, float src) {
    return __builtin_bit_cast(float, __builtin_amdgcn_update_dpp(__builtin_bit_cast(int, oldv), __builtin_bit_cast(int, src), CTRL, 0xF, 0xF, BC));
}
struct EpiUp {
    static constexpr bool PERM = true, MIDK = false; static constexpr int MIDK_T = 0;
    const float* cw; const float* cb; const float* ssq_x1; bf16_t* ACT;
    __device__ __forceinline__ void midk(AccT&, const Unit&, int, int, int, int) const {}
    __device__ __forceinline__ void operator()(AccT& acc, const Unit& u, int wr, int wc, int fr, int fq, PG8_LAS unsigned char* lds_epi) const {
        const int sq = u.pm / UP_TILES, ti = u.pm % UP_TILES, tok0 = 254 * ti - 1;
        PG8_LAS float* H = (PG8_LAS float*)lds_epi;
#pragma unroll
        for (int ai = 0; ai < 2; ++ai)
#pragma unroll
            for (int m = 0; m < 4; ++m) {
                const int tk = tok0 + ai * HALF + wr * 64 + m * 16 + fr;
                float r2 = 0.f;
                if (tk >= 0 && tk < SEQ) {
                    const float* p = ssq_x1 + ((size_t)sq * SEQ + tk) * 16;
                    const f32x4 a = *(const f32x4*)p, b = *(const f32x4*)(p + 4), c = *(const f32x4*)(p + 8), d = *(const f32x4*)(p + 12);
                    r2 = rsq(((a[0] + a[1]) + (a[2] + a[3])) + ((b[0] + b[1]) + (b[2] + b[3])) + ((c[0] + c[1]) + (c[2] + c[3])) + ((d[0] + d[1]) + (d[2] + d[3])), 1.0f / 1024.0f);
                }
#pragma unroll
                for (int bj = 0; bj < 2; ++bj)
#pragma unroll
                    for (int n = 0; n < 2; ++n) acc[ai][bj][m][n] = acc[ai][bj][m][n] * r2;
            }
#pragma unroll
        for (int ai = 0; ai < 2; ++ai) {
            const int gi = 2 * ai + wr;
#pragma unroll
            for (int bj = 0; bj < 2; ++bj)
#pragma unroll
                for (int n = 0; n < 2; ++n) {
                    const int col = bj * HALF + wc * 32 + fq * 8 + n * 4;
                    if (fr == 0) *(PG8_LAS f32x4*)(H + (gi * 2 + 0) * 256 + col) = acc[ai][bj][0][n];
                    if (fr == 15) *(PG8_LAS f32x4*)(H + (gi * 2 + 1) * 256 + col) = acc[ai][bj][3][n];
                }
        }
        asm volatile("s_waitcnt lgkmcnt(0)" ::: "memory"); __builtin_amdgcn_s_barrier(); asm volatile("" ::: "memory");
        const int chb = u.pn * 128 + wc * 32 + fq * 8;
#pragma unroll
        for (int n = 0; n < 2; ++n) {
            f32x4 w0[2], w1[2], w2[2], bb[2];
#pragma unroll
            for (int bj = 0; bj < 2; ++bj) {
                const int cc = bj * DFF + chb + n * 4;
                w0[bj] = *(const f32x4*)(cw + cc); w1[bj] = *(const f32x4*)(cw + 2 * DFF + cc); w2[bj] = *(const f32x4*)(cw + 4 * DFF + cc); bb[bj] = *(const f32x4*)(cb + cc);
            }
#pragma unroll
            for (int ai = 0; ai < 2; ++ai) {
                const int gi = 2 * ai + wr;
                f32x4 hp[2], hn[2];
#pragma unroll
                for (int bj = 0; bj < 2; ++bj) {
                    const int col = bj * HALF + wc * 32 + fq * 8 + n * 4;
                    hp[bj] = gi > 0 ? *(const PG8_LAS f32x4*)(H + ((gi - 1) * 2 + 1) * 256 + col) : (f32x4){0.f, 0.f, 0.f, 0.f};
                    hn[bj] = gi < 3 ? *(const PG8_LAS f32x4*)(H + ((gi + 1) * 2 + 0) * 256 + col) : (f32x4){0.f, 0.f, 0.f, 0.f};
                }
#pragma unroll
                for (int m = 0; m < 4; ++m) {
                    f32x4 hc[2];
#pragma unroll
                    for (int bj = 0; bj < 2; ++bj) {
                        const f32x4 v = acc[ai][bj][m][n];
                        f32x4 pv, nv;
#pragma unroll
                        for (int i = 0; i < 4; ++i) {
                            const float xp = m > 0 ? dpp_mov<0x121, true>(0.f, acc[ai][bj][m > 0 ? m - 1 : 0][n][i]) : hp[bj][i];
                            pv[i] = dpp_mov<0x111, false>(xp, v[i]);
                            const float xn = m < 3 ? dpp_mov<0x12F, true>(0.f, acc[ai][bj][m < 3 ? m + 1 : 3][n][i]) : hn[bj][i];
                            nv[i] = dpp_mov<0x101, false>(xn, v[i]);
                        }
                        hc[bj] = pv * w0[bj] + v * w1[bj] + nv * w2[bj] + bb[bj];
                    }
                    f32x4 a;
#pragma unroll
                    for (int i = 0; i < 4; ++i) { const float gv = hc[0][i]; a[i] = gv * __builtin_amdgcn_rcpf(1.0f + __builtin_amdgcn_exp2f(-gv * LOG2E)) * hc[1][i]; }
                    const int rl = ai * HALF + wr * 64 + m * 16 + fr, tk = tok0 + rl;
                    if (rl >= 1 && rl <= 254 && tk < SEQ) *(u32x2*)(ACT + ((size_t)sq * SEQ + tk) * DFF + chb + n * 4) = pack4(a);
                }
            }
        }
    }
};

struct EpiDown {
    static constexpr bool PERM = false, MIDK = false; static constexpr int MIDK_T = 0;
    float* out; bf16_t* X2B;
    __device__ __forceinline__ void midk(AccT&, const Unit&, int, int, int, int) const {}
    __device__ __forceinline__ void operator()(AccT& acc, const Unit& u, int wr, int wc, int fr, int fq, PG8_LAS unsigned char*) const {
#pragma unroll
        for (int ai = 0; ai < 2; ++ai) {
            f32x4 xr[4][2][2];
#pragma unroll
            for (int m = 0; m < 4; ++m) {
                const size_t row = (size_t)u.pm * BM + ai * HALF + wr * 64 + m * 16 + fr;
#pragma unroll
                for (int bj = 0; bj < 2; ++bj)
#pragma unroll
                    for (int n = 0; n < 2; ++n) xr[m][bj][n] = *(const f32x4*)(out + row * D + u.pn * BM + bj * HALF + wc * 32 + n * 16 + fq * 4);
            }
#pragma unroll
            for (int m = 0; m < 4; ++m) {
                const size_t row = (size_t)u.pm * BM + ai * HALF + wr * 64 + m * 16 + fr;
#pragma unroll
                for (int bj = 0; bj < 2; ++bj)
#pragma unroll
                    for (int n = 0; n < 2; ++n) {
                        const int col = u.pn * BM + bj * HALF + wc * 32 + n * 16 + fq * 4;
                        const f32x4 x2 = xr[m][bj][n] + acc[ai][bj][m][n];
                        *(f32x4*)(out + row * D + col) = x2;
                        *(u32x2*)(X2B + row * D + col) = pack4(x2);
                    }
            }
        }
    }
};

struct EpiGate {
    static constexpr bool PERM = false, MIDK = false; static constexpr int MIDK_T = 0;
    float* out; const bf16_t* ER; const float* ssq_e; const float* gple; const float* bg;
    __device__ __forceinline__ void midk(AccT&, const Unit&, int, int, int, int) const {}
    __device__ __forceinline__ void operator()(AccT& acc, const Unit& u, int wr, int wc, int fr, int fq, PG8_LAS unsigned char*) const {
        f32x4 bv[2][2], gv[2][2];
#pragma unroll
        for (int bj = 0; bj < 2; ++bj)
#pragma unroll
            for (int n = 0; n < 2; ++n) { const int col = u.pn * BM + bj * HALF + wc * 32 + n * 16 + fq * 4; bv[bj][n] = *(const f32x4*)(bg + col); gv[bj][n] = *(const f32x4*)(gple + col); }
#pragma unroll
        for (int ai = 0; ai < 2; ++ai)
#pragma unroll
            for (int mp = 0; mp < 2; ++mp) {
                f32x4 yv[2][2][2]; u32x2 ew[2][2][2]; float re[2];
#pragma unroll
                for (int mm = 0; mm < 2; ++mm) {
                    const int m = 2 * mp + mm;
                    const size_t row = (size_t)u.pm * BM + ai * HALF + wr * 64 + m * 16 + fr;
                    const float* p = ssq_e + row * 16;
                    const f32x4 a = *(const f32x4*)p, b = *(const f32x4*)(p + 4), c = *(const f32x4*)(p + 8), d = *(const f32x4*)(p + 12);
                    re[mm] = rsq(((a[0] + a[1]) + (a[2] + a[3])) + ((b[0] + b[1]) + (b[2] + b[3])) + ((c[0] + c[1]) + (c[2] + c[3])) + ((d[0] + d[1]) + (d[2] + d[3])), 1.0f / 1024.0f);
#pragma unroll
                    for (int bj = 0; bj < 2; ++bj)
#pragma unroll
                        for (int n = 0; n < 2; ++n) { const int col = u.pn * BM + bj * HALF + wc * 32 + n * 16 + fq * 4;
                            ew[mm][bj][n] = *(const u32x2*)(ER + row * D + col); yv[mm][bj][n] = *(const f32x4*)(out + row * D + col); }
                }
#pragma unroll
                for (int mm = 0; mm < 2; ++mm) {
                    const int m = 2 * mp + mm;
                    const size_t row = (size_t)u.pm * BM + ai * HALF + wr * 64 + m * 16 + fr;
#pragma unroll
                    for (int bj = 0; bj < 2; ++bj)
#pragma unroll
                        for (int n = 0; n < 2; ++n) {
                            const int col = u.pn * BM + bj * HALF + wc * 32 + n * 16 + fq * 4;
                            const u32x2 e2 = ew[mm][bj][n];
                            const f32x4 ev = {__builtin_bit_cast(float, e2.x << 16), __builtin_bit_cast(float, e2.x & 0xffff0000u), __builtin_bit_cast(float, e2.y << 16), __builtin_bit_cast(float, e2.y & 0xffff0000u)};
                            const f32x4 z = acc[ai][bj][m][n] + bv[bj][n];
                            f32x4 y = yv[mm][bj][n];
#pragma unroll
                            for (int i = 0; i < 4; ++i) y[i] += __builtin_amdgcn_rcpf(1.0f + __builtin_amdgcn_exp2f(-z[i] * LOG2E)) * ev[i] * re[mm] * gv[bj][n][i];
                            *(f32x4*)(out + row * D + col) = y;
                        }
                }
            }
    }
};
}
namespace attn {
typedef unsigned short bf16_t;
typedef short bf16x8 __attribute__((ext_vector_type(8)));
typedef short s16x4 __attribute__((ext_vector_type(4)));
typedef float f32x16 __attribute__((ext_vector_type(16)));
typedef unsigned u32x4 __attribute__((ext_vector_type(4)));
typedef unsigned u32x2 __attribute__((ext_vector_type(2)));
#define ATT_LAS __attribute__((address_space(3)))
constexpr int NKEY = 320, KROW = 144, KS_BYTES = NKEY * KROW, VPLANE = NKEY * 64, VS_OFF = KS_BYTES, LDS_BYTES = KS_BYTES + 2 * VPLANE;
constexpr int NUNITS = NSEQ * 2 * (SEQ / 64);
__device__ __forceinline__ int crow(int r, int hi) { return (r & 3) + 8 * (r >> 2) + 4 * hi; }
__device__ __forceinline__ s16x4 vtr(const ATT_LAS unsigned char* p) { return __builtin_bit_cast(s16x4, __builtin_amdgcn_ds_read_tr16_b64_v4i16((ATT_LAS s16x4*)p)); }

__device__ __forceinline__ void unit(int uid, pg8::bf16_t* MIX, const pg8::bf16_t* KB, const pg8::bf16_t* VB, const float* sink, float* ssq_a, ATT_LAS unsigned char* lds) {
    const int tid = threadIdx.x, lane = tid & 63, r32 = lane & 31, hi = lane >> 5; const int wid = __builtin_amdgcn_readfirstlane(tid >> 6);
    const int qb = uid & 255, kvh = (uid >> 8) & 1, b = uid >> 9;
    const int q0 = qb * 64, kbase = q0 - 128;
    u32x4 kr[5], vr[5];
#pragma unroll
    for (int i = 0; i < 5; ++i) {
        const int c = tid + 512 * i, row = c >> 3, ch = c & 7, k = kbase + row;
        kr[i] = (u32x4){0u, 0u, 0u, 0u}; vr[i] = (u32x4){0u, 0u, 0u, 0u};
        if (k >= 0 && k < SEQ) { const size_t g = ((size_t)b * SEQ + k) * 128 + kvh * 64 + ch * 8; kr[i] = *(const u32x4*)(KB + g); vr[i] = *(const u32x4*)(VB + g); }
    }
    asm volatile("s_waitcnt lgkmcnt(0)" ::: "memory"); __builtin_amdgcn_s_barrier(); asm volatile("" ::: "memory");
#pragma unroll
    for (int i = 0; i < 5; ++i) {
        const int c = tid + 512 * i, row = c >> 3, ch = c & 7;
        *(ATT_LAS u32x4*)(lds + row * KROW + ch * 16) = kr[i];
        *(ATT_LAS u32x4*)(lds + VS_OFF + (ch >> 2) * VPLANE + row * 64 + (ch & 3) * 16) = vr[i];
    }
    asm volatile("s_waitcnt lgkmcnt(0)" ::: "memory"); __builtin_amdgcn_s_barrier(); asm volatile("" ::: "memory");
    const int hq = kvh * 4 + (wid >> 1), sb = wid & 1, qi = sb * 32 + r32;
    const size_t tok = (size_t)b * SEQ + q0 + qi;
    bf16x8 qf[4];
#pragma unroll
    for (int d0 = 0; d0 < 4; ++d0) qf[d0] = *(const bf16x8*)(MIX + tok * D + hq * 64 + d0 * 16 + hi * 8);
    float m = sink[hq] * LOG2E, l = hi == 0 ? 1.f : 0.f;
    f32x16 o0, o1;
#pragma unroll
    for (int r = 0; r < 16; ++r) { o0[r] = 0.f; o1[r] = 0.f; }
    const ATT_LAS unsigned char* kp = lds + r32 * KROW + hi * 16;
    const ATT_LAS unsigned char* vp = lds + VS_OFF + (4 * hi + ((lane & 15) >> 2)) * 64 + ((lane >> 4) & 1) * 32 + (lane & 3) * 8;
    for (int g = 0; g < 3; ++g) {
        f32x16 s[3];
        const int st0 = sb + 3 * g;
#pragma unroll
        for (int j = 0; j < 3; ++j) {
#pragma unroll
            for (int r = 0; r < 16; ++r) s[j][r] = 0.f;
#pragma unroll
            for (int d0 = 0; d0 < 4; ++d0) {
                const bf16x8 kf = *(const ATT_LAS bf16x8*)(kp + (32 * (st0 + j)) * KROW + d0 * 32);
                s[j] = __builtin_amdgcn_mfma_f32_32x32x16_bf16(kf, qf[d0], s[j], 0, 0, 0);
            }
        }
        float mloc = -1e30f;
#pragma unroll
        for (int j = 0; j < 3; ++j)
#pragma unroll
            for (int r = 0; r < 16; ++r) {
                const int kk = 32 * (st0 + j) + crow(r, hi), k = kbase + kk;
                const bool ok = kk >= qi && kk <= qi + 256 && k >= 0 && k < SEQ;
                s[j][r] = ok ? s[j][r] : -1e30f;
                mloc = fmaxf(mloc, s[j][r]);
            }
        mloc = fmaxf(mloc, __shfl_xor(mloc, 32));
        const float mnew = fmaxf(m, mloc), alpha = __builtin_amdgcn_exp2f(m - mnew);
        m = mnew; l *= alpha;
#pragma unroll
        for (int r = 0; r < 16; ++r) { o0[r] *= alpha; o1[r] *= alpha; }
        float ps = 0.f;
#pragma unroll
        for (int j = 0; j < 3; ++j)
#pragma unroll
            for (int r = 0; r < 16; ++r) { s[j][r] = __builtin_amdgcn_exp2f(s[j][r] - mnew); ps += s[j][r]; }
        l += ps;
#pragma unroll
        for (int j = 0; j < 3; ++j)
#pragma unroll
            for (int ks = 0; ks < 2; ++ks) {
                u32x4 pw;
                pw.x = pg8::cvt_pk_bf16(s[j][8 * ks + 0], s[j][8 * ks + 1]); pw.y = pg8::cvt_pk_bf16(s[j][8 * ks + 2], s[j][8 * ks + 3]);
                pw.z = pg8::cvt_pk_bf16(s[j][8 * ks + 4], s[j][8 * ks + 5]); pw.w = pg8::cvt_pk_bf16(s[j][8 * ks + 6], s[j][8 * ks + 7]);
                const bf16x8 pf = __builtin_bit_cast(bf16x8, pw);
                const ATT_LAS unsigned char* vq = vp + (32 * (st0 + j) + 16 * ks) * 64;
                const s16x4 a0 = vtr(vq), a1 = vtr(vq + 8 * 64), b0 = vtr(vq + VPLANE), b1 = vtr(vq + VPLANE + 8 * 64);
                const bf16x8 vf0 = (bf16x8){a0[0], a0[1], a0[2], a0[3], a1[0], a1[1], a1[2], a1[3]};
                const bf16x8 vf1 = (bf16x8){b0[0], b0[1], b0[2], b0[3], b1[0], b1[1], b1[2], b1[3]};
                o0 = __builtin_amdgcn_mfma_f32_32x32x16_bf16(vf0, pf, o0, 0, 0, 0);
                o1 = __builtin_amdgcn_mfma_f32_32x32x16_bf16(vf1, pf, o1, 0, 0, 0);
            }
    }
    const float ltot = l + __shfl_xor(l, 32), inv = 1.0f / ltot;
    float ss = 0.f;
#pragma unroll
    for (int r = 0; r < 16; ++r) { o0[r] *= inv; o1[r] *= inv; ss += o0[r] * o0[r] + o1[r] * o1[r]; }
    ss += __shfl_xor(ss, 32);
    if (hi == 0) ssq_a[tok * 8 + hq] = ss;
    pg8::bf16_t* op = MIX + tok * D + hq * 64 + 4 * hi;
#pragma unroll
    for (int rg = 0; rg < 4; ++rg) {
        u32x2 w0, w1;
        w0.x = pg8::cvt_pk_bf16(o0[4 * rg], o0[4 * rg + 1]); w0.y = pg8::cvt_pk_bf16(o0[4 * rg + 2], o0[4 * rg + 3]);
        w1.x = pg8::cvt_pk_bf16(o1[4 * rg], o1[4 * rg + 1]); w1.y = pg8::cvt_pk_bf16(o1[4 * rg + 2], o1[4 * rg + 3]);
        *(u32x2*)(op + 8 * rg) = w0; *(u32x2*)(op + 32 + 8 * rg) = w1;
    }
}
}
constexpr int NWAVES = 8;
#ifndef MK_N_LAUNCHES
#define MK_N_LAUNCHES 1
#endif
constexpr int N_PHASES = 8;
constexpr int N_LAUNCHES = MK_N_LAUNCHES;

constexpr size_t MiB = 1u << 20;
constexpr size_t WS_CTL = 0, CTL_ZERO_BYTES = 64 * 1024;
constexpr size_t WS_ROPEC = 1 * MiB, WS_ROPES = WS_ROPEC + 512 * 1024;
constexpr size_t WS_TWC = 2 * MiB, WS_TWS = WS_TWC + 64 * 1024;
constexpr size_t WS_DFT1 = WS_TWS + 64 * 1024, WS_DFT2 = WS_DFT1 + 128 * 1024;
constexpr size_t WS_WQKV = 3 * MiB;
constexpr size_t WS_WAB = WS_WQKV + 768 * 1024 * 2;
constexpr size_t WS_WOUT = WS_WAB + 2 * MiB;
constexpr size_t WS_WUP = WS_WOUT + 2 * MiB;
constexpr size_t WS_WDOWN = WS_WUP + 11 * MiB;
constexpr size_t WS_WPLE = WS_WDOWN + (size_t)1024 * 2816 * 2;
constexpr size_t WS_WGATE = WS_WPLE + 512 * 1024;
constexpr size_t WS_WEND = WS_WGATE + 2 * MiB;
static_assert(WS_WEND <= 30 * MiB, "weights region");
constexpr size_t WS_ERAW = 30 * MiB;
constexpr size_t WS_SSQ_A = 126 * MiB, WS_SSQ_F = WS_SSQ_A + (size_t)T * 8 * 4, WS_SSQ_X1 = WS_SSQ_F + (size_t)T * 8 * 4, WS_SSQ_E = WS_SSQ_X1 + (size_t)T * 16 * 4;
static_assert(WS_SSQ_E + (size_t)T * 16 * 4 <= 136 * MiB, "ssq region");
constexpr size_t WS_R1 = 136 * MiB;
constexpr size_t WS_MIX = 234 * MiB;
constexpr size_t WS_KB = 330 * MiB, WS_VB = 342 * MiB;
constexpr size_t WS_W1 = 354 * MiB;
constexpr size_t WS_PB = 450 * MiB;
constexpr size_t WS_ACT = 234 * MiB;
constexpr size_t WS_END = 498 * MiB;
static_assert((size_t)NSEQ * XPAD * D * 2 <= 98 * MiB && WS_ACT + (size_t)T * DFF * 2 <= WS_END && WS_PB + (size_t)T * PLE * 2 <= WS_END, "d_ws map");
constexpr int CW_BAR = 4096;

constexpr int RING_OFF = 0, RING_BYTES = 131072, EPI_OFF = RING_BYTES, EPI_BYTES = 16384;
constexpr int LDSCTL_OFF = EPI_OFF + EPI_BYTES, MISC_OFF = LDSCTL_OFF + 320;
constexpr int LDS_BYTES = LDSCTL_OFF + 1024;
static_assert(attn::LDS_BYTES <= RING_BYTES, "attention LDS");

#define GAS __attribute__((address_space(1)))
#define LAS __attribute__((address_space(3)))
typedef unsigned short bf16;
typedef unsigned v4u __attribute__((ext_vector_type(4)));
typedef float f32x4 __attribute__((ext_vector_type(4)));
typedef GAS unsigned gu32;
#define RLX_AGENT __ATOMIC_RELAXED, __HIP_MEMORY_SCOPE_AGENT
#define LDS_WAIT() asm volatile("s_waitcnt lgkmcnt(0)" ::: "memory")
#define VM_WAIT() asm volatile("s_waitcnt vmcnt(0)" ::: "memory")
__device__ __forceinline__ unsigned f2bf(float f) { unsigned u = __builtin_bit_cast(unsigned, f); return (u + 0x7fffu + ((u >> 16) & 1u)) >> 16; }
__device__ __forceinline__ unsigned pk2(float lo, float hi) { return f2bf(lo) | (f2bf(hi) << 16); }

#define XB_TMO      128
#define XB_XCNT(j)  (256  + 64 * (j))
#define XB_XSUB(j)  (1280 + 64 * (j))
#define XB_XGEN(j)  (2304 + 64 * (j))
#define XB_TOP      3328
#define XB_TOPGEN   3392
#define XCD_BAR_WORDS 3456
#define XB_SPIN_CAP (1u << 18)
__device__ __forceinline__ unsigned xb_ld(unsigned* p)              { return __hip_atomic_load(p, __ATOMIC_RELAXED, __HIP_MEMORY_SCOPE_AGENT); }
__device__ __forceinline__ unsigned xb_add(unsigned* p, unsigned v) { return __hip_atomic_fetch_add(p, v, __ATOMIC_RELAXED, __HIP_MEMORY_SCOPE_AGENT); }
__device__ __forceinline__ unsigned xb_xcc_id() { return (unsigned)__builtin_amdgcn_s_getreg((3 << 11) | 20) & 0xFu; }
#define XB_SPIN(cond, bar) do { unsigned _sp = 0; while (cond) { __builtin_amdgcn_s_sleep(1); \
    if ((++_sp & 255u) == 0u) { if (xb_ld(&(bar)[XB_TMO])) break; if (_sp > XB_SPIN_CAP) { atomicAdd(&(bar)[XB_TMO], 1u); break; } } } } while (0)
struct XcdBarrier { unsigned* bar; unsigned x; volatile LAS unsigned* st; };
__device__ __forceinline__ XcdBarrier xcd_barrier_post(unsigned* bar, volatile LAS unsigned* st) {
    XcdBarrier b; b.bar = bar; b.x = xb_xcc_id(); b.st = st;
    if (threadIdx.x == 0) (void)xb_add(&bar[XB_XCNT(b.x)], 1u);
    return b;
}
__device__ __forceinline__ void xcd_barrier_complete(unsigned* bar, unsigned x, unsigned& nloc, unsigned& nx) {
    const unsigned G = gridDim.x * gridDim.y * gridDim.z;
    unsigned sum, cnt, mine, sp = 0u;
    for (;;) {
        sum = 0u; cnt = 0u; mine = 0u;
#pragma unroll
        for (unsigned j = 0; j < 16; ++j) { const unsigned c = xb_ld(&bar[XB_XCNT(j)]); sum += c; cnt += (c > 0u) ? 1u : 0u; mine = (j == x) ? c : mine; }
        if (sum == G) break;
        __builtin_amdgcn_s_sleep(1);
        if ((++sp & 255u) == 0u) { if (xb_ld(&bar[XB_TMO])) break; if (sp > XB_SPIN_CAP) { atomicAdd(&bar[XB_TMO], 1u); break; } }
    }
    nloc = mine > 0u ? mine : 1u; nx = cnt > 0u ? cnt : 1u;
}
__device__ __forceinline__ void xcd_barrier(const XcdBarrier& b) {
    asm volatile("s_waitcnt vmcnt(0)" ::: "memory");
    __syncthreads();
    if (threadIdx.x == 0) {
        unsigned* bar = b.bar;
        __builtin_amdgcn_s_waitcnt(0);
        unsigned nloc = b.st[0], nx = b.st[1];
        if (nloc == 0u) { xcd_barrier_complete(bar, b.x, nloc, nx); b.st[0] = nloc; b.st[1] = nx; }
        const unsigned old = xb_add(&bar[XB_XSUB(b.x)], 1u);
        const unsigned gen = old / nloc;
        if (old + 1u == (gen + 1u) * nloc) {
            __builtin_amdgcn_fence(__ATOMIC_RELEASE, "agent");
            asm volatile("s_waitcnt vmcnt(0)" ::: "memory");
            const unsigned og = xb_add(&bar[XB_TOP], 1u);
            const unsigned tg = og / nx;
            if (og + 1u == (tg + 1u) * nx) xb_add(&bar[XB_TOPGEN], 1u);
            else XB_SPIN(xb_ld(&bar[XB_TOPGEN]) == tg, bar);
            __builtin_amdgcn_fence(__ATOMIC_ACQUIRE, "agent");
            xb_add(&bar[XB_XGEN(b.x)], 1u);
            asm volatile("s_waitcnt vmcnt(0)" ::: "memory");
        } else {
            XB_SPIN(xb_ld(&bar[XB_XGEN(b.x)]) == gen, bar);
            __builtin_amdgcn_fence(__ATOMIC_ACQUIRE, "agent");
            asm volatile("s_waitcnt vmcnt(0)" ::: "memory");
        }
    }
    __syncthreads();
}

__device__ __forceinline__ float wave_sum(float v) {
#pragma unroll
    for (int o = 1; o < 64; o <<= 1) v += __shfl_xor(v, o);
    return v;
}
__device__ __forceinline__ void p0_transpose_item(const float* W, int ldw, int src_n0, const float* gk, int k0, bf16* WT, int ldt, int dst_n0, LAS float* scr, int lane) {
#pragma unroll 8
    for (int i = 0; i < 32; ++i) { const int kk = 2 * i + (lane >> 5); float v = W[(size_t)(k0 + kk) * ldw + src_n0 + (lane & 31)]; if (gk) v *= gk[k0 + kk]; scr[kk * 33 + (lane & 31)] = v; }
    LDS_WAIT(); asm volatile("" ::: "memory");
    const int c = lane & 7;
#pragma unroll
    for (int j = 0; j < 4; ++j) { const int n = (lane >> 3) + 8 * j; const LAS float* s = scr + (8 * c) * 33 + n;
        v4u o; o.x = pk2(s[0 * 33], s[1 * 33]); o.y = pk2(s[2 * 33], s[3 * 33]); o.z = pk2(s[4 * 33], s[5 * 33]); o.w = pk2(s[6 * 33], s[7 * 33]);
        *(GAS v4u*)(WT + (size_t)(dst_n0 + n) * ldt + k0 + 8 * c) = o; }
    LDS_WAIT(); asm volatile("" ::: "memory");
}
__constant__ float c_invf[8] = {1.0f, 0.19392274474868576f, 0.03760603093086393f, 0.007292664737217109f, 0.001414213562373095f, 0.0002742481756762073f, 5.318295896944988e-05f, 1.031338537721246e-05f};

struct Args { const float* in[22]; float* out; unsigned char* ws; int ph_lo, ph_hi, li, pad; };

__global__ void __launch_bounds__(NWAVES * 64, 2) mk_fwd(Args args) {
    extern __shared__ __attribute__((aligned(16))) unsigned char lds_raw[];
    LAS unsigned char* lds = (LAS unsigned char*)lds_raw;
    volatile LAS unsigned* MISC = (volatile LAS unsigned*)(lds + MISC_OFF);
    const int tid = threadIdx.x, lane = tid & 63, wave = __builtin_amdgcn_readfirstlane(tid >> 6);
    const int G = gridDim.x, bx = blockIdx.x, vcu = (G % 8 == 0) ? (bx % 8) * (G / 8) + bx / 8 : bx;
    unsigned char* ws = args.ws;
    gu32* ctl = (gu32*)(ws + WS_CTL);
    const float *xp = args.in[0], *xs = args.in[1], *pp = args.in[2], *ps = args.in[3], *attn_norm = args.in[4], *w_in = args.in[5], *q_norm = args.in[6], *k_norm = args.in[7], *sink = args.in[8],
                *w_fourier = args.in[9], *ao_norm = args.in[10], *fo_norm = args.in[11], *w_out = args.in[12], *ffn_norm = args.in[13], *w_up = args.in[14], *conv_w = args.in[15], *conv_b = args.in[16],
                *w_down = args.in[17], *w_ple = args.in[18], *ple_norm = args.in[19], *w_gate = args.in[20], *b_gate = args.in[21];
    float* out = args.out;
    float* ropeC = (float*)(ws + WS_ROPEC); float* ropeS = (float*)(ws + WS_ROPES); float* twc = (float*)(ws + WS_TWC); float* tws = (float*)(ws + WS_TWS);
    bf16 *DFT1 = (bf16*)(ws + WS_DFT1), *DFT2 = (bf16*)(ws + WS_DFT2), *WQKV = (bf16*)(ws + WS_WQKV), *WAB = (bf16*)(ws + WS_WAB), *WOUT = (bf16*)(ws + WS_WOUT), *WUP = (bf16*)(ws + WS_WUP),
         *WDOWN = (bf16*)(ws + WS_WDOWN), *WPLE = (bf16*)(ws + WS_WPLE), *WGATE = (bf16*)(ws + WS_WGATE), *ERAW = (bf16*)(ws + WS_ERAW), *HB = (bf16*)(ws + WS_R1), *ZB = (bf16*)(ws + WS_R1),
         *X1B = (bf16*)(ws + WS_R1), *X2B = (bf16*)(ws + WS_R1), *MIX = (bf16*)(ws + WS_MIX), *KB = (bf16*)(ws + WS_KB), *VB = (bf16*)(ws + WS_VB), *W1 = (bf16*)(ws + WS_W1), *PB = (bf16*)(ws + WS_PB),
         *ACT = (bf16*)(ws + WS_ACT);
    float *ssq_a = (float*)(ws + WS_SSQ_A), *ssq_f = (float*)(ws + WS_SSQ_F), *ssq_x1 = (float*)(ws + WS_SSQ_X1), *ssq_e = (float*)(ws + WS_SSQ_E);

    for (int u = tid; u < (LDS_BYTES - LDSCTL_OFF) / 4; u += NWAVES * 64) ((LAS unsigned*)(lds + LDSCTL_OFF))[u] = 0u;
    __syncthreads();
    XcdBarrier bar; bar.bar = (unsigned*)(ctl + CW_BAR) + args.li * XCD_BAR_WORDS; bar.x = 0; bar.st = nullptr;
    if (N_LAUNCHES != N_PHASES) bar = xcd_barrier_post((unsigned*)(ctl + CW_BAR) + args.li * XCD_BAR_WORDS, MISC + 8);
#define GRID_BAR() do { if (N_LAUNCHES != N_PHASES) xcd_barrier(bar); } while (0)
    const int lo = args.ph_lo, hi = args.ph_hi;
#ifndef PH_MASK
#define PH_MASK 0xFF
#endif
#define IN(k) (((PH_MASK >> (k)) & 1) && lo <= (k) && (k) < hi)
#define BOTH(k) (IN(k) && IN((k) + 1))
    LAS unsigned char* ring = lds + RING_OFF; LAS unsigned char* epi = lds + EPI_OFF;

    if (IN(0)) {
        const int gw = vcu * NWAVES + wave, NGW = G * NWAVES;
        LAS float* scr = (LAS float*)(ring + wave * 16384);
        {
            f32x4 gv[4];
#pragma unroll
            for (int j = 0; j < 4; ++j) gv[j] = ((const GAS f32x4*)attn_norm)[lane + 64 * j];
            for (int mrow = gw; mrow < T; mrow += NGW) {
                const float* xrow = mrow < 2 * SEQ ? xp + (size_t)mrow * D : xs + (size_t)(mrow - 2 * SEQ) * D;
                const GAS f32x4* xr = (const GAS f32x4*)xrow + lane;
                f32x4 v[4]; float s = 0.f;
#pragma unroll
                for (int j = 0; j < 4; ++j) { v[j] = xr[64 * j]; s += (v[j].x * v[j].x + v[j].y * v[j].y) + (v[j].z * v[j].z + v[j].w * v[j].w); }
                const float rstd = 1.f / sqrtf(wave_sum(s) * (1.f / D) + EPS);
                GAS unsigned long long* o8 = (GAS unsigned long long*)(HB + (size_t)mrow * D) + lane;
#pragma unroll
                for (int j = 0; j < 4; ++j) { const f32x4 y = v[j] * rstd * gv[j]; o8[64 * j] = (unsigned long long)pk2(y.x, y.y) | ((unsigned long long)pk2(y.z, y.w) << 32); }
            }
        }
        for (size_t c8 = (size_t)gw * 64 + lane; c8 < (size_t)T * PLE / 8; c8 += (size_t)NGW * 64) {
            const size_t e0 = c8 * 8, row = e0 / PLE;
            const float* src = row < (size_t)2 * SEQ ? pp + e0 : ps + (e0 - (size_t)2 * SEQ * PLE);
            const f32x4 a = *(const f32x4*)src, b = *(const f32x4*)(src + 4);
            v4u o; o.x = pk2(a.x, a.y); o.y = pk2(a.z, a.w); o.z = pk2(b.x, b.y); o.w = pk2(b.z, b.w);
            *(v4u*)(PB + e0) = o;
        }
        {
            constexpr int I_QKV = 16 * 24, I_OUT = 16 * 32, I_UP = 16 * 176, I_DOWN = 44 * 32, I_PLE = 4 * 32, I_GATE = 16 * 32;
            constexpr int NIT = I_QKV + I_OUT + I_UP + I_DOWN + I_PLE + I_GATE;
            for (int it = gw; it < NIT; it += NGW) {
                int r = it;
                if (r < I_QKV) { const int kb = r / 24, nb = r % 24, n0 = 32 * nb, tile = n0 >> 8, p = n0 & 255, bj = p >> 7, wcc = (p >> 5) & 3;
                    p0_transpose_item(w_in, INW, tile * 256 + wcc * 64 + bj * 32, nullptr, 64 * kb, WQKV, D, n0, scr, lane); continue; } r -= I_QKV;
                if (r < I_OUT) { const int kb = r / 32, nb = r % 32; p0_transpose_item(w_out, D, 32 * nb, kb < 8 ? ao_norm : fo_norm - 512, 64 * kb, WOUT, D, 32 * nb, scr, lane); continue; } r -= I_OUT;
                if (r < I_UP) { const int kb = r / 176, nb = r % 176, n0 = 32 * nb, tile = n0 >> 8, p = n0 & 255, bj = p >> 7;
                    p0_transpose_item(w_up, 2 * DFF, bj * DFF + tile * 128 + (p & 127), ffn_norm, 64 * kb, WUP, D, n0, scr, lane); continue; } r -= I_UP;
                if (r < I_DOWN) { const int kb = r / 32, nb = r % 32; p0_transpose_item(w_down, D, 32 * nb, nullptr, 64 * kb, WDOWN, DFF, 32 * nb, scr, lane); continue; } r -= I_DOWN;
                if (r < I_PLE) { const int kb = r / 32, nb = r % 32; p0_transpose_item(w_ple, D, 32 * nb, nullptr, 64 * kb, WPLE, PLE, 32 * nb, scr, lane); continue; } r -= I_PLE;
                { const int kb = r / 32, nb = r % 32; p0_transpose_item(w_gate, D, 32 * nb, nullptr, 64 * kb, WGATE, D, 32 * nb, scr, lane); }
            }
        }
        for (int idx = vcu * 512 + tid; idx < SEQ * 8; idx += G * 512) {
            const int pos = idx >> 3;
            const float ang = (float)pos * c_invf[idx & 7];
            const double a = (double)ang, rr = a - 6.283185307179586476925 * rint(a * 0.15915494309189533577);
            float sn, cs; sincospif((float)(rr * 0.31830988618379067154), &sn, &cs);
            ropeC[idx] = cs; ropeS[idx] = sn;
        }
        for (int idx = vcu * 512 + tid; idx < 128 * 128; idx += G * 512) {
            const int k1 = idx >> 7, n2 = idx & 127; float sn, cs; sincospif(2.0f * (float)(k1 * n2) / 16384.0f, &sn, &cs); twc[idx] = cs; tws[idx] = sn;
        }
        for (int idx = vcu * 512 + tid; idx < 256 * 256; idx += G * 512) {
            const int r = idx >> 8, k = idx & 255, kr = r & 127, im = r >> 7, part = k >> 7, nn = k & 127;
            float sn, cs; sincospif(2.0f * (float)((kr * nn) & 127) / 128.0f, &sn, &cs);
            const float v1 = im == 0 ? (part == 0 ? cs : -sn) : (part == 0 ? -sn : -cs);
            DFT1[idx] = (bf16)f2bf(v1);
            const float v2 = im == 0 ? (part == 0 ? cs : sn) * (1.0f / 1024.0f) : 0.f;
            DFT2[idx] = (bf16)f2bf(v2);
        }
        __syncthreads();
        {
            LAS float* Ml = (LAS float*)ring; LAS float* Wl = Ml + 64 * 65; LAS float* tg = Wl + 64 * 65;
            for (int item = vcu; item < 256; item += G) {
                const int part = item >> 7, g = (item >> 4) & 7, k0 = 64 * (item & 15);
                if (tid < 64) { float sn, cs; sincospif(2.0f * (float)tid / 64.0f, &sn, &cs); tg[tid] = part == 0 ? cs : sn; }
#pragma unroll
                for (int i = 0; i < 8; ++i) { const int idx = tid + 512 * i, k = idx >> 6, c = idx & 63; Wl[k * 65 + c] = w_in[(size_t)(k0 + k) * INW + 768 + 64 * g + c]; }
                __syncthreads();
                { const int e = tid & 63;
#pragma unroll 1
                  for (int i = 0; i < 8; ++i) { const int c = (tid >> 6) + 8 * i; float a = 0.f;
#pragma unroll 4
                      for (int j = 0; j < 64; ++j) a += tg[(c * j) & 63] * w_fourier[(size_t)g * 4096 + j * 64 + e];
                      Ml[c * 65 + e] = a; } }
                __syncthreads();
                { const int e = tid >> 3, kc = (tid & 7) * 8; float a[8];
#pragma unroll
                  for (int kk = 0; kk < 8; ++kk) a[kk] = 0.f;
#pragma unroll 2
                  for (int c = 0; c < 64; ++c) { const float mv = Ml[c * 65 + e];
#pragma unroll
                      for (int kk = 0; kk < 8; ++kk) a[kk] += Wl[(kc + kk) * 65 + c] * mv; }
                  v4u o; o.x = pk2(a[0], a[1]); o.y = pk2(a[2], a[3]); o.z = pk2(a[4], a[5]); o.w = pk2(a[6], a[7]);
                  *(v4u*)(WAB + (size_t)(part * 512 + 64 * g + e) * D + k0 + kc) = o; }
                __syncthreads();
            }
        }
        if (BOTH(0)) GRID_BAR();
    }

    if (IN(1)) {
        {
            pg8::SchedPlain S; S.o.init(T / 256, 3, G, bx); S.A = (const char*)HB; S.B = (const char*)WQKV; S.tA = (size_t)256 * D * 2; S.tB = (size_t)256 * D * 2;
            const pg8::Geom g{D, D * 2, D * 2, 128 * D * 2, 128 * D * 2};
            const pg8::EpiQKV E{MIX, KB, VB, q_norm, k_norm, ropeC, ropeS};
            pg8::gemm_phase<pg8::EpiQKV, pg8::SchedPlain, true>(ring, epi, g, S, E);
        }
        {
            pg8::SchedTokGather S; S.o.init(4, T / 256, G, bx); S.A = (const char*)WAB; S.HB = (const char*)HB; S.tA = (size_t)256 * D * 2;
            const pg8::Geom g{D, D * 2, 128 * D * 2, 128 * D * 2, D * 2};
            const pg8::EpiAB E{W1};
            pg8::gemm_phase<pg8::EpiAB, pg8::SchedTokGather, true>(ring, epi, g, S, E);
        }
        {
            pg8::SchedPlain S; S.o.init(T / 256, 4, G, bx); S.A = (const char*)PB; S.B = (const char*)WPLE; S.tA = (size_t)256 * PLE * 2; S.tB = (size_t)256 * PLE * 2;
            const pg8::Geom g{PLE, PLE * 2, PLE * 2, 128 * PLE * 2, 128 * PLE * 2};
            const pg8::EpiPle E{ERAW, ssq_e};
            pg8::gemm_phase<pg8::EpiPle, pg8::SchedPlain, true>(ring, epi, g, S, E);
        }
        if (BOTH(1)) GRID_BAR();
    }

    if (IN(2)) {
#ifndef NO_ATT
        for (int uid = vcu; uid < attn::NUNITS; uid += G) attn::unit(uid, MIX, KB, VB, sink, ssq_a, ring);
#endif
        LDS_WAIT(); __syncthreads();
#ifndef NO_S1
        {
            pg8::SchedPlain S; S.o.init(1, NSEQ * 512 * 128 / 256, G, bx); S.A = (const char*)DFT1; S.B = (const char*)W1; S.tA = 0; S.tB = (size_t)256 * 256 * 2;
            const pg8::Geom g{256, 512, 512, 128 * 512, 128 * 512};
            const pg8::EpiS1 E{ZB, twc, tws};
            pg8::gemm_phase<pg8::EpiS1, pg8::SchedPlain, true>(ring, epi, g, S, E);
        }
#endif
        if (BOTH(2)) GRID_BAR();
    }

    if (IN(3)) {
        pg8::SchedPlain S; S.o.init(1, NSEQ * 128 * 512 / 256, G, bx); S.A = (const char*)DFT2; S.B = (const char*)ZB; S.tA = 0; S.tB = (size_t)256 * 256 * 2;
        const pg8::Geom g{256, 512, 512, 128 * 512, 128 * 512};
        const pg8::EpiS2 E{MIX, ssq_f};
        pg8::gemm_phase<pg8::EpiS2, pg8::SchedPlain, true>(ring, epi, g, S, E);
        if (BOTH(3)) GRID_BAR();
    }

    if (IN(4)) {
        for (int i = vcu * 512 + tid; i < NSEQ * 256 * (D / 8); i += G * 512) {
            const int sq = i / (256 * (D / 8)), rem = i % (256 * (D / 8)), rr = rem / (D / 8), c8 = rem % (D / 8);
            const int prow = rr == 0 ? 0 : SEQ + rr;
            *(v4u*)(X1B + ((size_t)sq * XPAD + prow) * D + c8 * 8) = (v4u){0u, 0u, 0u, 0u};
        }
        pg8::SchedPlain S; S.o.init(T / 256, 4, G, bx); S.A = (const char*)MIX; S.B = (const char*)WOUT; S.tA = (size_t)256 * D * 2; S.tB = (size_t)256 * D * 2;
        const pg8::Geom g{D, D * 2, D * 2, 128 * D * 2, 128 * D * 2};
        const pg8::EpiOut E{xp, xs, out, X1B, ssq_a, ssq_f, ssq_x1};
        pg8::gemm_phase<pg8::EpiOut, pg8::SchedPlain, true>(ring, epi, g, S, E);
        if (BOTH(4)) GRID_BAR();
    }

    if (IN(5)) {
        pg8::SchedHalo S; S.o.init(NSEQ * UP_TILES, 2 * DFF / 256, G, bx); S.X1B = (const char*)X1B; S.B = (const char*)WUP; S.tB = (size_t)256 * D * 2;
        const pg8::Geom g{D, D * 2, D * 2, 128 * D * 2, 128 * D * 2};
        const pg8::EpiUp E{conv_w, conv_b, ssq_x1, ACT};
        pg8::gemm_phase<pg8::EpiUp, pg8::SchedHalo, true>(ring, epi, g, S, E);
        if (BOTH(5)) GRID_BAR();
    }

    if (IN(6)) {
        pg8::SchedPlain S; S.o.init(T / 256, 4, G, bx); S.A = (const char*)ACT; S.B = (const char*)WDOWN; S.tA = (size_t)256 * DFF * 2; S.tB = (size_t)256 * DFF * 2;
        const pg8::Geom g{DFF, DFF * 2, DFF * 2, 128 * DFF * 2, 128 * DFF * 2};
        const pg8::EpiDown E{out, X2B};
        pg8::gemm_phase<pg8::EpiDown, pg8::SchedPlain, true>(ring, epi, g, S, E);
        if (BOTH(6)) GRID_BAR();
    }

    if (IN(7)) {
        pg8::SchedPlain S; S.o.init(T / 256, 4, G, bx); S.A = (const char*)X2B; S.B = (const char*)WGATE; S.tA = (size_t)256 * D * 2; S.tB = (size_t)256 * D * 2;
        const pg8::Geom g{D, D * 2, D * 2, 128 * D * 2, 128 * D * 2};
        const pg8::EpiGate E{out, ERAW, ssq_e, ple_norm, b_gate};
        pg8::gemm_phase<pg8::EpiGate, pg8::SchedPlain, true>(ring, epi, g, S, E);
    }
#undef IN
#undef BOTH
#undef GRID_BAR
}

extern "C" void kernel_launch(void* const* d_in, const int* in_sizes, int n_in, void* d_out, int out_size, void* d_ws, size_t ws_size, hipStream_t stream) {
    static int grid = 0;
    if (grid == 0) {
        if (n_in != 22 || in_sizes[0] != 2 * SEQ * D || out_size != T * D || ws_size < WS_END) { fprintf(stderr, "kernel_launch: unexpected shapes (n_in %d, in0 %d, out %d, ws %zu); nothing launched\n", n_in, n_in > 0 ? in_sizes[0] : -1, out_size, ws_size); grid = -1; return; }
        int dev = 0, cus = 0, per_cu = 0;
        if (hipGetDevice(&dev) != hipSuccess || hipDeviceGetAttribute(&cus, hipDeviceAttributeMultiprocessorCount, dev) != hipSuccess) { fprintf(stderr, "kernel_launch: device query failed\n"); grid = -1; return; }
        if (hipFuncSetAttribute((const void*)mk_fwd, hipFuncAttributeMaxDynamicSharedMemorySize, LDS_BYTES) != hipSuccess) { fprintf(stderr, "kernel_launch: hipFuncSetAttribute failed\n"); grid = -1; return; }
        if (hipOccupancyMaxActiveBlocksPerMultiprocessor(&per_cu, (const void*)mk_fwd, NWAVES * 64, LDS_BYTES) != hipSuccess || per_cu < 1)
            fprintf(stderr, "kernel_launch: note: occupancy query reports %d workgroups per CU\n", per_cu);
        (void)hipGetLastError();
        grid = cus;
    }
    if (grid < 0) return;
    if (hipMemsetAsync((char*)d_ws + WS_CTL, 0, CTL_ZERO_BYTES, stream) != hipSuccess) { fprintf(stderr, "kernel_launch: memset failed\n"); return; }
    Args a{};
    for (int i = 0; i < 22; ++i) a.in[i] = (const float*)d_in[i];
    a.out = (float*)d_out; a.ws = (unsigned char*)d_ws;
    for (int li = 0; li < N_LAUNCHES; ++li) {
        if (N_LAUNCHES == 1) { a.ph_lo = 0; a.ph_hi = N_PHASES; } else { a.ph_lo = li; a.ph_hi = li + 1; }
        a.li = 0;
        hipLaunchKernelGGL(mk_fwd, dim3(grid), dim3(NWAVES * 64), LDS_BYTES, stream, a);
        const hipError_t le = hipPeekAtLastError();
        if (le != hipSuccess) { fprintf(stderr, "kernel_launch: launch %d failed: %s\n", li, hipGetErrorName(le)); break; }
    }
}
```

```cpp
#include <hip/hip_runtime.h>
#include <cstdio>
#include <cstdint>
#include <cmath>
namespace pg8 {
#define PG8_LAS __attribute__((address_space(3)))
typedef unsigned short bf16_t;
typedef short bf16x8 __attribute__((ext_vector_type(8)));
typedef float f32x4 __attribute__((ext_vector_type(4)));
typedef unsigned u32x4 __attribute__((ext_vector_type(4)));
typedef unsigned u32x2 __attribute__((ext_vector_type(2)));
constexpr int BM = 256, BK = 64, HALF = 128, HTB = HALF * BK * 2  , STAGE_BYTES = 8 * HTB, NXCD = 8, WGM = 8;

__host__ __device__ __forceinline__ int lds_byte(int r, int c) { const int st = (r >> 4) * 2 + (c >> 5), rr = r & 15, cc = c & 31, ob = rr * 64 + cc * 2; return st * 1024 + (ob ^ (((ob >> 9) & 1) << 5)); }
__host__ __device__ __forceinline__ void stage_rc(int b, int& R, int& C) { const int st = b / 1024, sb = b % 1024, swz = sb ^ (((sb >> 9) & 1) << 5); R = (st >> 1) * 16 + swz / 64; C = (st & 1) * 32 + (swz % 64) / 2; }
__host__ __device__ __forceinline__ int perm32(int rho) { const int n = rho >> 4, i = rho & 15; return 8 * (i >> 2) + 4 * n + (i & 3); }

struct Unit { int pm, pn, ui; };
struct Geom { int K; unsigned rsA, rsB, hsA, hsB; };

struct TileOrder {
    int nM, nN, nwg, G, c, heavy;
    __device__ void init(int nM_, int nN_, int G_, int c_) { nM = nM_; nN = nN_; nwg = nM * nN; G = G_; c = c_; heavy = 0; }
    __device__ bool next(int i, Unit& u) const {
        long L = (long)i * G + c;
        if (heavy > 0) {
            const int light = G - heavy, r3 = nwg - G - 2 * light;
            if (i == 0) L = c;
            else if (c < heavy || i > 3 || (i == 3 && c - heavy >= r3)) return false;
            else L = G + (long)(i - 1) * light + (c - heavy);
        }
        if (L >= nwg) return false;
        int wgid = (int)L; { const int q = nwg / NXCD, r = nwg % NXCD, xcd = wgid % NXCD, off = wgid / NXCD; wgid = (xcd < r ? xcd * (q + 1) : r * (q + 1) + (xcd - r) * q) + off; }
        const int nig = WGM * nN, gid = wgid / nig, fm = gid * WGM, gsz = (nM - fm) < WGM ? (nM - fm) : WGM;
        u.pm = fm + ((wgid % nig) % gsz); u.pn = (wgid % nig) / gsz; u.ui = i; return true;
    }
};

__device__ __forceinline__ unsigned cvt_pk_bf16(float lo, float hi) { unsigned r; asm volatile("v_cvt_pk_bf16_f32 %0, %1, %2" : "=v"(r) : "v"(lo), "v"(hi)); return r; }
__device__ __forceinline__ u32x4 pack8(const f32x4 a, const f32x4 b) { u32x4 w; w.x = cvt_pk_bf16(a[0], a[1]); w.y = cvt_pk_bf16(a[2], a[3]); w.z = cvt_pk_bf16(b[0], b[1]); w.w = cvt_pk_bf16(b[2], b[3]); return w; }
__device__ __forceinline__ u32x2 pack4(const f32x4 a) { u32x2 w; w.x = cvt_pk_bf16(a[0], a[1]); w.y = cvt_pk_bf16(a[2], a[3]); return w; }

template <class E, class = void> struct PermA { static constexpr bool v = false; };
template <class E> struct PermA<E, decltype((void)E::PERMA)> { static constexpr bool v = E::PERMA; };
template <class Epi, class Sched, bool ALIGN_EPI>
__device__ __forceinline__ void gemm_phase(PG8_LAS unsigned char* lds, PG8_LAS unsigned char* lds_epi, const Geom g, const Sched& S, const Epi& E) {
    int tid = threadIdx.x; asm volatile("" : "+v"(tid));
    const int wid = __builtin_amdgcn_readfirstlane(tid >> 6), lane = tid & 63, wr = wid >> 2, wc = wid & 3, fr = lane & 15, fq = lane >> 4;
    const int K = g.K, nt = K / BK;
    unsigned voffA[2], voffB[2];
#pragma unroll
    for (int i = 0; i < 2; ++i) { int R, C; stage_rc(tid * 16 + i * 8192, R, C); const int Rb = Epi::PERM ? ((R & ~31) + perm32(R & 31)) : R;
        const int Ra = PermA<Epi>::v ? ((R & ~63) + 4 * (R & 15) + ((R >> 4) & 3)) : R;
        voffA[i] = (unsigned)Ra * g.rsA + (unsigned)C * 2u; voffB[i] = (unsigned)Rb * g.rsB + (unsigned)C * 2u; }
    const size_t kstep = (size_t)(BK * 2);
    const size_t hsA = g.hsA, hsB = g.hsB;
    const unsigned ldsw = (unsigned)wid * 1024u;
    const int aoff = lds_byte(wr * 64 + fr, fq * 8), boff = lds_byte(wc * 32 + fr, fq * 8);
#define PG8_SA(b, h) (((b) * 2 + (h)) * HTB)
#define PG8_SB(b, h) ((4 + (b) * 2 + (h)) * HTB)
#define PG8_STAGE(bufoff, gbase, voff) do { _Pragma("unroll") for (int _i = 0; _i < 2; ++_i) \
        __builtin_amdgcn_global_load_lds((const unsigned*)((const char*)(gbase) + (voff)[_i]), (PG8_LAS unsigned*)(lds + (bufoff) + ldsw + _i * 8192), 16, 0, 0); } while (0)
#define PG8_LDA(dst, b, h) do { _Pragma("unroll") for (int m = 0; m < 4; ++m) _Pragma("unroll") for (int k = 0; k < 2; ++k) dst[m][k] = *(const PG8_LAS bf16x8*)(lds + PG8_SA(b, h) + aoff + m * 2048 + k * 1024); } while (0)
#define PG8_LDB(dst, b, h) do { _Pragma("unroll") for (int n = 0; n < 2; ++n) _Pragma("unroll") for (int k = 0; k < 2; ++k) dst[n][k] = *(const PG8_LAS bf16x8*)(lds + PG8_SB(b, h) + boff + n * 2048 + k * 1024); } while (0)
#define PG8_MMA(ai, bj, At, Bt) do { __builtin_amdgcn_s_setprio(1); _Pragma("unroll") for (int m = 0; m < 4; ++m) _Pragma("unroll") for (int n = 0; n < 2; ++n) _Pragma("unroll") for (int k = 0; k < 2; ++k) \
        acc[ai][bj][m][n] = __builtin_amdgcn_mfma_f32_16x16x32_bf16(Bt[n][k], At[m][k], acc[ai][bj][m][n], 0, 0, 0); __builtin_amdgcn_s_setprio(0); } while (0)
#define PG8_WAIT_V(n) asm volatile("s_waitcnt vmcnt(" #n ")" ::: "memory")
#define PG8_WAIT_L(n) asm volatile("s_waitcnt lgkmcnt(" #n ")" ::: "memory")
#define PG8_BAR __builtin_amdgcn_s_barrier()
#define PG8_SCHED __builtin_amdgcn_sched_barrier(0)
    Unit cur, nxt; int ui = 0;
    if (!S.next(0, cur)) return;
    f32x4 acc[2][2][4][2];
#pragma unroll
    for (int a = 0; a < 2; ++a)
#pragma unroll
        for (int b = 0; b < 2; ++b)
#pragma unroll
            for (int m = 0; m < 4; ++m)
#pragma unroll
                for (int n = 0; n < 2; ++n) acc[a][b][m][n] = (f32x4){0.f, 0.f, 0.f, 0.f};
    bf16x8 At[4][2], B0[2][2], B1[2][2];
    typename Epi::Pre pre;
    const char* cA = S.a_base(cur); const char* cB = S.b_base(cur);
    PG8_STAGE(PG8_SB(0, 0), cB, voffB); PG8_STAGE(PG8_SB(0, 1), cB + hsB, voffB); PG8_STAGE(PG8_SA(0, 0), cA, voffA); PG8_STAGE(PG8_SA(0, 1), cA + hsA, voffA);
    if (wr == 1) PG8_BAR;
    PG8_WAIT_V(2); PG8_BAR;
    PG8_STAGE(PG8_SB(1, 0), cB + kstep, voffB); PG8_STAGE(PG8_SA(1, 0), cA + kstep, voffA); PG8_STAGE(PG8_SB(1, 1), cB + hsB + kstep, voffB);
    PG8_WAIT_V(6); PG8_BAR;
    for (;;) {
        const bool has_next = S.next(ui + 1, nxt);
        E.unit_begin(cur, lds_epi, wid, lane);
        const char* nA = has_next ? S.a_base(nxt) : cA; const char* nB = has_next ? S.b_base(nxt) : cB;
#pragma unroll 1
        for (int t = 0; t < nt; t += 2) {
            const bool last = (t == nt - 2);
            const char* a1 = cA + (size_t)(t + 1) * kstep;
            const char* a2 = last ? nA : cA + (size_t)(t + 2) * kstep; const char* b2 = last ? nB : cB + (size_t)(t + 2) * kstep;
            const char* a3 = a2 + kstep; const char* b3 = b2 + kstep;
            if constexpr (Epi::MIDK) { if (t == Epi::MIDK_T) E.midk(acc, cur, wr, wc, fr, fq); }
            if (last) E.prefetch(pre, cur, wr, wc, fr, fq, lds_epi, wid, lane);
            PG8_LDB(B0, 0, 0); PG8_LDB(B1, 0, 1); PG8_SCHED; PG8_LDA(At, 0, 0); PG8_STAGE(PG8_SA(1, 1), a1 + hsA, voffA);
            PG8_WAIT_V(8); PG8_WAIT_L(0); PG8_BAR; PG8_MMA(0, 0, At, B0); PG8_MMA(0, 1, At, B1); PG8_BAR; PG8_SCHED;
            PG8_LDA(At, 0, 1); PG8_STAGE(PG8_SB(0, 0), b2, voffB); PG8_STAGE(PG8_SB(0, 1), b2 + hsB, voffB); PG8_STAGE(PG8_SA(0, 0), a2, voffA);
            PG8_WAIT_V(8); PG8_WAIT_L(0); PG8_BAR; PG8_MMA(1, 0, At, B0); PG8_MMA(1, 1, At, B1); PG8_BAR; PG8_SCHED;
            PG8_LDB(B0, 1, 0); PG8_LDB(B1, 1, 1); PG8_SCHED; PG8_LDA(At, 1, 0); PG8_STAGE(PG8_SA(0, 1), a2 + hsA, voffA);
            PG8_WAIT_V(8); PG8_WAIT_L(0); PG8_BAR; PG8_MMA(0, 0, At, B0); PG8_MMA(0, 1, At, B1); PG8_BAR; PG8_SCHED;
            PG8_LDA(At, 1, 1); PG8_STAGE(PG8_SB(1, 0), b3, voffB); PG8_STAGE(PG8_SB(1, 1), b3 + hsB, voffB); PG8_STAGE(PG8_SA(1, 0), a3, voffA);
            PG8_WAIT_V(8); PG8_WAIT_L(0); PG8_BAR; PG8_MMA(1, 0, At, B0); PG8_MMA(1, 1, At, B1); PG8_BAR; PG8_SCHED;
        }
        if constexpr (ALIGN_EPI) { if (wr == 0) PG8_BAR; }
        E(acc, pre, cur, wr, wc, fr, fq, lds_epi);
        if (!has_next) break;
#pragma unroll
        for (int a = 0; a < 2; ++a)
#pragma unroll
            for (int b = 0; b < 2; ++b)
#pragma unroll
                for (int m = 0; m < 4; ++m)
#pragma unroll
                    for (int n = 0; n < 2; ++n) acc[a][b][m][n] = (f32x4){0.f, 0.f, 0.f, 0.f};
        cur = nxt; cA = nA; cB = nB; ++ui;
        if constexpr (ALIGN_EPI) { if (wr == 1) PG8_BAR; }
    }
    PG8_WAIT_V(0);
    if constexpr (!ALIGN_EPI) { if (wr == 0) PG8_BAR; }
    PG8_BAR;
#undef PG8_SA
#undef PG8_SB
#undef PG8_STAGE
#undef PG8_LDA
#undef PG8_LDB
#undef PG8_MMA
#undef PG8_WAIT_V
#undef PG8_WAIT_L
#undef PG8_BAR
#undef PG8_SCHED
}
}
constexpr int D = 1024, SEQ = 16384, NSEQ = 3, T = NSEQ * SEQ, DFF = 2816, PLE = 256, INW = 1280;
constexpr int XPAD = 16640;
constexpr int UP_TILES = 65;
constexpr float EPS = 1e-6f;
constexpr float LOG2E = 1.4426950408889634f;
constexpr float QSCALE = 0.125f * LOG2E;

namespace pg8 {
struct SchedPlain {
    TileOrder o; const char* A; const char* B; size_t tA, tB;
    __device__ __forceinline__ bool next(int i, Unit& u) const { return o.next(i, u); }
    __device__ __forceinline__ const char* a_base(const Unit& u) const { return A + (size_t)u.pm * tA; }
    __device__ __forceinline__ const char* b_base(const Unit& u) const { return B + (size_t)u.pn * tB; }
};
struct SchedTokGather {
    TileOrder o; const char* A; const char* HB; size_t tA;
    __device__ __forceinline__ bool next(int i, Unit& u) const { return o.next(i, u); }
    __device__ __forceinline__ const char* a_base(const Unit& u) const { return A + (size_t)u.pm * tA; }
    __device__ __forceinline__ const char* b_base(const Unit& u) const { return HB + ((size_t)(u.pn >> 6) * SEQ + 2 * (u.pn & 63)) * (D * 2); }
};
struct SchedHalo {
    TileOrder o; const char* X1B; const char* B; size_t tB;
    __device__ __forceinline__ bool next(int i, Unit& u) const { return o.next(i, u); }
    __device__ __forceinline__ const char* a_base(const Unit& u) const { const int s = u.pm / UP_TILES, ti = u.pm % UP_TILES; return X1B + ((size_t)s * XPAD + 254 * ti) * (D * 2); }
    __device__ __forceinline__ const char* b_base(const Unit& u) const { return B + (size_t)u.pn * tB; }
};

struct SchedPad {
    TileOrder o; const char* XB; const char* B; size_t tB;
    __device__ __forceinline__ bool next(int i, Unit& u) const { return o.next(i, u); }
    __device__ __forceinline__ const char* a_base(const Unit& u) const { return XB + ((size_t)(u.pm >> 6) * XPAD + 1 + (size_t)(u.pm & 63) * 256) * (D * 2); }
    __device__ __forceinline__ const char* b_base(const Unit& u) const { return B + (size_t)u.pn * tB; }
};

typedef f32x4 AccT[2][2][4][2];
__device__ __forceinline__ float sum4sq(const f32x4 v) { return (v[0] * v[0] + v[1] * v[1]) + (v[2] * v[2] + v[3] * v[3]); }
__device__ __forceinline__ float red_fq(float s) { s += __shfl_xor(s, 16); s += __shfl_xor(s, 32); return s; }
__device__ __forceinline__ float rsq(float ss, float inv_n) { return 1.0f / sqrtf(ss * inv_n + EPS); }

struct EpiQKV {
    static constexpr bool PERM = true, MIDK = false; static constexpr int MIDK_T = 0;
    bf16_t* MIX; bf16_t* KB; bf16_t* VB; const float* qg; const float* kg; const float* ropeC; const float* ropeS;
    __device__ __forceinline__ void midk(AccT&, const Unit&, int, int, int, int) const {}
    struct Pre {};
    __device__ __forceinline__ void unit_begin(const Unit&, PG8_LAS unsigned char*, int, int) const {}
    __device__ __forceinline__ void prefetch(Pre&, const Unit& u, int, int, int, int, PG8_LAS unsigned char* lds_epi, int wid, int lane) const {
        asm volatile("" : "+v"(lane));
        const int pos0 = (u.pm * BM) & (SEQ - 1);
#pragma unroll
        for (int j = 0; j < 2; ++j) { const int i = 2 * wid + j, tbl = i >> 3, chunk = i & 7;
            __builtin_amdgcn_global_load_lds((const unsigned*)((tbl ? ropeS : ropeC) + pos0 * 8 + chunk * 256 + lane * 4), (PG8_LAS unsigned*)(lds_epi + tbl * 8192 + chunk * 1024), 16, 0, 0); }
    }
    __device__ __forceinline__ void operator()(AccT& acc, Pre& pre, const Unit& u, int wr, int wc, int fr, int fq, PG8_LAS unsigned char* lds_epi) const {
        const PG8_LAS float* ropeCl = (const PG8_LAS float*)lds_epi; const PG8_LAS float* ropeSl = (const PG8_LAS float*)(lds_epi + 8192);
        const int hh = u.pn * 4 + wc; const bool isq = hh < 8, nrm = hh < 10;
        f32x4 gn[2][2];
#pragma unroll
        for (int bj = 0; bj < 2; ++bj)
#pragma unroll
            for (int n = 0; n < 2; ++n) { gn[bj][n] = (f32x4){1.f, 1.f, 1.f, 1.f};
                if (nrm) { gn[bj][n] = *(const f32x4*)((isq ? qg : kg) + 32 * bj + 8 * fq + 4 * n); if (isq) gn[bj][n] = gn[bj][n] * QSCALE; } }
        bf16_t* dst; int pitch;
        if (isq) { dst = MIX + hh * 64; pitch = D; } else if (nrm) { dst = KB + (hh - 8) * 64; pitch = 128; } else { dst = VB + (hh - 10) * 64; pitch = 128; }
#pragma unroll
        for (int aim = 0; aim < 4; ++aim) {
            const int ai = aim >> 1;
            f32x4 cs[4][2], sn[4][2];
            if (nrm) {
#pragma unroll
                for (int m = 2 * (aim & 1); m < 2 * (aim & 1) + 2; ++m) { const int rl = ai * HALF + wr * 64 + m * 16 + fr;
                    cs[m][0] = *(const PG8_LAS f32x4*)(ropeCl + rl * 8); cs[m][1] = *(const PG8_LAS f32x4*)(ropeCl + rl * 8 + 4);
                    sn[m][0] = *(const PG8_LAS f32x4*)(ropeSl + rl * 8); sn[m][1] = *(const PG8_LAS f32x4*)(ropeSl + rl * 8 + 4); }
            }
#pragma unroll
            for (int m = 2 * (aim & 1); m < 2 * (aim & 1) + 2; ++m) {
                const int row = u.pm * BM + ai * HALF + wr * 64 + m * 16 + fr;
                f32x4 v[2][2];
#pragma unroll
                for (int bj = 0; bj < 2; ++bj)
#pragma unroll
                    for (int n = 0; n < 2; ++n) v[bj][n] = acc[ai][bj][m][n];
                if (nrm) {
                    float ss = (sum4sq(v[0][0]) + sum4sq(v[0][1])) + (sum4sq(v[1][0]) + sum4sq(v[1][1]));
                    ss = red_fq(ss);
                    const float rstd = rsq(ss, 1.0f / 64.0f);
#pragma unroll
                    for (int bj = 0; bj < 2; ++bj)
#pragma unroll
                        for (int n = 0; n < 2; ++n) v[bj][n] = v[bj][n] * rstd * gn[bj][n];
#pragma unroll
                    for (int n = 0; n < 2; ++n)
#pragma unroll
                        for (int i = 0; i < 4; ++i) {
                            const float own = v[0][n][i], oth = __shfl_xor(own, 16);
                            const float r0 = own * cs[m][n][i] - oth * sn[m][n][i], r1 = own * cs[m][n][i] + oth * sn[m][n][i];
                            v[0][n][i] = fq == 0 ? r0 : (fq == 1 ? r1 : own);
                        }
                }
#pragma unroll
                for (int bj = 0; bj < 2; ++bj) *(u32x4*)(dst + (size_t)row * pitch + 32 * bj + 8 * fq) = pack8(v[bj][0], v[bj][1]);
            }
        }
    }
};

struct EpiAB {
    static constexpr bool PERM = true, MIDK = false; static constexpr int MIDK_T = 0;
    bf16_t* W1;
    __device__ __forceinline__ void midk(AccT&, const Unit&, int, int, int, int) const {}
    struct Pre {};
    __device__ __forceinline__ void unit_begin(const Unit&, PG8_LAS unsigned char*, int, int) const {}
    __device__ __forceinline__ void prefetch(Pre&, const Unit&, int, int, int, int, PG8_LAS unsigned char*, int, int) const {}
    __device__ __forceinline__ void operator()(AccT& acc, Pre& pre, const Unit& u, int wr, int wc, int fr, int fq, PG8_LAS unsigned char*) const {
        const int b = u.pn >> 6, j2 = u.pn & 63;
#pragma unroll
        for (int ai = 0; ai < 2; ++ai)
#pragma unroll
            for (int m = 0; m < 4; ++m) {
                const int r = u.pm * BM + ai * HALF + wr * 64 + m * 16 + fr, part = r >> 9, e = r & 511;
#pragma unroll
                for (int bj = 0; bj < 2; ++bj) {
                    const int n2 = 2 * j2 + bj;
                    bf16_t* dst = W1 + ((((size_t)(b * 512 + e) * 128 + n2) * 2 + part) * 128 + 32 * wc + 8 * fq);
                    *(u32x4*)dst = pack8(acc[ai][bj][m][0], acc[ai][bj][m][1]);
                }
            }
    }
};

struct EpiPle {
    static constexpr bool PERM = true, MIDK = false; static constexpr int MIDK_T = 0;
    bf16_t* ER; float* ssq;
    __device__ __forceinline__ void midk(AccT&, const Unit&, int, int, int, int) const {}
    struct Pre {};
    __device__ __forceinline__ void unit_begin(const Unit&, PG8_LAS unsigned char*, int, int) const {}
    __device__ __forceinline__ void prefetch(Pre&, const Unit&, int, int, int, int, PG8_LAS unsigned char*, int, int) const {}
    __device__ __forceinline__ void operator()(AccT& acc, Pre& pre, const Unit& u, int wr, int wc, int fr, int fq, PG8_LAS unsigned char*) const {
#pragma unroll
        for (int ai = 0; ai < 2; ++ai)
#pragma unroll
            for (int m = 0; m < 4; ++m) {
                const int row = u.pm * BM + ai * HALF + wr * 64 + m * 16 + fr;
                float s = (sum4sq(acc[ai][0][m][0]) + sum4sq(acc[ai][0][m][1])) + (sum4sq(acc[ai][1][m][0]) + sum4sq(acc[ai][1][m][1]));
                s = red_fq(s);
                if (fq == 0) ssq[(size_t)row * 16 + u.pn * 4 + wc] = s;
#pragma unroll
                for (int bj = 0; bj < 2; ++bj) *(u32x4*)(ER + (size_t)row * D + u.pn * BM + bj * HALF + wc * 32 + fq * 8) = pack8(acc[ai][bj][m][0], acc[ai][bj][m][1]);
            }
    }
};

struct EpiS1 {
    static constexpr bool PERM = true, MIDK = false; static constexpr int MIDK_T = 0;
    bf16_t* ZB; const float* twc; const float* tws;
    __device__ __forceinline__ void midk(AccT&, const Unit&, int, int, int, int) const {}
    struct Pre {};
    __device__ __forceinline__ void unit_begin(const Unit&, PG8_LAS unsigned char*, int, int) const {}
    __device__ __forceinline__ void prefetch(Pre&, const Unit&, int, int, int, int, PG8_LAS unsigned char*, int, int) const {}
    __device__ __forceinline__ void operator()(AccT& acc, Pre& pre, const Unit& u, int wr, int wc, int fr, int fq, PG8_LAS unsigned char*) const {
        const int b = u.pn >> 8, e0 = 2 * (u.pn & 255);
        f32x4 c[4][2], s[4][2];
#pragma unroll
        for (int m = 0; m < 4; ++m)
#pragma unroll
            for (int n = 0; n < 2; ++n) { const int k1 = wr * 64 + m * 16 + fr; c[m][n] = *(const f32x4*)(twc + k1 * 128 + 32 * wc + 8 * fq + 4 * n); s[m][n] = *(const f32x4*)(tws + k1 * 128 + 32 * wc + 8 * fq + 4 * n); }
#pragma unroll
        for (int m = 0; m < 4; ++m) {
            const int k1 = wr * 64 + m * 16 + fr;
#pragma unroll
            for (int bj = 0; bj < 2; ++bj) {
                f32x4 zr[2], zi[2];
#pragma unroll
                for (int n = 0; n < 2; ++n) { const f32x4 yr = acc[0][bj][m][n], yi = acc[1][bj][m][n]; zr[n] = yr * c[m][n] + yi * s[m][n]; zi[n] = yi * c[m][n] - yr * s[m][n]; }
                bf16_t* dst = ZB + ((((size_t)(b * 128 + k1) * 512 + (e0 + bj)) * 2) * 128 + 32 * wc + 8 * fq);
                *(u32x4*)dst = pack8(zr[0], zr[1]); *(u32x4*)(dst + 128) = pack8(zi[0], zi[1]);
            }
        }
    }
};

struct EpiS2 {
    static constexpr bool PERM = true, MIDK = false; static constexpr int MIDK_T = 0;
    bf16_t* MIX; float* ssq;
    __device__ __forceinline__ void midk(AccT&, const Unit&, int, int, int, int) const {}
    struct Pre {};
    __device__ __forceinline__ void unit_begin(const Unit&, PG8_LAS unsigned char*, int, int) const {}
    __device__ __forceinline__ void prefetch(Pre&, const Unit&, int, int, int, int, PG8_LAS unsigned char*, int, int) const {}
    __device__ __forceinline__ void operator()(AccT& acc, Pre& pre, const Unit& u, int wr, int wc, int fr, int fq, PG8_LAS unsigned char*) const {
        const int eh = u.pn & 1, k1 = (u.pn >> 1) & 127, b = u.pn >> 8;
#pragma unroll
        for (int m = 0; m < 4; ++m) {
            const int k2 = wr * 64 + m * 16 + fr; const size_t tok = (size_t)b * SEQ + k1 + 128 * k2;
            float s = (sum4sq(acc[0][0][m][0]) + sum4sq(acc[0][0][m][1])) + (sum4sq(acc[0][1][m][0]) + sum4sq(acc[0][1][m][1]));
            s = red_fq(s);
            if (fq == 0) ssq[tok * 8 + eh * 4 + wc] = s;
#pragma unroll
            for (int bj = 0; bj < 2; ++bj) *(u32x4*)(MIX + tok * D + 512 + eh * 256 + bj * HALF + wc * 32 + fq * 8) = pack8(acc[0][bj][m][0], acc[0][bj][m][1]);
        }
    }
};

struct EpiOut {
    static constexpr bool PERM = true, MIDK = true; static constexpr int MIDK_T = 8;
    const float* xp; const float* xs; bf16_t* X1B; float* ssq_x1; const PG8_LAS float* tab; PG8_LAS float* red;
    struct Pre {};
    __device__ __forceinline__ void unit_begin(const Unit&, PG8_LAS unsigned char*, int, int) const {}
    __device__ __forceinline__ void prefetch(Pre&, const Unit&, int, int, int, int, PG8_LAS unsigned char*, int, int) const {}
    __device__ __forceinline__ void midk(AccT& acc, const Unit& u, int wr, int wc, int fr, int fq) const {
#pragma unroll
        for (int ai = 0; ai < 2; ++ai)
#pragma unroll
            for (int m = 0; m < 4; ++m) {
                const float ratio = tab[(u.ui * 256 + ai * HALF + wr * 64 + m * 16 + fr) * 2];
#pragma unroll
                for (int bj = 0; bj < 2; ++bj)
#pragma unroll
                    for (int n = 0; n < 2; ++n) acc[ai][bj][m][n] = acc[ai][bj][m][n] * ratio;
            }
    }
    __device__ __forceinline__ void operator()(AccT& acc, Pre& pre, const Unit& u, int wr, int wc, int fr, int fq, PG8_LAS unsigned char*) const {
        f32x4 xb[2][2][2];
#define EO_LOADQ(q) do { _Pragma("unroll") for (int mm = 0; mm < 2; ++mm) { const int row_ = u.pm * BM + ((q) >> 1) * HALF + wr * 64 + (2 * ((q) & 1) + mm) * 16 + fr; \
            const float* xrow_ = row_ < 2 * SEQ ? xp + (size_t)row_ * D : xs + (size_t)(row_ - 2 * SEQ) * D; \
            _Pragma("unroll") for (int bj = 0; bj < 2; ++bj) _Pragma("unroll") for (int n = 0; n < 2; ++n) xb[mm][bj][n] = *(const f32x4*)(xrow_ + u.pn * BM + bj * HALF + wc * 32 + fq * 8 + n * 4); } } while (0)
#define EO_MATHQ(q) do { _Pragma("unroll") for (int mm = 0; mm < 2; ++mm) { const int ai_ = (q) >> 1, m_ = 2 * ((q) & 1) + mm; const float rf = tab[(u.ui * 256 + ai_ * HALF + wr * 64 + m_ * 16 + fr) * 2 + 1]; \
            _Pragma("unroll") for (int bj = 0; bj < 2; ++bj) _Pragma("unroll") for (int n = 0; n < 2; ++n) acc[ai_][bj][m_][n] = xb[mm][bj][n] + acc[ai_][bj][m_][n] * rf; } \
            asm volatile("" ::: "memory"); } while (0)
#define EO_STOREQ(q) do { _Pragma("unroll") for (int mm = 0; mm < 2; ++mm) { const int ai_ = (q) >> 1, m_ = 2 * ((q) & 1) + mm; const int rl = ai_ * HALF + wr * 64 + m_ * 16 + fr, row = u.pm * BM + rl; \
            const size_t prow = (size_t)(row >> 14) * XPAD + 1 + (row & (SEQ - 1)); float s = 0.f; \
            _Pragma("unroll") for (int bj = 0; bj < 2; ++bj) { const f32x4 a = acc[ai_][bj][m_][0], b = acc[ai_][bj][m_][1]; \
                *(u32x4*)(X1B + prow * D + u.pn * BM + bj * HALF + wc * 32 + fq * 8) = pack8(a, b); s += sum4sq(a) + sum4sq(b); } \
            s = red_fq(s); if (fq == 0) red[wc * 256 + rl] = s; } } while (0)
        EO_LOADQ(0); EO_MATHQ(0);
        EO_LOADQ(1); EO_STOREQ(0); EO_MATHQ(1);
        EO_LOADQ(2); EO_STOREQ(1); EO_MATHQ(2);
        EO_LOADQ(3); EO_STOREQ(2); EO_MATHQ(3);
        EO_STOREQ(3);
#undef EO_LOADQ
#undef EO_MATHQ
#undef EO_STOREQ
        asm volatile("s_waitcnt lgkmcnt(0)" ::: "memory"); __builtin_amdgcn_s_barrier(); asm volatile("" ::: "memory");
        const int tid = threadIdx.x;
        if (tid < 256) ssq_x1[((size_t)u.pm * BM + tid) * 4 + u.pn] = (red[tid] + red[256 + tid]) + (red[512 + tid] + red[768 + tid]);
    }
};


template <int CTRL, bool BC> __device__ __forceinline__ float dpp_mov(float oldv, float src) {
    return __builtin_bit_cast(float, __builtin_amdgcn_update_dpp(__builtin_bit_cast(int, oldv), __builtin_bit_cast(int, src), CTRL, 0xF, 0xF, BC));
}
struct EpiUp {
    static constexpr bool PERM = true, MIDK = false, PERMA = true; static constexpr int MIDK_T = 0;
    const float* cw; const float* cb; const float* ssq_x1; bf16_t* ACT;
    static constexpr int OFF_SSQ = 8192, OFF_PAR = 12288;
    struct Pre {};
    __device__ __forceinline__ void midk(AccT&, const Unit&, int, int, int, int) const {}
    __device__ __forceinline__ void prefetch(Pre&, const Unit&, int, int, int, int, PG8_LAS unsigned char*, int, int) const {}
    __device__ __forceinline__ void unit_begin(const Unit& u, PG8_LAS unsigned char* lds_epi, int wid, int lane) const {
        const float* src; unsigned dst;
        if (wid < 4) { const float* arr = wid < 3 ? cw + (size_t)wid * 2 * DFF : cb; src = arr + (lane >> 5) * DFF + u.pn * 128 + (lane & 31) * 4; dst = OFF_PAR + (u.ui & 1) * 4096 + wid * 1024; }
        else { const int sq = u.pm / UP_TILES, ti = u.pm % UP_TILES; const unsigned tk1 = (unsigned)(sq * SEQ + 254 * ti + (wid - 4) * 64 + lane);
            src = (const float*)((const char*)(ssq_x1 - 4) + tk1 * 16u); dst = OFF_SSQ + (wid - 4) * 1024; }
        __builtin_amdgcn_global_load_lds((const unsigned*)src, (PG8_LAS unsigned*)(lds_epi + dst), 16, 0, 0);
    }
    __device__ __forceinline__ void operator()(AccT& acc, Pre&, const Unit& u, int wr, int wc, int fr, int fq, PG8_LAS unsigned char* lds_epi) const {
        const int sq = u.pm / UP_TILES, ti = u.pm % UP_TILES, tok0 = 254 * ti - 1;
        PG8_LAS float* H = (PG8_LAS float*)lds_epi;
        const PG8_LAS float* SSQ = (const PG8_LAS float*)(lds_epi + OFF_SSQ);
        const PG8_LAS float* PAR = (const PG8_LAS float*)(lds_epi + OFF_PAR + (u.ui & 1) * 4096);
#pragma unroll
        for (int ai = 0; ai < 2; ++ai)
#pragma unroll
            for (int m = 0; m < 4; ++m) {
                const int rl = ai * HALF + wr * 64 + 4 * fr + m, tk = tok0 + rl;
                const f32x4 p = *(const PG8_LAS f32x4*)(SSQ + rl * 4);
                const float r2 = (tk >= 0 && tk < SEQ) ? __builtin_amdgcn_rsqf(((p[0] + p[1]) + (p[2] + p[3])) * (1.0f / 1024.0f) + EPS) : 0.f;
#pragma unroll
                for (int bj = 0; bj < 2; ++bj)
#pragma unroll
                    for (int n = 0; n < 2; ++n) acc[ai][bj][m][n] = acc[ai][bj][m][n] * r2;
            }
#pragma unroll
        for (int ai = 0; ai < 2; ++ai) {
            const int gi = 2 * ai + wr;
#pragma unroll
            for (int bj = 0; bj < 2; ++bj)
#pragma unroll
                for (int n = 0; n < 2; ++n) {
                    const int col = bj * HALF + wc * 32 + fq * 8 + n * 4;
                    if (fr == 0) *(PG8_LAS f32x4*)(H + (gi * 2 + 0) * 256 + col) = acc[ai][bj][0][n];
                    if (fr == 15) *(PG8_LAS f32x4*)(H + (gi * 2 + 1) * 256 + col) = acc[ai][bj][3][n];
                }
        }
        asm volatile("s_waitcnt lgkmcnt(0)" ::: "memory"); __builtin_amdgcn_s_barrier(); asm volatile("" ::: "memory");
        const int chl = wc * 32 + fq * 8;
#pragma unroll
        for (int ai = 0; ai < 2; ++ai) {
            const int gi = 2 * ai + wr;
            u32x2 pk[2][4];
#pragma unroll
            for (int n = 0; n < 2; ++n) {
                f32x4 w0[2], w1[2], w2[2], bb[2], hp[2], hn[2];
#pragma unroll
                for (int bj = 0; bj < 2; ++bj) {
                    const int pc = bj * 128 + chl + n * 4;
                    w0[bj] = *(const PG8_LAS f32x4*)(PAR + pc); w1[bj] = *(const PG8_LAS f32x4*)(PAR + 256 + pc); w2[bj] = *(const PG8_LAS f32x4*)(PAR + 512 + pc); bb[bj] = *(const PG8_LAS f32x4*)(PAR + 768 + pc);
                    const int col = bj * HALF + chl + n * 4;
                    hp[bj] = gi > 0 ? *(const PG8_LAS f32x4*)(H + ((gi - 1) * 2 + 1) * 256 + col) : (f32x4){0.f, 0.f, 0.f, 0.f};
                    hn[bj] = gi < 3 ? *(const PG8_LAS f32x4*)(H + ((gi + 1) * 2 + 0) * 256 + col) : (f32x4){0.f, 0.f, 0.f, 0.f};
                }
                f32x4 pv0[2], nv3[2];
#pragma unroll
                for (int bj = 0; bj < 2; ++bj)
#pragma unroll
                    for (int i = 0; i < 4; ++i) {
                        pv0[bj][i] = dpp_mov<0x111, false>(hp[bj][i], acc[ai][bj][3][n][i]);
                        nv3[bj][i] = dpp_mov<0x101, false>(hn[bj][i], acc[ai][bj][0][n][i]);
                    }
#pragma unroll
                for (int m = 0; m < 4; ++m) {
                    f32x4 hc[2];
#pragma unroll
                    for (int bj = 0; bj < 2; ++bj) {
                        const f32x4 pv = m > 0 ? acc[ai][bj][m > 0 ? m - 1 : 0][n] : pv0[bj];
                        const f32x4 nv = m < 3 ? acc[ai][bj][m < 3 ? m + 1 : 3][n] : nv3[bj];
                        hc[bj] = __builtin_elementwise_fma(pv, w0[bj], __builtin_elementwise_fma(acc[ai][bj][m][n], w1[bj], __builtin_elementwise_fma(nv, w2[bj], bb[bj])));
                    }
                    const f32x4 t = hc[0] * (-LOG2E), gu = hc[0] * hc[1];
                    f32x4 ex; ex[0] = __builtin_amdgcn_exp2f(t[0]); ex[1] = __builtin_amdgcn_exp2f(t[1]); ex[2] = __builtin_amdgcn_exp2f(t[2]); ex[3] = __builtin_amdgcn_exp2f(t[3]);
                    const f32x4 dn = ex + 1.0f;
                    f32x4 rc; rc[0] = __builtin_amdgcn_rcpf(dn[0]); rc[1] = __builtin_amdgcn_rcpf(dn[1]); rc[2] = __builtin_amdgcn_rcpf(dn[2]); rc[3] = __builtin_amdgcn_rcpf(dn[3]);
                    pk[n][m] = pack4(gu * rc);
                }
            }
#pragma unroll
            for (int m = 0; m < 4; ++m) {
                const int rl = ai * HALF + wr * 64 + 4 * fr + m, tk = tok0 + rl;
                if (rl >= 1 && rl <= 254 && tk < SEQ) { u32x4 w; w.x = pk[0][m].x; w.y = pk[0][m].y; w.z = pk[1][m].x; w.w = pk[1][m].y;
                    *(u32x4*)(ACT + ((size_t)sq * SEQ + tk) * DFF + u.pn * 128 + chl) = w; }
            }
        }
    }
};

struct EpiLite {
    static constexpr bool PERM = true, MIDK = false; static constexpr int MIDK_T = 0;
    bf16_t* O;
    __device__ __forceinline__ void midk(AccT&, const Unit&, int, int, int, int) const {}
    struct Pre {};
    __device__ __forceinline__ void unit_begin(const Unit&, PG8_LAS unsigned char*, int, int) const {}
    __device__ __forceinline__ void prefetch(Pre&, const Unit&, int, int, int, int, PG8_LAS unsigned char*, int, int) const {}
    __device__ __forceinline__ void operator()(AccT& acc, Pre& pre, const Unit& u, int wr, int wc, int fr, int fq, PG8_LAS unsigned char*) const {
#pragma unroll
        for (int ai = 0; ai < 2; ++ai)
#pragma unroll
            for (int m = 0; m < 4; ++m) {
                int row = u.pm * 254 + ai * HALF + wr * 64 + m * 16 + fr; row = row < T - 1 ? row : T - 2;
#pragma unroll
                for (int bj = 0; bj < 2; ++bj) {
#ifdef PROBE_NULL_EPI
                    const u32x4 w = pack8(acc[ai][bj][m][0], acc[ai][bj][m][1]);
                    if (w.x == 0x7fc17fc1u) *(u32x4*)(O + (size_t)row * DFF + u.pn * 128 + bj * HALF + wc * 32 + fq * 8) = w;
#else
                    *(u32x4*)(O + (size_t)row * DFF + u.pn * 128 + bj * HALF + wc * 32 + fq * 8) = pack8(acc[ai][bj][m][0], acc[ai][bj][m][1]);
#endif
                }
            }
    }
};

struct EpiDown {
    static constexpr bool PERM = true, MIDK = false; static constexpr int MIDK_T = 0;
    bf16_t* XB;
    __device__ __forceinline__ void midk(AccT&, const Unit&, int, int, int, int) const {}
    struct Pre { u32x4 x[2][2]; };
    __device__ __forceinline__ void unit_begin(const Unit&, PG8_LAS unsigned char*, int, int) const {}
#define ED_ADDR(gq, bj) (XB + ((size_t)((u.pm * BM + ((gq) >> 2) * HALF + wr * 64 + ((gq) & 3) * 16 + fr) >> 14) * XPAD + 1 + ((u.pm * BM + ((gq) >> 2) * HALF + wr * 64 + ((gq) & 3) * 16 + fr) & (SEQ - 1))) * D + u.pn * BM + (bj) * HALF + wc * 32 + fq * 8)
    __device__ __forceinline__ void prefetch(Pre& pre, const Unit& u, int wr, int wc, int fr, int fq, PG8_LAS unsigned char*, int, int) const {
#pragma unroll
        for (int gq = 0; gq < 2; ++gq)
#pragma unroll
            for (int bj = 0; bj < 2; ++bj) pre.x[gq][bj] = *(const u32x4*)ED_ADDR(gq, bj);
    }
    __device__ __forceinline__ void operator()(AccT& acc, Pre& pre, const Unit& u, int wr, int wc, int fr, int fq, PG8_LAS unsigned char*) const {
        u32x4 xb[8][2];
#pragma unroll
        for (int bj = 0; bj < 2; ++bj) { xb[0][bj] = pre.x[0][bj]; xb[1][bj] = pre.x[1][bj]; }
#pragma unroll
        for (int gq = 2; gq < 8; ++gq)
#pragma unroll
            for (int bj = 0; bj < 2; ++bj) xb[gq][bj] = *(const u32x4*)ED_ADDR(gq, bj);
#pragma unroll
        for (int gq = 0; gq < 8; ++gq) {
            const int ai = gq >> 2, m = gq & 3;
#pragma unroll
            for (int bj = 0; bj < 2; ++bj) {
                const u32x4 w = xb[gq][bj];
                const f32x4 a = {__builtin_bit_cast(float, w.x << 16), __builtin_bit_cast(float, w.x & 0xffff0000u), __builtin_bit_cast(float, w.y << 16), __builtin_bit_cast(float, w.y & 0xffff0000u)};
                const f32x4 b = {__builtin_bit_cast(float, w.z << 16), __builtin_bit_cast(float, w.z & 0xffff0000u), __builtin_bit_cast(float, w.w << 16), __builtin_bit_cast(float, w.w & 0xffff0000u)};
                *(u32x4*)ED_ADDR(gq, bj) = pack8(a + acc[ai][bj][m][0], b + acc[ai][bj][m][1]);
            }
        }
    }
#undef ED_ADDR
};

template <int MODE> struct EpiGateT {
    static constexpr bool PERM = false, MIDK = false; static constexpr int MIDK_T = 0;
    float* out; const bf16_t* X2B; const bf16_t* ER; const float* gple; const float* bg; const PG8_LAS float* tab;
    __device__ __forceinline__ void midk(AccT&, const Unit&, int, int, int, int) const {}
    struct Pre {};
    __device__ __forceinline__ void unit_begin(const Unit&, PG8_LAS unsigned char*, int, int) const {}
#define EG_ROW(gq) (u.pm * BM + ((gq) >> 2) * HALF + wr * 64 + ((gq) & 3) * 16 + fr)
#define EG_COL(bj, n) (u.pn * BM + (bj) * HALF + wc * 32 + (n) * 16 + fq * 4)
#define EG_PROW(row_) ((size_t)((row_) >> 14) * XPAD + 1 + ((row_) & (SEQ - 1)))
    __device__ __forceinline__ void prefetch(Pre&, const Unit&, int, int, int, int, PG8_LAS unsigned char*, int, int) const {}
    __device__ __forceinline__ void operator()(AccT& acc, Pre& pre, const Unit& u, int wr, int wc, int fr, int fq, PG8_LAS unsigned char*) const {
        const PG8_LAS float* bgt = tab + 1024 + u.ui * 512 + wc * 32 + fq * 4;
        u32x2 yb[4][2][2], eb[4][2][2];
#define EG_LOADH(ai) do { _Pragma("unroll") for (int m = 0; m < 4; ++m) { const int row_ = EG_ROW((ai) * 4 + m); _Pragma("unroll") for (int bj = 0; bj < 2; ++bj) _Pragma("unroll") for (int n = 0; n < 2; ++n) { \
            if (MODE != 2 && MODE != 4) { yb[m][bj][n] = *(const u32x2*)(X2B + EG_PROW(row_) * D + EG_COL(bj, n)); eb[m][bj][n] = *(const u32x2*)(ER + (size_t)row_ * D + EG_COL(bj, n)); } \
            else { yb[m][bj][n] = (u32x2){(unsigned)row_, 1u}; eb[m][bj][n] = yb[m][bj][n]; } } } } while (0)
#define EG_MATH(ai) do { _Pragma("unroll") for (int m = 0; m < 4; ++m) { const float re = tab[u.ui * 256 + (ai) * HALF + wr * 64 + m * 16 + fr]; \
            _Pragma("unroll") for (int bj = 0; bj < 2; ++bj) _Pragma("unroll") for (int n = 0; n < 2; ++n) { \
                const f32x4 bvv = *(const PG8_LAS f32x4*)(bgt + bj * HALF + 16 * n), gvv = *(const PG8_LAS f32x4*)(bgt + 256 + bj * HALF + 16 * n); \
                const u32x2 e2 = eb[m][bj][n], y2 = yb[m][bj][n]; \
                const f32x4 ev = {__builtin_bit_cast(float, e2.x << 16), __builtin_bit_cast(float, e2.x & 0xffff0000u), __builtin_bit_cast(float, e2.y << 16), __builtin_bit_cast(float, e2.y & 0xffff0000u)}; \
                f32x4 y = {__builtin_bit_cast(float, y2.x << 16), __builtin_bit_cast(float, y2.x & 0xffff0000u), __builtin_bit_cast(float, y2.y << 16), __builtin_bit_cast(float, y2.y & 0xffff0000u)}; \
                const f32x4 z = acc[ai][bj][m][n] + bvv; \
                _Pragma("unroll") for (int i = 0; i < 4; ++i) { if (MODE == 4) y[i] += z[i]; else y[i] += __builtin_amdgcn_rcpf(1.0f + __builtin_amdgcn_exp2f(-z[i] * LOG2E)) * ev[i] * re * gvv[i]; } \
                acc[ai][bj][m][n] = y; } } \
            asm volatile("" ::: "memory"); } while (0)
#define EG_STOREH(ai) do { _Pragma("unroll") for (int m = 0; m < 4; ++m) { const size_t row = (size_t)EG_ROW((ai) * 4 + m); _Pragma("unroll") for (int bj = 0; bj < 2; ++bj) _Pragma("unroll") for (int n = 0; n < 2; ++n) { \
            const f32x4 y = acc[ai][bj][m][n]; if (MODE != 1 || y[0] == 1.2345e30f) *(f32x4*)(out + row * D + EG_COL(bj, n)) = y; } } } while (0)
        EG_LOADH(0);
        EG_MATH(0);
        EG_LOADH(1);
        EG_STOREH(0);
        EG_MATH(1);
        EG_STOREH(1);
#undef EG_LOADH
#undef EG_MATH
#undef EG_STOREH
    }
#undef EG_ROW
#undef EG_COL
#undef EG_PROW
};
typedef EpiGateT<0> EpiGate;
}
#ifndef PROBE_ATT
#define PROBE_ATT 0
#endif
namespace attn {
typedef unsigned short bf16_t;
typedef short bf16x8 __attribute__((ext_vector_type(8)));
typedef short s16x4 __attribute__((ext_vector_type(4)));
typedef float f32x16 __attribute__((ext_vector_type(16)));
typedef float f32x2 __attribute__((ext_vector_type(2)));
typedef float f32x4 __attribute__((ext_vector_type(4)));
typedef unsigned u32x4 __attribute__((ext_vector_type(4)));
typedef unsigned u32x2 __attribute__((ext_vector_type(2)));
#define ATT_LAS __attribute__((address_space(3)))
constexpr int NSLOT = 6, NKEY = NSLOT * 64, KROW = 144, KS_BYTES = NKEY * KROW, VPLANE = NKEY * 64, VS_OFF = KS_BYTES, LDS_BYTES = KS_BYTES + 2 * VPLANE;
constexpr int NUNITS = NSEQ * 2 * (SEQ / 64);
__device__ __forceinline__ int crow(int r, int hi) { return (r & 3) + 8 * (r >> 2) + 4 * hi; }
__device__ __forceinline__ s16x4 vtr(const ATT_LAS unsigned char* p) { return __builtin_bit_cast(s16x4, __builtin_amdgcn_ds_read_tr16_b64_v4i16((ATT_LAS s16x4*)p)); }
__device__ __forceinline__ int slot_of(int kb6) { return kb6 >= NSLOT ? kb6 - NSLOT : kb6; }

__device__ __forceinline__ void load_blk(u32x4& rk, u32x4& rv, int uid, int kb, const pg8::bf16_t* KB, const pg8::bf16_t* VB) {
    int tid = threadIdx.x; asm volatile("" : "+v"(tid));
    const int kvh = (uid >> 8) & 1, b = uid >> 9, row = tid >> 3, ch = tid & 7;
    int k = kb * 64 + row; k = k < 0 ? 0 : (k > SEQ - 1 ? SEQ - 1 : k);
    const size_t g = ((size_t)b * SEQ + k) * 128 + kvh * 64 + ch * 8; rk = *(const u32x4*)(KB + g); rv = *(const u32x4*)(VB + g);
}
__device__ __forceinline__ void stash_blk(const u32x4& rk, const u32x4& rv, int slot, ATT_LAS unsigned char* lds) {
    int tid = threadIdx.x; asm volatile("" : "+v"(tid));
    const int row = slot * 64 + (tid >> 3), ch = tid & 7;
    *(ATT_LAS u32x4*)(lds + row * KROW + ch * 16) = rk;
    *(ATT_LAS u32x4*)(lds + VS_OFF + (ch >> 2) * VPLANE + row * 64 + (ch & 3) * 16) = rv;
}
__device__ __forceinline__ void load_q(bf16x8 (&q)[4], int uid, const pg8::bf16_t* MIX) {
    int tid = threadIdx.x; asm volatile("" : "+v"(tid));
    const int lane = tid & 63, r32 = lane & 31, hi = lane >> 5, wid = __builtin_amdgcn_readfirstlane(tid >> 6);
    const int qb = uid & 255, kvh = (uid >> 8) & 1, b = uid >> 9, hq = kvh * 4 + (wid >> 1);
    const size_t tok = (size_t)b * SEQ + qb * 64 + (wid & 1) * 32 + r32;
#pragma unroll
    for (int d0 = 0; d0 < 4; ++d0) q[d0] = *(const bf16x8*)(MIX + tok * D + hq * 64 + d0 * 16 + hi * 8);
}
constexpr int TAB_OFF = LDS_BYTES, TAB_BYTES = 3 * 4 * 64 * 16;
__device__ __forceinline__ void compute(int uid, int next_uid, const bf16x8 (&qf)[4], bf16x8 (&qn)[4], const u32x4& rk, const u32x4& rv, float sink2, float negM, const f32x16& cinit, pg8::bf16_t* MIX, float* ssq_a, ATT_LAS unsigned char* lds) {
    int tid = threadIdx.x; asm volatile("" : "+v"(tid));
    const int lane = tid & 63, r32 = lane & 31, hi = lane >> 5; const int wid = __builtin_amdgcn_readfirstlane(tid >> 6);
    const int qb = uid & 255, kvh = (uid >> 8) & 1, b = uid >> 9;
    const int q0 = qb * 64;
    const int st_lo = qb == 0 ? 4 : (qb == 1 ? 2 : 0), st_hi = qb == 255 ? 6 : (qb == 254 ? 8 : 10);
    const bool edge = qb < 2 || qb >= 254;
    const int base6 = (qb + 4) % NSLOT;
    const int hq = kvh * 4 + (wid >> 1), sb = wid & 1, qi = sb * 32 + r32;
    const size_t tok = (size_t)b * SEQ + q0 + qi;
    float l = hi == 0 ? __builtin_amdgcn_exp2f(sink2 + negM) : 0.f;
    f32x16 o0, o1;
#pragma unroll
    for (int r = 0; r < 16; ++r) { o0[r] = 0.f; o1[r] = 0.f; }
    const ATT_LAS unsigned char* kp = lds + r32 * KROW + hi * 16;
    const ATT_LAS unsigned char* vp = lds + VS_OFF + (4 * hi + ((lane & 15) >> 2)) * 64 + ((lane >> 4) & 1) * 32 + (lane & 3) * 8;
    const ATT_LAS unsigned char* tp = lds + TAB_OFF + lane * 16;
#pragma unroll
    for (int g = 0; g < 3; ++g) {
        f32x16 s[3];
        const int st0 = sb + 3 * g;
        int rb[3];
#pragma unroll
        for (int j = 0; j < 3; ++j) rb[j] = slot_of(base6 + ((st0 + j) >> 1)) * 64 + ((st0 + j) & 1) * 32;
        const int jm = g == 0 ? 0 : (g == 2 ? 2 : -1);
        if (jm >= 0) {
            const bool in = st0 + jm >= st_lo && st0 + jm < st_hi;
            const ATT_LAS unsigned char* tq = tp + (in ? (g == 2 ? 4096 : 0) : 8192);
#pragma unroll
            for (int r4 = 0; r4 < 4; ++r4) { const f32x4 t = *(const ATT_LAS f32x4*)(tq + r4 * 1024); s[jm][4 * r4] = t[0]; s[jm][4 * r4 + 1] = t[1]; s[jm][4 * r4 + 2] = t[2]; s[jm][4 * r4 + 3] = t[3]; }
        }
#pragma unroll
        for (int d0 = 0; d0 < 4; ++d0)
#pragma unroll
            for (int j = 0; j < 3; ++j) {
                const bf16x8 kf = *(const ATT_LAS bf16x8*)(kp + rb[j] * KROW + d0 * 32);
                s[j] = __builtin_amdgcn_mfma_f32_32x32x16_bf16(kf, qf[d0], (d0 == 0 && j != jm) ? cinit : s[j], 0, 0, 0);
            }
        if (edge) {
#pragma unroll
            for (int j = 0; j < 3; ++j)
                if (j != jm && !(st0 + j >= st_lo && st0 + j < st_hi)) {
#pragma unroll
                    for (int r = 0; r < 16; ++r) s[j][r] = -1e30f;
                }
        }
        if (g == 2) load_q(qn, next_uid, MIX);
        f32x2 ps = (f32x2){0.f, 0.f};
#pragma unroll
        for (int j = 0; j < 3; ++j)
#pragma unroll
            for (int r = 0; r < 16; r += 2) { s[j][r] = __builtin_amdgcn_exp2f(s[j][r]); s[j][r + 1] = __builtin_amdgcn_exp2f(s[j][r + 1]); ps += (f32x2){s[j][r], s[j][r + 1]}; }
        l += ps[0] + ps[1];
#pragma unroll
        for (int j = 0; j < 3; ++j)
#pragma unroll
            for (int ks = 0; ks < 2; ++ks) {
                u32x4 pw;
                pw.x = pg8::cvt_pk_bf16(s[j][8 * ks + 0], s[j][8 * ks + 1]); pw.y = pg8::cvt_pk_bf16(s[j][8 * ks + 2], s[j][8 * ks + 3]);
                pw.z = pg8::cvt_pk_bf16(s[j][8 * ks + 4], s[j][8 * ks + 5]); pw.w = pg8::cvt_pk_bf16(s[j][8 * ks + 6], s[j][8 * ks + 7]);
                const bf16x8 pf = __builtin_bit_cast(bf16x8, pw);
                const ATT_LAS unsigned char* vq = vp + (rb[j] + 16 * ks) * 64;
                const s16x4 a0 = vtr(vq), a1 = vtr(vq + 8 * 64), b0 = vtr(vq + VPLANE), b1 = vtr(vq + VPLANE + 8 * 64);
                const bf16x8 vf0 = (bf16x8){a0[0], a0[1], a0[2], a0[3], a1[0], a1[1], a1[2], a1[3]};
                const bf16x8 vf1 = (bf16x8){b0[0], b0[1], b0[2], b0[3], b1[0], b1[1], b1[2], b1[3]};
                o0 = __builtin_amdgcn_mfma_f32_32x32x16_bf16(vf0, pf, o0, 0, 0, 0);
                o1 = __builtin_amdgcn_mfma_f32_32x32x16_bf16(vf1, pf, o1, 0, 0, 0);
            }
        if (g == 1) stash_blk(rk, rv, slot_of(base6 + 5), lds);
        __builtin_amdgcn_sched_barrier(0);
    }
    const float ltot = l + __shfl_xor(l, 32), inv = __builtin_amdgcn_rcpf(ltot);
    float ss = 0.f;
#pragma unroll
    for (int r = 0; r < 16; ++r) { o0[r] *= inv; o1[r] *= inv; ss += o0[r] * o0[r] + o1[r] * o1[r]; }
    ss += __shfl_xor(ss, 32);
    ssq_a[tok * 8 + hq] = ss;
    pg8::bf16_t* op = MIX + tok * D + hq * 64 + 4 * hi;
#pragma unroll
    for (int rg = 0; rg < 4; ++rg) {
        u32x2 w0, w1;
        w0.x = pg8::cvt_pk_bf16(o0[4 * rg], o0[4 * rg + 1]); w0.y = pg8::cvt_pk_bf16(o0[4 * rg + 2], o0[4 * rg + 3]);
        w1.x = pg8::cvt_pk_bf16(o1[4 * rg], o1[4 * rg + 1]); w1.y = pg8::cvt_pk_bf16(o1[4 * rg + 2], o1[4 * rg + 3]);
        *(u32x2*)(op + 8 * rg) = w0; *(u32x2*)(op + 32 + 8 * rg) = w1;
    }
}
__device__ __forceinline__ void phase(int u0, int u1, pg8::bf16_t* MIX, const pg8::bf16_t* KB, const pg8::bf16_t* VB, const float* sink, const float* qg, const float* kg, float* ssq_a, ATT_LAS unsigned char* lds, unsigned long long& tacc) {
#define ATT_T(k, sgn) do { if (PROBE_ATT == (k)) { asm volatile("s_waitcnt lgkmcnt(0)" ::: "memory"); tacc sgn __builtin_amdgcn_s_memrealtime(); } } while (0)
    if (u0 >= u1) return;
    const int wq = __builtin_amdgcn_readfirstlane((int)threadIdx.x >> 6) >> 1;
#define ATT_UNI(x) __builtin_bit_cast(float, __builtin_amdgcn_readfirstlane(__builtin_bit_cast(int, (float)(x))))
    const float sk0 = ATT_UNI(sink[wq] * LOG2E), sk1 = ATT_UNI(sink[4 + wq] * LOG2E);
    float gq = fabsf(qg[threadIdx.x & 63]), gk = fabsf(kg[threadIdx.x & 63]);
#pragma unroll
    for (int o = 1; o < 64; o <<= 1) { gq = fmaxf(gq, __shfl_xor(gq, o)); gk = fmaxf(gk, __shfl_xor(gk, o)); }
    const float negM = ATT_UNI(-(64.0f * QSCALE * 1.02f) * gq * gk);
#undef ATT_UNI
    {
        const int lane = threadIdx.x & 63, r32 = lane & 31, hi = lane >> 5, w = __builtin_amdgcn_readfirstlane((int)threadIdx.x >> 6);
        const int tb = w >> 2, r4 = w & 3;
        f32x4 t;
#pragma unroll
        for (int i = 0; i < 4; ++i) { const int c = crow(4 * r4 + i, hi); t[i] = (tb == 0 ? c >= r32 : c <= r32) ? negM : -1e30f; }
        *(ATT_LAS f32x4*)(lds + TAB_OFF + tb * 4096 + r4 * 1024 + lane * 16) = t;
        if (w < 4) *(ATT_LAS f32x4*)(lds + TAB_OFF + 8192 + w * 1024 + lane * 16) = (f32x4){-1e30f, -1e30f, -1e30f, -1e30f};
    }
    f32x16 cinit;
#pragma unroll
    for (int r = 0; r < 16; ++r) cinit[r] = negM;
    int uid = u0;
#pragma unroll 1
    while (uid < u1) {
        const int run_end = (uid | 255) + 1 < u1 ? (uid | 255) + 1 : u1;
        bf16x8 qn[4];
        {
            const int qb = uid & 255, base6 = (qb + 4) % NSLOT;
            u32x4 fk[5], fv[5];
#pragma unroll
            for (int i = 0; i < 5; ++i) load_blk(fk[i], fv[i], uid, qb - 2 + i, KB, VB);
            load_q(qn, uid, MIX);
            asm volatile("s_waitcnt lgkmcnt(0)" ::: "memory"); __builtin_amdgcn_s_barrier(); asm volatile("" ::: "memory");
#pragma unroll
            for (int i = 0; i < 5; ++i) stash_blk(fk[i], fv[i], slot_of(base6 + i), lds);
            __builtin_amdgcn_s_waitcnt(0);
            __builtin_amdgcn_s_barrier(); asm volatile("" ::: "memory");
        }
#pragma unroll 1
        for (; uid < run_end; ++uid) {
            ATT_T(1, -=);
#pragma unroll
            for (int d0 = 0; d0 < 4; ++d0) asm volatile("" : "+v"(qn[d0]));
            u32x4 rk, rv; load_blk(rk, rv, uid, (uid & 255) + 3, KB, VB);
            __builtin_amdgcn_sched_barrier(0);
            bf16x8 qf[4];
#pragma unroll
            for (int d0 = 0; d0 < 4; ++d0) qf[d0] = qn[d0];
            ATT_T(2, -=);
            compute(uid, uid + 1 < u1 ? uid + 1 : uid, qf, qn, rk, rv, ((uid >> 8) & 1) ? sk1 : sk0, negM, cinit, MIX, ssq_a, lds);
            ATT_T(2, +=); ATT_T(3, -=);
            asm volatile("s_waitcnt lgkmcnt(0)" ::: "memory"); __builtin_amdgcn_s_barrier(); asm volatile("" ::: "memory");
            ATT_T(3, +=); ATT_T(1, +=);
        }
    }
}
}
constexpr int NWAVES = 8;
#ifndef MK_N_LAUNCHES
#define MK_N_LAUNCHES 1
#endif
constexpr int N_PHASES = 8;
constexpr int N_LAUNCHES = MK_N_LAUNCHES;

constexpr size_t MiB = 1u << 20;
constexpr size_t WS_CTL = 0, CTL_ZERO_BYTES = 64 * 1024;
constexpr size_t WS_ROPEC = 1 * MiB, WS_ROPES = WS_ROPEC + 512 * 1024;
constexpr size_t WS_TWC = 2 * MiB, WS_TWS = WS_TWC + 64 * 1024;
constexpr size_t WS_DFT1 = WS_TWS + 64 * 1024, WS_DFT2 = WS_DFT1 + 128 * 1024;
constexpr size_t WS_WQKV = 3 * MiB;
constexpr size_t WS_WAB = WS_WQKV + 768 * 1024 * 2;
constexpr size_t WS_WOUT = WS_WAB + 2 * MiB;
constexpr size_t WS_WUP = WS_WOUT + 2 * MiB;
constexpr size_t WS_WDOWN = WS_WUP + 11 * MiB;
constexpr size_t WS_WPLE = WS_WDOWN + (size_t)1024 * 2816 * 2;
constexpr size_t WS_WGATE = WS_WPLE + 512 * 1024;
constexpr size_t WS_WEND = WS_WGATE + 2 * MiB;
static_assert(WS_WEND <= 30 * MiB, "weights region");
constexpr size_t WS_ERAW = 30 * MiB;
constexpr size_t WS_SSQ_A = 126 * MiB, WS_SSQ_F = WS_SSQ_A + (size_t)T * 8 * 4, WS_SSQ_X1 = WS_SSQ_F + (size_t)T * 8 * 4, WS_SSQ_E = WS_SSQ_X1 + (size_t)T * 16 * 4;
static_assert(WS_SSQ_E + (size_t)T * 16 * 4 <= 136 * MiB, "ssq region");
constexpr size_t WS_R1 = 136 * MiB;
constexpr size_t WS_MIX = 234 * MiB;
constexpr size_t WS_KB = 330 * MiB, WS_VB = 342 * MiB;
constexpr size_t WS_W1 = 354 * MiB;
constexpr size_t WS_PB = 450 * MiB;
constexpr size_t WS_ACT = 234 * MiB;
constexpr size_t WS_END = 498 * MiB;
static_assert((size_t)NSEQ * XPAD * D * 2 <= 98 * MiB && WS_ACT + (size_t)T * DFF * 2 <= WS_END && WS_PB + (size_t)T * PLE * 2 <= WS_END, "d_ws map");
constexpr int CW_BAR = 4096;

constexpr int RING_OFF = 0, RING_BYTES = 131072, EPI_OFF = RING_BYTES, EPI_BYTES = 20480;
constexpr int LDSCTL_OFF = EPI_OFF + EPI_BYTES, MISC_OFF = LDSCTL_OFF + 320;
constexpr int LDS_BYTES = LDSCTL_OFF + 1024;
static_assert(attn::TAB_OFF + attn::TAB_BYTES <= RING_BYTES, "attention LDS");

#define GAS __attribute__((address_space(1)))
#define LAS __attribute__((address_space(3)))
typedef unsigned short bf16;
typedef unsigned v4u __attribute__((ext_vector_type(4)));
typedef float f32x4 __attribute__((ext_vector_type(4)));
typedef GAS unsigned gu32;
#define RLX_AGENT __ATOMIC_RELAXED, __HIP_MEMORY_SCOPE_AGENT
#define LDS_WAIT() asm volatile("s_waitcnt lgkmcnt(0)" ::: "memory")
#define VM_WAIT() asm volatile("s_waitcnt vmcnt(0)" ::: "memory")
__device__ __forceinline__ unsigned f2bf(float f) { unsigned u = __builtin_bit_cast(unsigned, f); return (u + 0x7fffu + ((u >> 16) & 1u)) >> 16; }
__device__ __forceinline__ unsigned pk2(float lo, float hi) { return f2bf(lo) | (f2bf(hi) << 16); }

#define XB_TMO      128
#define XB_XCNT(j)  (256  + 64 * (j))
#define XB_XSUB(j)  (1280 + 64 * (j))
#define XB_XGEN(j)  (2304 + 64 * (j))
#define XB_TOP      3328
#define XB_TOPGEN   3392
#define XCD_BAR_WORDS 3456
#define XB_SPIN_CAP (1u << 18)
__device__ __forceinline__ unsigned xb_ld(unsigned* p)              { return __hip_atomic_load(p, __ATOMIC_RELAXED, __HIP_MEMORY_SCOPE_AGENT); }
__device__ __forceinline__ unsigned xb_add(unsigned* p, unsigned v) { return __hip_atomic_fetch_add(p, v, __ATOMIC_RELAXED, __HIP_MEMORY_SCOPE_AGENT); }
__device__ __forceinline__ unsigned xb_xcc_id() { return (unsigned)__builtin_amdgcn_s_getreg((3 << 11) | 20) & 0xFu; }
#define XB_SPIN(cond, bar) do { unsigned _sp = 0; while (cond) { __builtin_amdgcn_s_sleep(1); \
    if ((++_sp & 255u) == 0u) { if (xb_ld(&(bar)[XB_TMO])) break; if (_sp > XB_SPIN_CAP) { atomicAdd(&(bar)[XB_TMO], 1u); break; } } } } while (0)
struct XcdBarrier { unsigned* bar; unsigned x; volatile LAS unsigned* st; };
__device__ __forceinline__ XcdBarrier xcd_barrier_post(unsigned* bar, volatile LAS unsigned* st) {
    XcdBarrier b; b.bar = bar; b.x = xb_xcc_id(); b.st = st;
    if (threadIdx.x == 0) (void)xb_add(&bar[XB_XCNT(b.x)], 1u);
    return b;
}
__device__ __forceinline__ void xcd_barrier_complete(unsigned* bar, unsigned x, unsigned& nloc, unsigned& nx) {
    const unsigned G = gridDim.x * gridDim.y * gridDim.z;
    unsigned sum, cnt, mine, sp = 0u;
    for (;;) {
        sum = 0u; cnt = 0u; mine = 0u;
#pragma unroll
        for (unsigned j = 0; j < 16; ++j) { const unsigned c = xb_ld(&bar[XB_XCNT(j)]); sum += c; cnt += (c > 0u) ? 1u : 0u; mine = (j == x) ? c : mine; }
        if (sum == G) break;
        __builtin_amdgcn_s_sleep(1);
        if ((++sp & 255u) == 0u) { if (xb_ld(&bar[XB_TMO])) break; if (sp > XB_SPIN_CAP) { atomicAdd(&bar[XB_TMO], 1u); break; } }
    }
    nloc = mine > 0u ? mine : 1u; nx = cnt > 0u ? cnt : 1u;
}
__device__ __forceinline__ void xcd_barrier(const XcdBarrier& b) {
    asm volatile("s_waitcnt vmcnt(0)" ::: "memory");
    __syncthreads();
    if (threadIdx.x == 0) {
        unsigned* bar = b.bar;
        __builtin_amdgcn_s_waitcnt(0);
        unsigned nloc = b.st[0], nx = b.st[1];
        if (nloc == 0u) { xcd_barrier_complete(bar, b.x, nloc, nx); b.st[0] = nloc; b.st[1] = nx; }
        const unsigned old = xb_add(&bar[XB_XSUB(b.x)], 1u);
        const unsigned gen = old / nloc;
        if (old + 1u == (gen + 1u) * nloc) {
            __builtin_amdgcn_fence(__ATOMIC_RELEASE, "agent");
            asm volatile("s_waitcnt vmcnt(0)" ::: "memory");
            const unsigned og = xb_add(&bar[XB_TOP], 1u);
            const unsigned tg = og / nx;
            if (og + 1u == (tg + 1u) * nx) xb_add(&bar[XB_TOPGEN], 1u);
            else XB_SPIN(xb_ld(&bar[XB_TOPGEN]) == tg, bar);
            __builtin_amdgcn_fence(__ATOMIC_ACQUIRE, "agent");
            xb_add(&bar[XB_XGEN(b.x)], 1u);
            asm volatile("s_waitcnt vmcnt(0)" ::: "memory");
        } else {
            XB_SPIN(xb_ld(&bar[XB_XGEN(b.x)]) == gen, bar);
            __builtin_amdgcn_fence(__ATOMIC_ACQUIRE, "agent");
            asm volatile("s_waitcnt vmcnt(0)" ::: "memory");
        }
    }
    __syncthreads();
}

__device__ __forceinline__ float wave_sum(float v) {
#pragma unroll
    for (int o = 1; o < 64; o <<= 1) v += __shfl_xor(v, o);
    return v;
}
struct TrItem { const float* W; const float* gk; bf16* WT; int ldw, src_n0, k0, ldt, dst_n0; };
__device__ __forceinline__ void p0_tr_load(f32x4 (&v)[8], const TrItem& t, int lane) {
    const int nq = (lane & 7) * 4;
#pragma unroll
    for (int i = 0; i < 8; ++i) { const int kk = 8 * i + (lane >> 3); v[i] = *(const f32x4*)(t.W + (size_t)(t.k0 + kk) * t.ldw + t.src_n0 + nq); }
}
__device__ __forceinline__ void p0_tr_finish(const f32x4 (&v)[8], const TrItem& t, LAS float* scr, int lane) {
    const int nq = (lane & 7) * 4;
#pragma unroll
    for (int i = 0; i < 8; ++i) { const int kk = 8 * i + (lane >> 3); f32x4 x = v[i]; if (t.gk) x = x * t.gk[t.k0 + kk]; *(LAS f32x4*)(scr + kk * 36 + nq) = x; }
    LDS_WAIT(); asm volatile("" ::: "memory");
    const int c = lane & 7;
#pragma unroll
    for (int j = 0; j < 4; ++j) { const int n = (lane >> 3) + 8 * j; const LAS float* s = scr + (8 * c) * 36 + n;
        v4u o; o.x = pk2(s[0 * 36], s[1 * 36]); o.y = pk2(s[2 * 36], s[3 * 36]); o.z = pk2(s[4 * 36], s[5 * 36]); o.w = pk2(s[6 * 36], s[7 * 36]);
        *(GAS v4u*)(t.WT + (size_t)(t.dst_n0 + n) * t.ldt + t.k0 + 8 * c) = o; }
    LDS_WAIT(); asm volatile("" ::: "memory");
}
__constant__ float c_invf[8] = {1.0f, 0.19392274474868576f, 0.03760603093086393f, 0.007292664737217109f, 0.001414213562373095f, 0.0002742481756762073f, 5.318295896944988e-05f, 1.031338537721246e-05f};

#ifndef PLE_FIRST
#define PLE_FIRST 0
#endif
#ifndef S1_FIRST
#define S1_FIRST 0
#endif
#ifndef STG
#define STG 0
#endif
__device__ __forceinline__ void stagger(int bx, int us_step) {
    const int g = (bx >> 3) & 3;
    if (STG && g && us_step) { const unsigned long long t0 = __builtin_amdgcn_s_memrealtime(), dt = (unsigned long long)(g * us_step) * 100ull;
        while (__builtin_amdgcn_s_memrealtime() - t0 < dt) __builtin_amdgcn_s_sleep(16); }
}
#ifndef STG_P1A
#define STG_P1A 6
#define STG_P1B 6
#define STG_P1C 3
#define STG_S1 4
#define STG_S2 3
#define STG_P4 8
#define STG_P5 5
#define STG_P6 14
#define STG_P7 8
#endif
struct Args { const float* in[22]; float* out; unsigned char* ws; int ph_lo, ph_hi, li, pad; };

__global__ void __launch_bounds__(NWAVES * 64, 2) mk_fwd(Args args) {
    extern __shared__ __attribute__((aligned(16))) unsigned char lds_raw[];
    LAS unsigned char* lds = (LAS unsigned char*)lds_raw;
    volatile LAS unsigned* MISC = (volatile LAS unsigned*)(lds + MISC_OFF);
    const int tid = threadIdx.x, lane = tid & 63, wave = __builtin_amdgcn_readfirstlane(tid >> 6);
    const int G = gridDim.x, bx = blockIdx.x, vcu = (G % 8 == 0) ? (bx % 8) * (G / 8) + bx / 8 : bx;
    unsigned char* ws = args.ws;
    gu32* ctl = (gu32*)(ws + WS_CTL);
    volatile LAS unsigned long long* PT = (volatile LAS unsigned long long*)(lds + LDSCTL_OFF + 512);
#define INPTR(k) ((const float*)(((unsigned long long)(unsigned)__builtin_amdgcn_readfirstlane((int)(PT[k] >> 32)) << 32) | (unsigned long long)(unsigned)__builtin_amdgcn_readfirstlane((int)(unsigned)PT[k])))
    float* out = args.out;
    float* ropeC = (float*)(ws + WS_ROPEC); float* ropeS = (float*)(ws + WS_ROPES); float* twc = (float*)(ws + WS_TWC); float* tws = (float*)(ws + WS_TWS);
    bf16 *DFT1 = (bf16*)(ws + WS_DFT1), *DFT2 = (bf16*)(ws + WS_DFT2), *WQKV = (bf16*)(ws + WS_WQKV), *WAB = (bf16*)(ws + WS_WAB), *WOUT = (bf16*)(ws + WS_WOUT), *WUP = (bf16*)(ws + WS_WUP),
         *WDOWN = (bf16*)(ws + WS_WDOWN), *WPLE = (bf16*)(ws + WS_WPLE), *WGATE = (bf16*)(ws + WS_WGATE), *ERAW = (bf16*)(ws + WS_ERAW), *HB = (bf16*)(ws + WS_R1), *ZB = (bf16*)(ws + WS_R1),
         *X1B = (bf16*)(ws + WS_R1), *X2B = (bf16*)(ws + WS_R1), *MIX = (bf16*)(ws + WS_MIX), *KB = (bf16*)(ws + WS_KB), *VB = (bf16*)(ws + WS_VB), *W1 = (bf16*)(ws + WS_W1), *PB = (bf16*)(ws + WS_PB),
         *ACT = (bf16*)(ws + WS_ACT);
    float *ssq_a = (float*)(ws + WS_SSQ_A), *ssq_f = (float*)(ws + WS_SSQ_F), *ssq_x1 = (float*)(ws + WS_SSQ_X1), *ssq_e = (float*)(ws + WS_SSQ_E);

    for (int u = tid; u < (LDS_BYTES - LDSCTL_OFF) / 4; u += NWAVES * 64) ((LAS unsigned*)(lds + LDSCTL_OFF))[u] = 0u;
    __syncthreads();
    if (tid == 0) {
#define PTW(k) PT[k] = (unsigned long long)args.in[k]
        PTW(0); PTW(1); PTW(2); PTW(3); PTW(4); PTW(5); PTW(6); PTW(7); PTW(8); PTW(9); PTW(10); PTW(11); PTW(12); PTW(13); PTW(14); PTW(15); PTW(16); PTW(17); PTW(18); PTW(19); PTW(20); PTW(21);
#undef PTW
    }
    __syncthreads();
    XcdBarrier bar; bar.bar = (unsigned*)(ctl + CW_BAR) + args.li * XCD_BAR_WORDS; bar.x = 0; bar.st = nullptr;
    if (N_LAUNCHES != N_PHASES) bar = xcd_barrier_post((unsigned*)(ctl + CW_BAR) + args.li * XCD_BAR_WORDS, MISC + 8);
#define GRID_BAR() do { if (N_LAUNCHES != N_PHASES) xcd_barrier(bar); } while (0)
    const int lo = args.ph_lo, hi = args.ph_hi;
#ifndef PROBE_SEG
#define PROBE_SEG (-1)
#endif
#ifndef PROBE_AMP
#define PROBE_AMP 4
#endif
    unsigned long long ts0 = 0, ts1 = 0, clk0 = 0, clk1 = 0, rt0 = 0, rt1 = 0;
#ifndef PROBE_SUB
#define PROBE_SUB (-1)
#endif
#define SUBSTAMP(idx) do { if (PROBE_SUB >= 0) { if ((idx) == PROBE_SUB) ts0 = __builtin_amdgcn_s_memrealtime(); if ((idx) == PROBE_SUB + 1) ts1 = __builtin_amdgcn_s_memrealtime(); } } while (0)
#define STAMP(idx) do { if (PROBE_SEG >= 0) { if ((idx) == PROBE_SEG) ts0 = __builtin_amdgcn_s_memrealtime(); if ((idx) == PROBE_SEG + 1) ts1 = __builtin_amdgcn_s_memrealtime(); } } while (0)
    STAMP(0);
#ifndef PH_MASK
#define PH_MASK 0xFF
#endif
#define IN(k) (((PH_MASK >> (k)) & 1) && lo <= (k) && (k) < hi)
#define BOTH(k) (IN(k) && IN((k) + 1))
#ifndef REP_MASK
#define REP_MASK 0
#endif
#define REPS(k) (((REP_MASK >> (k)) & 1) ? 2 : 1)
    LAS unsigned char* ring = lds + RING_OFF; LAS unsigned char* epi = lds + EPI_OFF;

    if (IN(0)) { _Pragma("unroll") for (int rep = 0; rep < REPS(0); ++rep) {
        const float *xp = INPTR(0), *xs = INPTR(1), *pp = INPTR(2), *ps = INPTR(3), *attn_norm = INPTR(4), *w_in = INPTR(5), *w_fourier = INPTR(9), *ao_norm = INPTR(10), *fo_norm = INPTR(11),
                    *w_out = INPTR(12), *ffn_norm = INPTR(13), *w_up = INPTR(14), *w_down = INPTR(17), *w_ple = INPTR(18), *w_gate = INPTR(20);
        const int gw = vcu * NWAVES + wave, NGW = G * NWAVES;
        LAS float* scr = (LAS float*)(ring + wave * 16384);
        SUBSTAMP(0);
        {
            f32x4 gv[4];
#pragma unroll
            for (int j = 0; j < 4; ++j) gv[j] = ((const GAS f32x4*)attn_norm)[lane + 64 * j];
#define HB_ROW(mrow_, q) (((mrow_) + (q) * NGW) < T ? ((mrow_) + (q) * NGW) : (mrow_))
#define HB_LOAD(V, mrow_) do { _Pragma("unroll") for (int q = 0; q < 4; ++q) { const int r = HB_ROW(mrow_, q); \
                const float* xrow = r < 2 * SEQ ? xp + (size_t)r * D : xs + (size_t)(r - 2 * SEQ) * D; \
                _Pragma("unroll") for (int j = 0; j < 4; ++j) V[q][j] = __builtin_nontemporal_load((const f32x4*)xrow + lane + 64 * j); } } while (0)
#define HB_NORM(V) do { float s[4]; _Pragma("unroll") for (int q = 0; q < 4; ++q) { s[q] = 0.f; \
                _Pragma("unroll") for (int j = 0; j < 4; ++j) s[q] += (V[q][j].x * V[q][j].x + V[q][j].y * V[q][j].y) + (V[q][j].z * V[q][j].z + V[q][j].w * V[q][j].w); } \
            _Pragma("unroll") for (int o = 1; o < 64; o <<= 1) { _Pragma("unroll") for (int q = 0; q < 4; ++q) s[q] += __shfl_xor(s[q], o); } \
            _Pragma("unroll") for (int q = 0; q < 4; ++q) { const float rstd = 1.f / sqrtf(s[q] * (1.f / D) + EPS); _Pragma("unroll") for (int j = 0; j < 4; ++j) V[q][j] = V[q][j] * rstd * gv[j]; } } while (0)
#define HB_STORE(V, mrow_) do { _Pragma("unroll") for (int q = 0; q < 4; ++q) { GAS unsigned long long* o8 = (GAS unsigned long long*)(HB + (size_t)HB_ROW(mrow_, q) * D) + lane; \
                _Pragma("unroll") for (int j = 0; j < 4; ++j) o8[64 * j] = (unsigned long long)pk2(V[q][j].x, V[q][j].y) | ((unsigned long long)pk2(V[q][j].z, V[q][j].w) << 32); } } while (0)
            if (gw < T) {
                f32x4 va[4][4], vb[4][4];
                HB_LOAD(va, gw);
                for (int mrow = gw; mrow < T; mrow += 8 * NGW) {
                    const bool h1 = mrow + 4 * NGW < T, h2 = mrow + 8 * NGW < T;
                    HB_NORM(va);
                    if (h1) HB_LOAD(vb, mrow + 4 * NGW);
                    HB_STORE(va, mrow);
                    if (h1) { HB_NORM(vb); if (h2) HB_LOAD(va, mrow + 8 * NGW); HB_STORE(vb, mrow + 4 * NGW); }
                }
            }
#undef HB_ROW
#undef HB_LOAD
#undef HB_NORM
#undef HB_STORE
        }
        SUBSTAMP(1);
        {
            constexpr size_t NCH = (size_t)T * PLE / 8; const size_t CST = (size_t)NGW * 64;
#define PB_CH(c0_, q) (((c0_) + (size_t)(q) * CST) < NCH ? ((c0_) + (size_t)(q) * CST) : (c0_))
#define PB_LOAD(A_, B_, c0_) do { _Pragma("unroll") for (int q = 0; q < 4; ++q) { const size_t e0 = PB_CH(c0_, q) * 8, row = e0 / PLE; \
                const float* src = row < (size_t)2 * SEQ ? pp + e0 : ps + (e0 - (size_t)2 * SEQ * PLE); \
                A_[q] = __builtin_nontemporal_load((const f32x4*)src); B_[q] = __builtin_nontemporal_load((const f32x4*)(src + 4)); } } while (0)
#define PB_STORE(A_, B_, c0_) do { _Pragma("unroll") for (int q = 0; q < 4; ++q) { const size_t e0 = PB_CH(c0_, q) * 8; \
                v4u o; o.x = pk2(A_[q].x, A_[q].y); o.y = pk2(A_[q].z, A_[q].w); o.z = pk2(B_[q].x, B_[q].y); o.w = pk2(B_[q].z, B_[q].w); *(v4u*)(PB + e0) = o; } } while (0)
            const size_t cfirst = (size_t)gw * 64 + lane;
            if (cfirst < NCH) {
                f32x4 a0[4], b0[4], a1[4], b1[4];
                PB_LOAD(a0, b0, cfirst);
                for (size_t c0 = cfirst; c0 < NCH; c0 += 8 * CST) {
                    const bool h1 = c0 + 4 * CST < NCH, h2 = c0 + 8 * CST < NCH;
                    if (h1) PB_LOAD(a1, b1, c0 + 4 * CST);
                    PB_STORE(a0, b0, c0);
                    if (h1) { if (h2) PB_LOAD(a0, b0, c0 + 8 * CST); PB_STORE(a1, b1, c0 + 4 * CST); }
                }
            }
#undef PB_CH
#undef PB_LOAD
#undef PB_STORE
        }
        SUBSTAMP(2);
        {
            constexpr int I_QKV = 16 * 24, I_OUT = 16 * 32, I_UP = 16 * 176, I_DOWN = 44 * 32, I_PLE = 4 * 32, I_GATE = 16 * 32;
            constexpr int NIT = I_QKV + I_OUT + I_UP + I_DOWN + I_PLE + I_GATE;
            auto decode = [&](int it) -> TrItem {
                int r = it;
                if (r < I_QKV) { const int kb = r / 24, nb = r % 24, n0 = 32 * nb, tile = n0 >> 8, p = n0 & 255, bj = p >> 7, wcc = (p >> 5) & 3;
                    return TrItem{w_in, nullptr, WQKV, INW, tile * 256 + wcc * 64 + bj * 32, 64 * kb, D, n0}; } r -= I_QKV;
                if (r < I_OUT) { const int kb = r / 32, nb = r % 32; return TrItem{w_out, kb < 8 ? ao_norm : fo_norm - 512, WOUT, D, 32 * nb, 64 * kb, D, 32 * nb}; } r -= I_OUT;
                if (r < I_UP) { const int kb = r / 176, nb = r % 176, n0 = 32 * nb, tile = n0 >> 8, p = n0 & 255, bj = p >> 7;
                    return TrItem{w_up, ffn_norm, WUP, 2 * DFF, bj * DFF + tile * 128 + (p & 127), 64 * kb, D, n0}; } r -= I_UP;
                if (r < I_DOWN) { const int kb = r / 32, nb = r % 32; return TrItem{w_down, nullptr, WDOWN, D, 32 * nb, 64 * kb, DFF, 32 * nb}; } r -= I_DOWN;
                if (r < I_PLE) { const int kb = r / 32, nb = r % 32; return TrItem{w_ple, nullptr, WPLE, D, 32 * nb, 64 * kb, PLE, 32 * nb}; } r -= I_PLE;
                { const int kb = r / 32, nb = r % 32; return TrItem{w_gate, nullptr, WGATE, D, 32 * nb, 64 * kb, D, 32 * nb}; }
            };
            if (gw < NIT) {
                f32x4 va[8], vb[8];
                TrItem cur = decode(gw); p0_tr_load(va, cur, lane);
                for (int it = gw; it < NIT; it += 2 * NGW) {
                    TrItem nx = cur; const bool h1 = it + NGW < NIT; if (h1) { nx = decode(it + NGW); p0_tr_load(vb, nx, lane); }
                    p0_tr_finish(va, cur, scr, lane);
                    const bool h2 = it + 2 * NGW < NIT; if (h2) { cur = decode(it + 2 * NGW); p0_tr_load(va, cur, lane); }
                    if (h1) p0_tr_finish(vb, nx, scr, lane);
                }
            }
        }
        SUBSTAMP(3);
        for (int idx = vcu * 512 + tid; idx < SEQ * 8; idx += G * 512) {
            const int pos = idx >> 3;
            const float ang = (float)pos * c_invf[idx & 7];
            const double a = (double)ang, rr = a - 6.283185307179586476925 * rint(a * 0.15915494309189533577);
            float sn, cs; sincospif((float)(rr * 0.31830988618379067154), &sn, &cs);
            ropeC[idx] = cs; ropeS[idx] = sn;
        }
        for (int idx = vcu * 512 + tid; idx < 128 * 128; idx += G * 512) {
            const int k1 = idx >> 7, n2 = idx & 127; float sn, cs; sincospif(2.0f * (float)(k1 * n2) / 16384.0f, &sn, &cs); twc[idx] = cs; tws[idx] = sn;
        }
        for (int idx = vcu * 512 + tid; idx < 256 * 256; idx += G * 512) {
            const int r = idx >> 8, k = idx & 255, kr = r & 127, im = r >> 7, part = k >> 7, nn = k & 127;
            float sn, cs; sincospif(2.0f * (float)((kr * nn) & 127) / 128.0f, &sn, &cs);
            const float v1 = im == 0 ? (part == 0 ? cs : -sn) : (part == 0 ? -sn : -cs);
            DFT1[idx] = (bf16)f2bf(v1);
            const float v2 = im == 0 ? (part == 0 ? cs : sn) * (1.0f / 1024.0f) : 0.f;
            DFT2[idx] = (bf16)f2bf(v2);
        }
        SUBSTAMP(4);
        __syncthreads();
        {
            LAS float* Ml = (LAS float*)ring; LAS float* Wl = Ml + 64 * 65; LAS float* Fl = Wl + 64 * 65; LAS float* tg = Fl + 64 * 65;
            for (int item = vcu; item < 256; item += G) {
                const int part = item >> 7, g = (item >> 4) & 7, k0 = 64 * (item & 15);
                if (tid < 64) { float sn, cs; sincospif(2.0f * (float)tid / 64.0f, &sn, &cs); tg[tid] = part == 0 ? cs : sn; }
#pragma unroll
                for (int i = 0; i < 8; ++i) { const int idx = tid + 512 * i, r = idx >> 6, c = idx & 63;
                    Wl[r * 65 + c] = w_in[(size_t)(k0 + r) * INW + 768 + 64 * g + c];
                    Fl[r * 65 + c] = w_fourier[(size_t)g * 4096 + idx]; }
                __syncthreads();
                { const int e = tid & 63;
#pragma unroll 1
                  for (int i = 0; i < 8; ++i) { const int c = (tid >> 6) + 8 * i; float a = 0.f;
#pragma unroll 8
                      for (int j = 0; j < 64; ++j) a += tg[(c * j) & 63] * Fl[j * 65 + e];
                      Ml[c * 65 + e] = a; } }
                __syncthreads();
                { const int e = tid >> 3, kc = (tid & 7) * 8; float a[8];
#pragma unroll
                  for (int kk = 0; kk < 8; ++kk) a[kk] = 0.f;
#pragma unroll 2
                  for (int c = 0; c < 64; ++c) { const float mv = Ml[c * 65 + e];
#pragma unroll
                      for (int kk = 0; kk < 8; ++kk) a[kk] += Wl[(kc + kk) * 65 + c] * mv; }
                  v4u o; o.x = pk2(a[0], a[1]); o.y = pk2(a[2], a[3]); o.z = pk2(a[4], a[5]); o.w = pk2(a[6], a[7]);
                  *(v4u*)(WAB + (size_t)(part * 512 + 64 * g + e) * D + k0 + kc) = o; }
                __syncthreads();
            }
        }
        __syncthreads(); }
        SUBSTAMP(5);
        if (BOTH(0)) GRID_BAR();
        SUBSTAMP(6);
    }
    STAMP(1);

    if (IN(1)) { _Pragma("unroll") for (int rep = 0; rep < REPS(1); ++rep) {
        const bool ple_first = PLE_FIRST && ((bx & 1) != 0);
#define P1C_BODY() do { pg8::SchedPlain S; S.o.init(T / 256, 4, G, bx); S.A = (const char*)PB; S.B = (const char*)WPLE; S.tA = (size_t)256 * PLE * 2; S.tB = (size_t)256 * PLE * 2; \
            const pg8::Geom g{PLE, PLE * 2, PLE * 2, 128 * PLE * 2, 128 * PLE * 2}; const pg8::EpiPle E{ERAW, ssq_e}; \
            pg8::gemm_phase<pg8::EpiPle, pg8::SchedPlain, true>(ring, epi, g, S, E); } while (0)
        if (ple_first) P1C_BODY();
        {
            pg8::SchedPlain S; S.o.init(T / 256, 3, G, bx); S.A = (const char*)HB; S.B = (const char*)WQKV; S.tA = (size_t)256 * D * 2; S.tB = (size_t)256 * D * 2;
            const pg8::Geom g{D, D * 2, D * 2, 128 * D * 2, 128 * D * 2};
            const pg8::EpiQKV E{MIX, KB, VB, INPTR(6), INPTR(7), ropeC, ropeS};
            stagger(bx, STG_P1A); pg8::gemm_phase<pg8::EpiQKV, pg8::SchedPlain, true>(ring, epi, g, S, E);
        }
        {
            pg8::SchedTokGather S; S.o.init(4, T / 256, G, bx); S.A = (const char*)WAB; S.HB = (const char*)HB; S.tA = (size_t)256 * D * 2;
            const pg8::Geom g{D, D * 2, 128 * D * 2, 128 * D * 2, D * 2};
            const pg8::EpiAB E{W1};
            pg8::gemm_phase<pg8::EpiAB, pg8::SchedTokGather, true>(ring, epi, g, S, E);
        }
        if (!ple_first) P1C_BODY();
#undef P1C_BODY
        }
        if (BOTH(1)) GRID_BAR();
    }
    STAMP(2);

    if (IN(2)) {
        const bool s1_first = S1_FIRST && ((bx & 1) != 0);
#define S1_BODY() do { pg8::SchedPlain S; S.o.init(1, NSEQ * 512 * 128 / 256, G, bx); S.A = (const char*)DFT1; S.B = (const char*)W1; S.tA = 0; S.tB = (size_t)256 * 256 * 2; \
            const pg8::Geom g{256, 512, 512, 128 * 512, 128 * 512}; const pg8::EpiS1 E{ZB, twc, tws}; \
            pg8::gemm_phase<pg8::EpiS1, pg8::SchedPlain, true>(ring, epi, g, S, E); } while (0)
        if (s1_first) S1_BODY();
        { const int per = (attn::NUNITS + G - 1) / G, a0 = vcu * per, a1 = a0 + per < attn::NUNITS ? a0 + per : attn::NUNITS;
          attn::phase(a0, a1, MIX, KB, VB, INPTR(8), INPTR(6), INPTR(7), ssq_a, ring, ts1); }
        LDS_WAIT(); __syncthreads();
        STAMP(3);
        if (!s1_first) S1_BODY();
#undef S1_BODY
        if (BOTH(2)) GRID_BAR();
    }
    STAMP(4);

    if (IN(3)) { _Pragma("unroll") for (int rep = 0; rep < REPS(3); ++rep) {
        pg8::SchedPlain S; S.o.init(1, NSEQ * 128 * 512 / 256, G, bx); S.A = (const char*)DFT2; S.B = (const char*)ZB; S.tA = 0; S.tB = (size_t)256 * 256 * 2;
        const pg8::Geom g{256, 512, 512, 128 * 512, 128 * 512};
        const pg8::EpiS2 E{MIX, ssq_f};
        stagger(bx, STG_S2); pg8::gemm_phase<pg8::EpiS2, pg8::SchedPlain, true>(ring, epi, g, S, E); }
        if (BOTH(3)) GRID_BAR();
    }
    STAMP(5);
#ifdef PROBE_XBAR
    for (int xb = 0; xb < PROBE_XBAR; ++xb) GRID_BAR();
#endif

    if (IN(4)) {
        for (int i = vcu * 512 + tid; i < NSEQ * 256 * (D / 8); i += G * 512) {
            const int sq = i / (256 * (D / 8)), rem = i % (256 * (D / 8)), rr = rem / (D / 8), c8 = rem % (D / 8);
            const int prow = rr == 0 ? 0 : SEQ + rr;
            *(v4u*)(X1B + ((size_t)sq * XPAD + prow) * D + c8 * 8) = (v4u){0u, 0u, 0u, 0u};
        }
        _Pragma("unroll") for (int rep = 0; rep < REPS(4); ++rep) {
        pg8::SchedPlain S; S.o.init(T / 256, 4, G, bx); S.A = (const char*)MIX; S.B = (const char*)WOUT; S.tA = (size_t)256 * D * 2; S.tB = (size_t)256 * D * 2;
        const pg8::Geom g{D, D * 2, D * 2, 128 * D * 2, 128 * D * 2};
        {
            LAS float* tab = (LAS float*)epi; pg8::Unit uu;
            for (int i = 0; i < 3 && S.next(i, uu); ++i)
                if (tid < 256) { const size_t row = (size_t)uu.pm * 256 + tid;
                    const f32x4 a0 = *(const f32x4*)(ssq_a + row * 8), a1 = *(const f32x4*)(ssq_a + row * 8 + 4), f0 = *(const f32x4*)(ssq_f + row * 8), f1 = *(const f32x4*)(ssq_f + row * 8 + 4);
                    const float ra = 1.0f / sqrtf(((a0[0] + a0[1]) + (a0[2] + a0[3]) + (a1[0] + a1[1]) + (a1[2] + a1[3])) * (1.0f / 512.0f) + EPS);
                    const float rf = 1.0f / sqrtf(((f0[0] + f0[1]) + (f0[2] + f0[3]) + (f1[0] + f1[1]) + (f1[2] + f1[3])) * (1.0f / 512.0f) + EPS);
                    tab[(i * 256 + tid) * 2] = ra / rf; tab[(i * 256 + tid) * 2 + 1] = rf; }
            LDS_WAIT(); __syncthreads();
        }
        const pg8::EpiOut E{INPTR(0), INPTR(1), X1B, ssq_x1, (const LAS float*)epi, (LAS float*)(epi + 8192)};
        stagger(bx, STG_P4); pg8::gemm_phase<pg8::EpiOut, pg8::SchedPlain, true>(ring, epi, g, S, E); }
        if (BOTH(4)) GRID_BAR();
    }
    STAMP(6);
#ifdef PROBE_CLK
    clk0 = clock64(); rt0 = __builtin_amdgcn_s_memrealtime();
#endif

    if (IN(5)) { _Pragma("unroll") for (int rep = 0; rep < REPS(5); ++rep) {
        pg8::SchedHalo S; S.o.init(NSEQ * UP_TILES, 2 * DFF / 256, G, bx); S.X1B = (const char*)X1B; S.B = (const char*)WUP; S.tB = (size_t)256 * D * 2;
        const pg8::Geom g{D, D * 2, D * 2, 128 * D * 2, 128 * D * 2};
        const pg8::EpiUp E{INPTR(15), INPTR(16), ssq_x1, ACT};
#ifdef PROBE_P5_LITE
        if (rep + 1 < REPS(5)) { const pg8::EpiLite EL{ACT}; pg8::gemm_phase<pg8::EpiLite, pg8::SchedHalo, true>(ring, epi, g, S, EL); GRID_BAR(); } else
#endif
        { stagger(bx, STG_P5); pg8::gemm_phase<pg8::EpiUp, pg8::SchedHalo, true>(ring, epi, g, S, E); } }
        if (BOTH(5)) GRID_BAR();
    }
    STAMP(7);
#ifdef PROBE_CLK
    clk1 = clock64(); rt1 = __builtin_amdgcn_s_memrealtime();
#endif

    if (IN(6)) { {
        pg8::SchedPlain S; S.o.init(T / 256, 4, G, bx); S.A = (const char*)ACT; S.B = (const char*)WDOWN; S.tA = (size_t)256 * DFF * 2; S.tB = (size_t)256 * DFF * 2;
        const pg8::Geom g{DFF, DFF * 2, DFF * 2, 128 * DFF * 2, 128 * DFF * 2};
        const pg8::EpiDown E{X1B};
        stagger(bx, STG_P6); pg8::gemm_phase<pg8::EpiDown, pg8::SchedPlain, true>(ring, epi, g, S, E); }
        if (BOTH(6)) GRID_BAR();
    }
    STAMP(8);

    if (IN(7)) { _Pragma("unroll") for (int rep = 0; rep < REPS(7); ++rep) {
        pg8::SchedPad S; S.o.init(T / 256, 4, G, bx); S.XB = (const char*)X2B; S.B = (const char*)WGATE; S.tB = (size_t)256 * D * 2;
        const pg8::Geom g{D, D * 2, D * 2, 128 * D * 2, 128 * D * 2};
        {
            LAS float* tab = (LAS float*)epi; pg8::Unit uu;
            for (int i = 0; i < 3 && S.next(i, uu); ++i)
                if (tid < 256) { const float* p = ssq_e + ((size_t)uu.pm * 256 + tid) * 16;
                    const f32x4 a = *(const f32x4*)p, b = *(const f32x4*)(p + 4), c = *(const f32x4*)(p + 8), d = *(const f32x4*)(p + 12);
                    tab[1024 + i * 512 + tid] = INPTR(21)[uu.pn * 256 + tid]; tab[1024 + i * 512 + 256 + tid] = INPTR(19)[uu.pn * 256 + tid];
                    tab[i * 256 + tid] = 1.0f / sqrtf((((a[0] + a[1]) + (a[2] + a[3])) + ((b[0] + b[1]) + (b[2] + b[3])) + ((c[0] + c[1]) + (c[2] + c[3])) + ((d[0] + d[1]) + (d[2] + d[3]))) * (1.0f / 1024.0f) + EPS); }
            LDS_WAIT(); __syncthreads();
        }
#ifndef EG_MODE
#define EG_MODE 0
#endif
        if (rep + 1 < REPS(7)) { const pg8::EpiGateT<EG_MODE> E{out, X2B, ERAW, INPTR(19), INPTR(21), (const LAS float*)epi}; pg8::gemm_phase<pg8::EpiGateT<EG_MODE>, pg8::SchedPad, true>(ring, epi, g, S, E); }
        else { const pg8::EpiGate E{out, X2B, ERAW, INPTR(19), INPTR(21), (const LAS float*)epi}; pg8::gemm_phase<pg8::EpiGate, pg8::SchedPad, true>(ring, epi, g, S, E); } }
    }
    STAMP(9);
#ifdef PROBE_CLK
    { const unsigned long long mhz = (clk1 - clk0) * 100ull / (rt1 - rt0), te = __builtin_amdgcn_s_memrealtime(); while (__builtin_amdgcn_s_memrealtime() - te < mhz * 100ull) __builtin_amdgcn_s_sleep(16); }
#endif
    if (PROBE_SEG >= 0 || PROBE_SUB >= 0 || PROBE_ATT > 0) { const unsigned long long te = __builtin_amdgcn_s_memrealtime(), dt = (ts1 - ts0) * PROBE_AMP; while (__builtin_amdgcn_s_memrealtime() - te < dt) __builtin_amdgcn_s_sleep(16); }
#undef IN
#undef BOTH
#undef GRID_BAR
}

extern "C" void kernel_launch(void* const* d_in, const int* in_sizes, int n_in, void* d_out, int out_size, void* d_ws, size_t ws_size, hipStream_t stream) {
    static int grid = 0;
    if (grid == 0) {
        if (n_in != 22 || in_sizes[0] != 2 * SEQ * D || out_size != T * D || ws_size < WS_END) { fprintf(stderr, "kernel_launch: unexpected shapes (n_in %d, in0 %d, out %d, ws %zu); nothing launched\n", n_in, n_in > 0 ? in_sizes[0] : -1, out_size, ws_size); grid = -1; return; }
        int dev = 0, cus = 0, per_cu = 0;
        if (hipGetDevice(&dev) != hipSuccess || hipDeviceGetAttribute(&cus, hipDeviceAttributeMultiprocessorCount, dev) != hipSuccess) { fprintf(stderr, "kernel_launch: device query failed\n"); grid = -1; return; }
        if (hipFuncSetAttribute((const void*)mk_fwd, hipFuncAttributeMaxDynamicSharedMemorySize, LDS_BYTES) != hipSuccess) { fprintf(stderr, "kernel_launch: hipFuncSetAttribute failed\n"); grid = -1; return; }
        if (hipOccupancyMaxActiveBlocksPerMultiprocessor(&per_cu, (const void*)mk_fwd, NWAVES * 64, LDS_BYTES) != hipSuccess || per_cu < 1)
            fprintf(stderr, "kernel_launch: note: occupancy query reports %d workgroups per CU\n", per_cu);
        (void)hipGetLastError();
        if (cus < 256) { fprintf(stderr, "kernel_launch: built for a 256-CU device (found %d CUs); nothing launched\n", cus); grid = -1; return; }
        grid = 256;
    }
    if (grid < 0) return;
    if (hipMemsetAsync((char*)d_ws + WS_CTL, 0, CTL_ZERO_BYTES, stream) != hipSuccess) { fprintf(stderr, "kernel_launch: memset failed\n"); return; }
    Args a{};
    for (int i = 0; i < 22; ++i) a.in[i] = (const float*)d_in[i];
    a.out = (float*)d_out; a.ws = (unsigned char*)d_ws;
    for (int li = 0; li < N_LAUNCHES; ++li) {
        if (N_LAUNCHES == 1) { a.ph_lo = 0; a.ph_hi = N_PHASES; } else { a.ph_lo = li; a.ph_hi = li + 1; }
        a.li = 0;
        hipLaunchKernelGGL(mk_fwd, dim3(grid), dim3(NWAVES * 64), LDS_BYTES, stream, a);
        const hipError_t le = hipPeekAtLastError();
        if (le != hipSuccess) { fprintf(stderr, "kernel_launch: launch %d failed: %s\n", li, hipGetErrorName(le)); break; }
    }
}
```

```cpp
#include <hip/hip_runtime.h>
#include <cstdio>
#include <cstdint>
#include <cmath>
namespace pg8 {
#define PG8_LAS __attribute__((address_space(3)))
typedef unsigned short bf16_t;
typedef short bf16x8 __attribute__((ext_vector_type(8)));
typedef float f32x4 __attribute__((ext_vector_type(4)));
typedef unsigned u32x4 __attribute__((ext_vector_type(4)));
typedef unsigned u32x2 __attribute__((ext_vector_type(2)));
constexpr int BM = 256, BK = 64, HALF = 128, HTB = HALF * BK * 2  , STAGE_BYTES = 8 * HTB, NXCD = 8, WGM = 8;

__host__ __device__ __forceinline__ int lds_byte(int r, int c) { const int st = (r >> 4) * 2 + (c >> 5), rr = r & 15, cc = c & 31, ob = rr * 64 + cc * 2; return st * 1024 + (ob ^ (((ob >> 9) & 1) << 5)); }
__host__ __device__ __forceinline__ void stage_rc(int b, int& R, int& C) { const int st = b / 1024, sb = b % 1024, swz = sb ^ (((sb >> 9) & 1) << 5); R = (st >> 1) * 16 + swz / 64; C = (st & 1) * 32 + (swz % 64) / 2; }
__host__ __device__ __forceinline__ int perm32(int rho) { const int n = rho >> 4, i = rho & 15; return 8 * (i >> 2) + 4 * n + (i & 3); }

struct Unit { int pm, pn, ui; };
struct Geom { int K; unsigned rsA, rsB, hsA, hsB; };

struct TileOrder {
    int nM, nN, nwg, G, c, heavy;
    __device__ void init(int nM_, int nN_, int G_, int c_) { nM = nM_; nN = nN_; nwg = nM * nN; G = G_; c = c_; heavy = 0; }
    __device__ bool next(int i, Unit& u) const {
        long L = (long)i * G + c;
        if (heavy > 0) {
            const int light = G - heavy, r3 = nwg - G - 2 * light;
            if (i == 0) L = c;
            else if (c < heavy || i > 3 || (i == 3 && c - heavy >= r3)) return false;
            else L = G + (long)(i - 1) * light + (c - heavy);
        }
        if (L >= nwg) return false;
        int wgid = (int)L; { const int q = nwg / NXCD, r = nwg % NXCD, xcd = wgid % NXCD, off = wgid / NXCD; wgid = (xcd < r ? xcd * (q + 1) : r * (q + 1) + (xcd - r) * q) + off; }
        const int nig = WGM * nN, gid = wgid / nig, fm = gid * WGM, gsz = (nM - fm) < WGM ? (nM - fm) : WGM;
        u.pm = fm + ((wgid % nig) % gsz); u.pn = (wgid % nig) / gsz; u.ui = i; return true;
    }
};

__device__ __forceinline__ unsigned cvt_pk_bf16(float lo, float hi) { unsigned r; asm volatile("v_cvt_pk_bf16_f32 %0, %1, %2" : "=v"(r) : "v"(lo), "v"(hi)); return r; }
__device__ __forceinline__ u32x4 pack8(const f32x4 a, const f32x4 b) { u32x4 w; w.x = cvt_pk_bf16(a[0], a[1]); w.y = cvt_pk_bf16(a[2], a[3]); w.z = cvt_pk_bf16(b[0], b[1]); w.w = cvt_pk_bf16(b[2], b[3]); return w; }
__device__ __forceinline__ u32x2 pack4(const f32x4 a) { u32x2 w; w.x = cvt_pk_bf16(a[0], a[1]); w.y = cvt_pk_bf16(a[2], a[3]); return w; }

template <class E, class = void> struct PermA { static constexpr bool v = false; };
template <class E> struct PermA<E, decltype((void)E::PERMA)> { static constexpr bool v = E::PERMA; };
template <class Epi, class Sched, bool ALIGN_EPI>
__device__ __forceinline__ void gemm_phase(PG8_LAS unsigned char* lds, PG8_LAS unsigned char* lds_epi, const Geom g, const Sched& S, const Epi& E) {
    int tid = threadIdx.x; asm volatile("" : "+v"(tid));
    const int wid = __builtin_amdgcn_readfirstlane(tid >> 6), lane = tid & 63, wr = wid >> 2, wc = wid & 3, fr = lane & 15, fq = lane >> 4;
    const int K = g.K, nt = K / BK;
    unsigned voffA[2], voffB[2];
#pragma unroll
    for (int i = 0; i < 2; ++i) { int R, C; stage_rc(tid * 16 + i * 8192, R, C); const int Rb = Epi::PERM ? ((R & ~31) + perm32(R & 31)) : R;
        const int Ra = PermA<Epi>::v ? ((R & ~63) + 4 * (R & 15) + ((R >> 4) & 3)) : R;
        voffA[i] = (unsigned)Ra * g.rsA + (unsigned)C * 2u; voffB[i] = (unsigned)Rb * g.rsB + (unsigned)C * 2u; }
    const size_t kstep = (size_t)(BK * 2);
    const size_t hsA = g.hsA, hsB = g.hsB;
    const unsigned ldsw = (unsigned)wid * 1024u;
    const int aoff = lds_byte(wr * 64 + fr, fq * 8), boff = lds_byte(wc * 32 + fr, fq * 8);
#define PG8_SA(b, h) (((b) * 2 + (h)) * HTB)
#define PG8_SB(b, h) ((4 + (b) * 2 + (h)) * HTB)
#define PG8_STAGE(bufoff, gbase, voff) do { _Pragma("unroll") for (int _i = 0; _i < 2; ++_i) \
        __builtin_amdgcn_global_load_lds((const unsigned*)((const char*)(gbase) + (voff)[_i]), (PG8_LAS unsigned*)(lds + (bufoff) + ldsw + _i * 8192), 16, 0, 0); } while (0)
#define PG8_LDA(dst, b, h) do { _Pragma("unroll") for (int m = 0; m < 4; ++m) _Pragma("unroll") for (int k = 0; k < 2; ++k) dst[m][k] = *(const PG8_LAS bf16x8*)(lds + PG8_SA(b, h) + aoff + m * 2048 + k * 1024); } while (0)
#define PG8_LDB(dst, b, h) do { _Pragma("unroll") for (int n = 0; n < 2; ++n) _Pragma("unroll") for (int k = 0; k < 2; ++k) dst[n][k] = *(const PG8_LAS bf16x8*)(lds + PG8_SB(b, h) + boff + n * 2048 + k * 1024); } while (0)
#define PG8_MMA(ai, bj, At, Bt) do { __builtin_amdgcn_s_setprio(1); _Pragma("unroll") for (int m = 0; m < 4; ++m) _Pragma("unroll") for (int n = 0; n < 2; ++n) _Pragma("unroll") for (int k = 0; k < 2; ++k) \
        acc[ai][bj][m][n] = __builtin_amdgcn_mfma_f32_16x16x32_bf16(Bt[n][k], At[m][k], acc[ai][bj][m][n], 0, 0, 0); __builtin_amdgcn_s_setprio(0); } while (0)
#define PG8_WAIT_V(n) asm volatile("s_waitcnt vmcnt(" #n ")" ::: "memory")
#define PG8_WAIT_L(n) asm volatile("s_waitcnt lgkmcnt(" #n ")" ::: "memory")
#define PG8_BAR __builtin_amdgcn_s_barrier()
#define PG8_SCHED __builtin_amdgcn_sched_barrier(0)
    Unit cur, nxt; int ui = 0;
    if (!S.next(0, cur)) return;
    f32x4 acc[2][2][4][2];
#pragma unroll
    for (int a = 0; a < 2; ++a)
#pragma unroll
        for (int b = 0; b < 2; ++b)
#pragma unroll
            for (int m = 0; m < 4; ++m)
#pragma unroll
                for (int n = 0; n < 2; ++n) acc[a][b][m][n] = (f32x4){0.f, 0.f, 0.f, 0.f};
    bf16x8 At[4][2], B0[2][2], B1[2][2];
    typename Epi::Pre pre;
    const char* cA = S.a_base(cur); const char* cB = S.b_base(cur);
    PG8_STAGE(PG8_SB(0, 0), cB, voffB); PG8_STAGE(PG8_SB(0, 1), cB + hsB, voffB); PG8_STAGE(PG8_SA(0, 0), cA, voffA); PG8_STAGE(PG8_SA(0, 1), cA + hsA, voffA);
    if (wr == 1) PG8_BAR;
    PG8_WAIT_V(2); PG8_BAR;
    PG8_STAGE(PG8_SB(1, 0), cB + kstep, voffB); PG8_STAGE(PG8_SA(1, 0), cA + kstep, voffA); PG8_STAGE(PG8_SB(1, 1), cB + hsB + kstep, voffB);
    PG8_WAIT_V(6); PG8_BAR;
    for (;;) {
        const bool has_next = S.next(ui + 1, nxt);
        E.unit_begin(cur, lds_epi, wid, lane);
        const char* nA = has_next ? S.a_base(nxt) : cA; const char* nB = has_next ? S.b_base(nxt) : cB;
#pragma unroll 1
        for (int t = 0; t < nt; t += 2) {
            const bool last = (t == nt - 2);
            const char* a1 = cA + (size_t)(t + 1) * kstep;
            const char* a2 = last ? nA : cA + (size_t)(t + 2) * kstep; const char* b2 = last ? nB : cB + (size_t)(t + 2) * kstep;
            const char* a3 = a2 + kstep; const char* b3 = b2 + kstep;
            if constexpr (Epi::MIDK) { if (t == Epi::MIDK_T) E.midk(acc, cur, wr, wc, fr, fq); }
            if (last) E.prefetch(pre, cur, wr, wc, fr, fq, lds_epi, wid, lane);
            PG8_LDB(B0, 0, 0); PG8_LDB(B1, 0, 1); PG8_SCHED; PG8_LDA(At, 0, 0); PG8_STAGE(PG8_SA(1, 1), a1 + hsA, voffA);
            PG8_WAIT_V(8); PG8_WAIT_L(0); PG8_BAR; PG8_MMA(0, 0, At, B0); PG8_MMA(0, 1, At, B1); PG8_BAR; PG8_SCHED;
            PG8_LDA(At, 0, 1); PG8_STAGE(PG8_SB(0, 0), b2, voffB); PG8_STAGE(PG8_SB(0, 1), b2 + hsB, voffB); PG8_STAGE(PG8_SA(0, 0), a2, voffA);
            PG8_WAIT_V(8); PG8_WAIT_L(0); PG8_BAR; PG8_MMA(1, 0, At, B0); PG8_MMA(1, 1, At, B1); PG8_BAR; PG8_SCHED;
            PG8_LDB(B0, 1, 0); PG8_LDB(B1, 1, 1); PG8_SCHED; PG8_LDA(At, 1, 0); PG8_STAGE(PG8_SA(0, 1), a2 + hsA, voffA);
            PG8_WAIT_V(8); PG8_WAIT_L(0); PG8_BAR; PG8_MMA(0, 0, At, B0); PG8_MMA(0, 1, At, B1); PG8_BAR; PG8_SCHED;
            PG8_LDA(At, 1, 1); PG8_STAGE(PG8_SB(1, 0), b3, voffB); PG8_STAGE(PG8_SB(1, 1), b3 + hsB, voffB); PG8_STAGE(PG8_SA(1, 0), a3, voffA);
            PG8_WAIT_V(8); PG8_WAIT_L(0); PG8_BAR; PG8_MMA(1, 0, At, B0); PG8_MMA(1, 1, At, B1); PG8_BAR; PG8_SCHED;
        }
        if constexpr (ALIGN_EPI) { if (wr == 0) PG8_BAR; }
        E(acc, pre, cur, wr, wc, fr, fq, lds_epi);
        if (!has_next) break;
#pragma unroll
        for (int a = 0; a < 2; ++a)
#pragma unroll
            for (int b = 0; b < 2; ++b)
#pragma unroll
                for (int m = 0; m < 4; ++m)
#pragma unroll
                    for (int n = 0; n < 2; ++n) acc[a][b][m][n] = (f32x4){0.f, 0.f, 0.f, 0.f};
        cur = nxt; cA = nA; cB = nB; ++ui;
        if constexpr (ALIGN_EPI) { if (wr == 1) PG8_BAR; }
    }
    PG8_WAIT_V(0);
    if constexpr (!ALIGN_EPI) { if (wr == 0) PG8_BAR; }
    PG8_BAR;
#undef PG8_SA
#undef PG8_SB
#undef PG8_STAGE
#undef PG8_LDA
#undef PG8_LDB
#undef PG8_MMA
#undef PG8_WAIT_V
#undef PG8_WAIT_L
#undef PG8_BAR
#undef PG8_SCHED
}
}
constexpr int D = 1024, SEQ = 16384, NSEQ = 3, T = NSEQ * SEQ, DFF = 2816, PLE = 256, INW = 1280;
constexpr int XPAD = 16640;
constexpr int UP_TILES = 65;
constexpr float EPS = 1e-6f;
constexpr float LOG2E = 1.4426950408889634f;
constexpr float QSCALE = 0.125f * LOG2E;

namespace pg8 {
struct SchedPlain {
    TileOrder o; const char* A; const char* B; size_t tA, tB;
    __device__ __forceinline__ bool next(int i, Unit& u) const { return o.next(i, u); }
    __device__ __forceinline__ const char* a_base(const Unit& u) const { return A + (size_t)u.pm * tA; }
    __device__ __forceinline__ const char* b_base(const Unit& u) const { return B + (size_t)u.pn * tB; }
};
struct SchedTokGather {
    TileOrder o; const char* A; const char* HB; size_t tA;
    __device__ __forceinline__ bool next(int i, Unit& u) const { return o.next(i, u); }
    __device__ __forceinline__ const char* a_base(const Unit& u) const { return A + (size_t)u.pm * tA; }
    __device__ __forceinline__ const char* b_base(const Unit& u) const { return HB + ((size_t)(u.pn >> 6) * SEQ + 2 * (u.pn & 63)) * (D * 2); }
};
struct SchedHalo {
    TileOrder o; const char* X1B; const char* B; size_t tB;
    __device__ __forceinline__ bool next(int i, Unit& u) const { return o.next(i, u); }
    __device__ __forceinline__ const char* a_base(const Unit& u) const { const int s = u.pm / UP_TILES, ti = u.pm % UP_TILES; return X1B + ((size_t)s * XPAD + 254 * ti) * (D * 2); }
    __device__ __forceinline__ const char* b_base(const Unit& u) const { return B + (size_t)u.pn * tB; }
};

struct SchedPad {
    TileOrder o; const char* XB; const char* B; size_t tB;
    __device__ __forceinline__ bool next(int i, Unit& u) const { return o.next(i, u); }
    __device__ __forceinline__ const char* a_base(const Unit& u) const { return XB + ((size_t)(u.pm >> 6) * XPAD + 1 + (size_t)(u.pm & 63) * 256) * (D * 2); }
    __device__ __forceinline__ const char* b_base(const Unit& u) const { return B + (size_t)u.pn * tB; }
};

typedef f32x4 AccT[2][2][4][2];
__device__ __forceinline__ float sum4sq(const f32x4 v) { return (v[0] * v[0] + v[1] * v[1]) + (v[2] * v[2] + v[3] * v[3]); }
__device__ __forceinline__ float red_fq(float s) { s += __shfl_xor(s, 16); s += __shfl_xor(s, 32); return s; }
__device__ __forceinline__ float rsq(float ss, float inv_n) { return 1.0f / sqrtf(ss * inv_n + EPS); }

struct EpiQKV {
    static constexpr bool PERM = true, MIDK = false; static constexpr int MIDK_T = 0;
    bf16_t* MIX; bf16_t* KB; bf16_t* VB; const float* qg; const float* kg; const float* ropeC; const float* ropeS;
    __device__ __forceinline__ void midk(AccT&, const Unit&, int, int, int, int) const {}
    struct Pre {};
    __device__ __forceinline__ void unit_begin(const Unit&, PG8_LAS unsigned char*, int, int) const {}
    __device__ __forceinline__ void prefetch(Pre&, const Unit& u, int, int, int, int, PG8_LAS unsigned char* lds_epi, int wid, int lane) const {
        asm volatile("" : "+v"(lane));
        const int pos0 = (u.pm * BM) & (SEQ - 1);
#pragma unroll
        for (int j = 0; j < 2; ++j) { const int i = 2 * wid + j, tbl = i >> 3, chunk = i & 7;
            __builtin_amdgcn_global_load_lds((const unsigned*)((tbl ? ropeS : ropeC) + pos0 * 8 + chunk * 256 + lane * 4), (PG8_LAS unsigned*)(lds_epi + tbl * 8192 + chunk * 1024), 16, 0, 0); }
    }
    __device__ __forceinline__ void operator()(AccT& acc, Pre& pre, const Unit& u, int wr, int wc, int fr, int fq, PG8_LAS unsigned char* lds_epi) const {
        const PG8_LAS float* ropeCl = (const PG8_LAS float*)lds_epi; const PG8_LAS float* ropeSl = (const PG8_LAS float*)(lds_epi + 8192);
        const int hh = u.pn * 4 + wc; const bool isq = hh < 8, nrm = hh < 10;
        f32x4 gn[2][2];
#pragma unroll
        for (int bj = 0; bj < 2; ++bj)
#pragma unroll
            for (int n = 0; n < 2; ++n) { gn[bj][n] = (f32x4){1.f, 1.f, 1.f, 1.f};
                if (nrm) { gn[bj][n] = *(const f32x4*)((isq ? qg : kg) + 32 * bj + 8 * fq + 4 * n); if (isq) gn[bj][n] = gn[bj][n] * QSCALE; } }
        bf16_t* dst; int pitch;
        if (isq) { dst = MIX + hh * 64; pitch = D; } else if (nrm) { dst = KB + (hh - 8) * 64; pitch = 128; } else { dst = VB + (hh - 10) * 64; pitch = 128; }
#pragma unroll
        for (int aim = 0; aim < 4; ++aim) {
            const int ai = aim >> 1;
            f32x4 cs[4][2], sn[4][2];
            if (nrm) {
#pragma unroll
                for (int m = 2 * (aim & 1); m < 2 * (aim & 1) + 2; ++m) { const int rl = ai * HALF + wr * 64 + m * 16 + fr;
                    cs[m][0] = *(const PG8_LAS f32x4*)(ropeCl + rl * 8); cs[m][1] = *(const PG8_LAS f32x4*)(ropeCl + rl * 8 + 4);
                    sn[m][0] = *(const PG8_LAS f32x4*)(ropeSl + rl * 8); sn[m][1] = *(const PG8_LAS f32x4*)(ropeSl + rl * 8 + 4); }
            }
#pragma unroll
            for (int m = 2 * (aim & 1); m < 2 * (aim & 1) + 2; ++m) {
                const int row = u.pm * BM + ai * HALF + wr * 64 + m * 16 + fr;
                f32x4 v[2][2];
#pragma unroll
                for (int bj = 0; bj < 2; ++bj)
#pragma unroll
                    for (int n = 0; n < 2; ++n) v[bj][n] = acc[ai][bj][m][n];
                if (nrm) {
                    float ss = (sum4sq(v[0][0]) + sum4sq(v[0][1])) + (sum4sq(v[1][0]) + sum4sq(v[1][1]));
                    ss = red_fq(ss);
                    const float rstd = rsq(ss, 1.0f / 64.0f);
#pragma unroll
                    for (int bj = 0; bj < 2; ++bj)
#pragma unroll
                        for (int n = 0; n < 2; ++n) v[bj][n] = v[bj][n] * rstd * gn[bj][n];
#pragma unroll
                    for (int n = 0; n < 2; ++n)
#pragma unroll
                        for (int i = 0; i < 4; ++i) {
                            const float own = v[0][n][i], oth = __shfl_xor(own, 16);
                            const float r0 = own * cs[m][n][i] - oth * sn[m][n][i], r1 = own * cs[m][n][i] + oth * sn[m][n][i];
                            v[0][n][i] = fq == 0 ? r0 : (fq == 1 ? r1 : own);
                        }
                }
#pragma unroll
                for (int bj = 0; bj < 2; ++bj) *(u32x4*)(dst + (size_t)row * pitch + 32 * bj + 8 * fq) = pack8(v[bj][0], v[bj][1]);
            }
        }
    }
};

struct EpiAB {
    static constexpr bool PERM = true, MIDK = false; static constexpr int MIDK_T = 0;
    bf16_t* W1;
    __device__ __forceinline__ void midk(AccT&, const Unit&, int, int, int, int) const {}
    struct Pre {};
    __device__ __forceinline__ void unit_begin(const Unit&, PG8_LAS unsigned char*, int, int) const {}
    __device__ __forceinline__ void prefetch(Pre&, const Unit&, int, int, int, int, PG8_LAS unsigned char*, int, int) const {}
    __device__ __forceinline__ void operator()(AccT& acc, Pre& pre, const Unit& u, int wr, int wc, int fr, int fq, PG8_LAS unsigned char*) const {
        const int b = u.pn >> 6, j2 = u.pn & 63;
#pragma unroll
        for (int ai = 0; ai < 2; ++ai)
#pragma unroll
            for (int m = 0; m < 4; ++m) {
                const int r = u.pm * BM + ai * HALF + wr * 64 + m * 16 + fr, part = r >> 9, e = r & 511;
#pragma unroll
                for (int bj = 0; bj < 2; ++bj) {
                    const int n2 = 2 * j2 + bj;
                    bf16_t* dst = W1 + ((((size_t)(b * 512 + e) * 128 + n2) * 2 + part) * 128 + 32 * wc + 8 * fq);
                    *(u32x4*)dst = pack8(acc[ai][bj][m][0], acc[ai][bj][m][1]);
                }
            }
    }
};

struct EpiPle {
    static constexpr bool PERM = true, MIDK = false; static constexpr int MIDK_T = 0;
    bf16_t* ER; float* ssq;
    __device__ __forceinline__ void midk(AccT&, const Unit&, int, int, int, int) const {}
    struct Pre {};
    __device__ __forceinline__ void unit_begin(const Unit&, PG8_LAS unsigned char*, int, int) const {}
    __device__ __forceinline__ void prefetch(Pre&, const Unit&, int, int, int, int, PG8_LAS unsigned char*, int, int) const {}
    __device__ __forceinline__ void operator()(AccT& acc, Pre& pre, const Unit& u, int wr, int wc, int fr, int fq, PG8_LAS unsigned char*) const {
#pragma unroll
        for (int ai = 0; ai < 2; ++ai)
#pragma unroll
            for (int m = 0; m < 4; ++m) {
                const int row = u.pm * BM + ai * HALF + wr * 64 + m * 16 + fr;
                float s = (sum4sq(acc[ai][0][m][0]) + sum4sq(acc[ai][0][m][1])) + (sum4sq(acc[ai][1][m][0]) + sum4sq(acc[ai][1][m][1]));
                s = red_fq(s);
                if (fq == 0) ssq[(size_t)row * 16 + u.pn * 4 + wc] = s;
#pragma unroll
                for (int bj = 0; bj < 2; ++bj) *(u32x4*)(ER + (size_t)row * D + u.pn * BM + bj * HALF + wc * 32 + fq * 8) = pack8(acc[ai][bj][m][0], acc[ai][bj][m][1]);
            }
    }
};

struct EpiS1 {
    static constexpr bool PERM = true, MIDK = false; static constexpr int MIDK_T = 0;
    bf16_t* ZB; const float* twc; const float* tws;
    __device__ __forceinline__ void midk(AccT&, const Unit&, int, int, int, int) const {}
    struct Pre {};
    __device__ __forceinline__ void unit_begin(const Unit&, PG8_LAS unsigned char*, int, int) const {}
    __device__ __forceinline__ void prefetch(Pre&, const Unit&, int, int, int, int, PG8_LAS unsigned char*, int, int) const {}
    __device__ __forceinline__ void operator()(AccT& acc, Pre& pre, const Unit& u, int wr, int wc, int fr, int fq, PG8_LAS unsigned char*) const {
        const int b = u.pn >> 8, e0 = 2 * (u.pn & 255);
        f32x4 c[4][2], s[4][2];
#pragma unroll
        for (int m = 0; m < 4; ++m)
#pragma unroll
            for (int n = 0; n < 2; ++n) { const int k1 = wr * 64 + m * 16 + fr; c[m][n] = *(const f32x4*)(twc + k1 * 128 + 32 * wc + 8 * fq + 4 * n); s[m][n] = *(const f32x4*)(tws + k1 * 128 + 32 * wc + 8 * fq + 4 * n); }
#pragma unroll
        for (int m = 0; m < 4; ++m) {
            const int k1 = wr * 64 + m * 16 + fr;
#pragma unroll
            for (int bj = 0; bj < 2; ++bj) {
                f32x4 zr[2], zi[2];
#pragma unroll
                for (int n = 0; n < 2; ++n) { const f32x4 yr = acc[0][bj][m][n], yi = acc[1][bj][m][n]; zr[n] = yr * c[m][n] + yi * s[m][n]; zi[n] = yi * c[m][n] - yr * s[m][n]; }
                bf16_t* dst = ZB + ((((size_t)(b * 128 + k1) * 512 + (e0 + bj)) * 2) * 128 + 32 * wc + 8 * fq);
                *(u32x4*)dst = pack8(zr[0], zr[1]); *(u32x4*)(dst + 128) = pack8(zi[0], zi[1]);
            }
        }
    }
};

struct EpiS2 {
    static constexpr bool PERM = true, MIDK = false; static constexpr int MIDK_T = 0;
    bf16_t* MIX; float* ssq;
    __device__ __forceinline__ void midk(AccT&, const Unit&, int, int, int, int) const {}
    struct Pre {};
    __device__ __forceinline__ void unit_begin(const Unit&, PG8_LAS unsigned char*, int, int) const {}
    __device__ __forceinline__ void prefetch(Pre&, const Unit&, int, int, int, int, PG8_LAS unsigned char*, int, int) const {}
    __device__ __forceinline__ void operator()(AccT& acc, Pre& pre, const Unit& u, int wr, int wc, int fr, int fq, PG8_LAS unsigned char*) const {
        const int eh = u.pn & 1, k1 = (u.pn >> 1) & 127, b = u.pn >> 8;
#pragma unroll
        for (int m = 0; m < 4; ++m) {
            const int k2 = wr * 64 + m * 16 + fr; const size_t tok = (size_t)b * SEQ + k1 + 128 * k2;
            float s = (sum4sq(acc[0][0][m][0]) + sum4sq(acc[0][0][m][1])) + (sum4sq(acc[0][1][m][0]) + sum4sq(acc[0][1][m][1]));
            s = red_fq(s);
            if (fq == 0) ssq[tok * 8 + eh * 4 + wc] = s;
#pragma unroll
            for (int bj = 0; bj < 2; ++bj) *(u32x4*)(MIX + tok * D + 512 + eh * 256 + bj * HALF + wc * 32 + fq * 8) = pack8(acc[0][bj][m][0], acc[0][bj][m][1]);
        }
    }
};

struct EpiOut {
    static constexpr bool PERM = true, MIDK = true; static constexpr int MIDK_T = 8;
    const float* xp; const float* xs; bf16_t* X1B; float* ssq_x1; const PG8_LAS float* tab; PG8_LAS float* red;
    struct Pre {};
    __device__ __forceinline__ void unit_begin(const Unit&, PG8_LAS unsigned char*, int, int) const {}
    __device__ __forceinline__ void prefetch(Pre&, const Unit&, int, int, int, int, PG8_LAS unsigned char*, int, int) const {}
    __device__ __forceinline__ void midk(AccT& acc, const Unit& u, int wr, int wc, int fr, int fq) const {
#pragma unroll
        for (int ai = 0; ai < 2; ++ai)
#pragma unroll
            for (int m = 0; m < 4; ++m) {
                const float ratio = tab[(u.ui * 256 + ai * HALF + wr * 64 + m * 16 + fr) * 2];
#pragma unroll
                for (int bj = 0; bj < 2; ++bj)
#pragma unroll
                    for (int n = 0; n < 2; ++n) acc[ai][bj][m][n] = acc[ai][bj][m][n] * ratio;
            }
    }
    __device__ __forceinline__ void operator()(AccT& acc, Pre& pre, const Unit& u, int wr, int wc, int fr, int fq, PG8_LAS unsigned char*) const {
        f32x4 xb[2][2][2];
#define EO_LOADQ(q) do { _Pragma("unroll") for (int mm = 0; mm < 2; ++mm) { const int row_ = u.pm * BM + ((q) >> 1) * HALF + wr * 64 + (2 * ((q) & 1) + mm) * 16 + fr; \
            const float* xrow_ = row_ < 2 * SEQ ? xp + (size_t)row_ * D : xs + (size_t)(row_ - 2 * SEQ) * D; \
            _Pragma("unroll") for (int bj = 0; bj < 2; ++bj) _Pragma("unroll") for (int n = 0; n < 2; ++n) xb[mm][bj][n] = *(const f32x4*)(xrow_ + u.pn * BM + bj * HALF + wc * 32 + fq * 8 + n * 4); } } while (0)
#define EO_MATHQ(q) do { _Pragma("unroll") for (int mm = 0; mm < 2; ++mm) { const int ai_ = (q) >> 1, m_ = 2 * ((q) & 1) + mm; const float rf = tab[(u.ui * 256 + ai_ * HALF + wr * 64 + m_ * 16 + fr) * 2 + 1]; \
            _Pragma("unroll") for (int bj = 0; bj < 2; ++bj) _Pragma("unroll") for (int n = 0; n < 2; ++n) acc[ai_][bj][m_][n] = xb[mm][bj][n] + acc[ai_][bj][m_][n] * rf; } \
            asm volatile("" ::: "memory"); } while (0)
#define EO_STOREQ(q) do { _Pragma("unroll") for (int mm = 0; mm < 2; ++mm) { const int ai_ = (q) >> 1, m_ = 2 * ((q) & 1) + mm; const int rl = ai_ * HALF + wr * 64 + m_ * 16 + fr, row = u.pm * BM + rl; \
            const size_t prow = (size_t)(row >> 14) * XPAD + 1 + (row & (SEQ - 1)); float s = 0.f; \
            _Pragma("unroll") for (int bj = 0; bj < 2; ++bj) { const f32x4 a = acc[ai_][bj][m_][0], b = acc[ai_][bj][m_][1]; \
                *(u32x4*)(X1B + prow * D + u.pn * BM + bj * HALF + wc * 32 + fq * 8) = pack8(a, b); s += sum4sq(a) + sum4sq(b); } \
            s = red_fq(s); if (fq == 0) red[wc * 256 + rl] = s; } } while (0)
        EO_LOADQ(0); EO_MATHQ(0);
        EO_LOADQ(1); EO_STOREQ(0); EO_MATHQ(1);
        EO_LOADQ(2); EO_STOREQ(1); EO_MATHQ(2);
        EO_LOADQ(3); EO_STOREQ(2); EO_MATHQ(3);
        EO_STOREQ(3);
#undef EO_LOADQ
#undef EO_MATHQ
#undef EO_STOREQ
        asm volatile("s_waitcnt lgkmcnt(0)" ::: "memory"); __builtin_amdgcn_s_barrier(); asm volatile("" ::: "memory");
        const int tid = threadIdx.x;
        if (tid < 256) ssq_x1[((size_t)u.pm * BM + tid) * 4 + u.pn] = (red[tid] + red[256 + tid]) + (red[512 + tid] + red[768 + tid]);
    }
};


template <int CTRL, bool BC> __device__ __forceinline__ float dpp_mov(float oldv, float src) {
    return __builtin_bit_cast(float, __builtin_amdgcn_update_dpp(__builtin_bit_cast(int, oldv), __builtin_bit_cast(int, src), CTRL, 0xF, 0xF, BC));
}
struct EpiUp {
    static constexpr bool PERM = true, MIDK = false, PERMA = true; static constexpr int MIDK_T = 0;
    const float* cw; const float* cb; const float* ssq_x1; bf16_t* ACT;
    static constexpr int OFF_SSQ = 8192, OFF_PAR = 12288;
    struct Pre {};
    __device__ __forceinline__ void midk(AccT&, const Unit&, int, int, int, int) const {}
    __device__ __forceinline__ void prefetch(Pre&, const Unit&, int, int, int, int, PG8_LAS unsigned char*, int, int) const {}
    __device__ __forceinline__ void unit_begin(const Unit& u, PG8_LAS unsigned char* lds_epi, int wid, int lane) const {
        const float* src; unsigned dst;
        if (wid < 4) { const float* arr = wid < 3 ? cw + (size_t)wid * 2 * DFF : cb; src = arr + (lane >> 5) * DFF + u.pn * 128 + (lane & 31) * 4; dst = OFF_PAR + (u.ui & 1) * 4096 + wid * 1024; }
        else { const int sq = u.pm / UP_TILES, ti = u.pm % UP_TILES; const unsigned tk1 = (unsigned)(sq * SEQ + 254 * ti + (wid - 4) * 64 + lane);
            src = (const float*)((const char*)(ssq_x1 - 4) + tk1 * 16u); dst = OFF_SSQ + (wid - 4) * 1024; }
        __builtin_amdgcn_global_load_lds((const unsigned*)src, (PG8_LAS unsigned*)(lds_epi + dst), 16, 0, 0);
    }
    __device__ __forceinline__ void operator()(AccT& acc, Pre&, const Unit& u, int wr, int wc, int fr, int fq, PG8_LAS unsigned char* lds_epi) const {
        const int sq = u.pm / UP_TILES, ti = u.pm % UP_TILES, tok0 = 254 * ti - 1;
        PG8_LAS float* H = (PG8_LAS float*)lds_epi;
        const PG8_LAS float* SSQ = (const PG8_LAS float*)(lds_epi + OFF_SSQ);
        const PG8_LAS float* PAR = (const PG8_LAS float*)(lds_epi + OFF_PAR + (u.ui & 1) * 4096);
#pragma unroll
        for (int ai = 0; ai < 2; ++ai)
#pragma unroll
            for (int m = 0; m < 4; ++m) {
                const int rl = ai * HALF + wr * 64 + 4 * fr + m, tk = tok0 + rl;
                const f32x4 p = *(const PG8_LAS f32x4*)(SSQ + rl * 4);
                const float r2 = (tk >= 0 && tk < SEQ) ? __builtin_amdgcn_rsqf(((p[0] + p[1]) + (p[2] + p[3])) * (1.0f / 1024.0f) + EPS) : 0.f;
#pragma unroll
                for (int bj = 0; bj < 2; ++bj)
#pragma unroll
                    for (int n = 0; n < 2; ++n) acc[ai][bj][m][n] = acc[ai][bj][m][n] * r2;
            }
#pragma unroll
        for (int ai = 0; ai < 2; ++ai) {
            const int gi = 2 * ai + wr;
#pragma unroll
            for (int bj = 0; bj < 2; ++bj)
#pragma unroll
                for (int n = 0; n < 2; ++n) {
                    const int col = bj * HALF + wc * 32 + fq * 8 + n * 4;
                    if (fr == 0) *(PG8_LAS f32x4*)(H + (gi * 2 + 0) * 256 + col) = acc[ai][bj][0][n];
                    if (fr == 15) *(PG8_LAS f32x4*)(H + (gi * 2 + 1) * 256 + col) = acc[ai][bj][3][n];
                }
        }
        asm volatile("s_waitcnt lgkmcnt(0)" ::: "memory"); __builtin_amdgcn_s_barrier(); asm volatile("" ::: "memory");
        const int chl = wc * 32 + fq * 8;
#pragma unroll
        for (int ai = 0; ai < 2; ++ai) {
            const int gi = 2 * ai + wr;
            u32x2 pk[2][4];
#pragma unroll
            for (int n = 0; n < 2; ++n) {
                f32x4 w0[2], w1[2], w2[2], bb[2], hp[2], hn[2];
#pragma unroll
                for (int bj = 0; bj < 2; ++bj) {
                    const int pc = bj * 128 + chl + n * 4;
                    w0[bj] = *(const PG8_LAS f32x4*)(PAR + pc); w1[bj] = *(const PG8_LAS f32x4*)(PAR + 256 + pc); w2[bj] = *(const PG8_LAS f32x4*)(PAR + 512 + pc); bb[bj] = *(const PG8_LAS f32x4*)(PAR + 768 + pc);
                    const int col = bj * HALF + chl + n * 4;
                    hp[bj] = gi > 0 ? *(const PG8_LAS f32x4*)(H + ((gi - 1) * 2 + 1) * 256 + col) : (f32x4){0.f, 0.f, 0.f, 0.f};
                    hn[bj] = gi < 3 ? *(const PG8_LAS f32x4*)(H + ((gi + 1) * 2 + 0) * 256 + col) : (f32x4){0.f, 0.f, 0.f, 0.f};
                }
                f32x4 pv0[2], nv3[2];
#pragma unroll
                for (int bj = 0; bj < 2; ++bj)
#pragma unroll
                    for (int i = 0; i < 4; ++i) {
                        pv0[bj][i] = dpp_mov<0x111, false>(hp[bj][i], acc[ai][bj][3][n][i]);
                        nv3[bj][i] = dpp_mov<0x101, false>(hn[bj][i], acc[ai][bj][0][n][i]);
                    }
#pragma unroll
                for (int m = 0; m < 4; ++m) {
                    f32x4 hc[2];
#pragma unroll
                    for (int bj = 0; bj < 2; ++bj) {
                        const f32x4 pv = m > 0 ? acc[ai][bj][m > 0 ? m - 1 : 0][n] : pv0[bj];
                        const f32x4 nv = m < 3 ? acc[ai][bj][m < 3 ? m + 1 : 3][n] : nv3[bj];
                        hc[bj] = __builtin_elementwise_fma(pv, w0[bj], __builtin_elementwise_fma(acc[ai][bj][m][n], w1[bj], __builtin_elementwise_fma(nv, w2[bj], bb[bj])));
                    }
                    const f32x4 t = hc[0] * (-LOG2E), gu = hc[0] * hc[1];
                    f32x4 ex; ex[0] = __builtin_amdgcn_exp2f(t[0]); ex[1] = __builtin_amdgcn_exp2f(t[1]); ex[2] = __builtin_amdgcn_exp2f(t[2]); ex[3] = __builtin_amdgcn_exp2f(t[3]);
                    const f32x4 dn = ex + 1.0f;
                    f32x4 rc; rc[0] = __builtin_amdgcn_rcpf(dn[0]); rc[1] = __builtin_amdgcn_rcpf(dn[1]); rc[2] = __builtin_amdgcn_rcpf(dn[2]); rc[3] = __builtin_amdgcn_rcpf(dn[3]);
                    pk[n][m] = pack4(gu * rc);
                }
            }
#pragma unroll
            for (int m = 0; m < 4; ++m) {
                const int rl = ai * HALF + wr * 64 + 4 * fr + m, tk = tok0 + rl;
                if (rl >= 1 && rl <= 254 && tk < SEQ) { u32x4 w; w.x = pk[0][m].x; w.y = pk[0][m].y; w.z = pk[1][m].x; w.w = pk[1][m].y;
                    *(u32x4*)(ACT + ((size_t)sq * SEQ + tk) * DFF + u.pn * 128 + chl) = w; }
            }
        }
    }
};

struct EpiLite {
    static constexpr bool PERM = true, MIDK = false; static constexpr int MIDK_T = 0;
    bf16_t* O;
    __device__ __forceinline__ void midk(AccT&, const Unit&, int, int, int, int) const {}
    struct Pre {};
    __device__ __forceinline__ void unit_begin(const Unit&, PG8_LAS unsigned char*, int, int) const {}
    __device__ __forceinline__ void prefetch(Pre&, const Unit&, int, int, int, int, PG8_LAS unsigned char*, int, int) const {}
    __device__ __forceinline__ void operator()(AccT& acc, Pre& pre, const Unit& u, int wr, int wc, int fr, int fq, PG8_LAS unsigned char*) const {
#pragma unroll
        for (int ai = 0; ai < 2; ++ai)
#pragma unroll
            for (int m = 0; m < 4; ++m) {
                int row = u.pm * 254 + ai * HALF + wr * 64 + m * 16 + fr; row = row < T - 1 ? row : T - 2;
#pragma unroll
                for (int bj = 0; bj < 2; ++bj) {
#ifdef PROBE_NULL_EPI
                    const u32x4 w = pack8(acc[ai][bj][m][0], acc[ai][bj][m][1]);
                    if (w.x == 0x7fc17fc1u) *(u32x4*)(O + (size_t)row * DFF + u.pn * 128 + bj * HALF + wc * 32 + fq * 8) = w;
#else
                    *(u32x4*)(O + (size_t)row * DFF + u.pn * 128 + bj * HALF + wc * 32 + fq * 8) = pack8(acc[ai][bj][m][0], acc[ai][bj][m][1]);
#endif
                }
            }
    }
};

struct EpiDown {
    static constexpr bool PERM = true, MIDK = false; static constexpr int MIDK_T = 0;
    bf16_t* XB;
    __device__ __forceinline__ void midk(AccT&, const Unit&, int, int, int, int) const {}
    struct Pre { u32x4 x[2][2]; };
    __device__ __forceinline__ void unit_begin(const Unit&, PG8_LAS unsigned char*, int, int) const {}
#define ED_ADDR(gq, bj) (XB + ((size_t)((u.pm * BM + ((gq) >> 2) * HALF + wr * 64 + ((gq) & 3) * 16 + fr) >> 14) * XPAD + 1 + ((u.pm * BM + ((gq) >> 2) * HALF + wr * 64 + ((gq) & 3) * 16 + fr) & (SEQ - 1))) * D + u.pn * BM + (bj) * HALF + wc * 32 + fq * 8)
    __device__ __forceinline__ void prefetch(Pre& pre, const Unit& u, int wr, int wc, int fr, int fq, PG8_LAS unsigned char*, int, int) const {
#pragma unroll
        for (int gq = 0; gq < 2; ++gq)
#pragma unroll
            for (int bj = 0; bj < 2; ++bj) pre.x[gq][bj] = *(const u32x4*)ED_ADDR(gq, bj);
    }
    __device__ __forceinline__ void operator()(AccT& acc, Pre& pre, const Unit& u, int wr, int wc, int fr, int fq, PG8_LAS unsigned char*) const {
        u32x4 xb[8][2];
#pragma unroll
        for (int bj = 0; bj < 2; ++bj) { xb[0][bj] = pre.x[0][bj]; xb[1][bj] = pre.x[1][bj]; }
#pragma unroll
        for (int gq = 2; gq < 8; ++gq)
#pragma unroll
            for (int bj = 0; bj < 2; ++bj) xb[gq][bj] = *(const u32x4*)ED_ADDR(gq, bj);
#pragma unroll
        for (int gq = 0; gq < 8; ++gq) {
            const int ai = gq >> 2, m = gq & 3;
#pragma unroll
            for (int bj = 0; bj < 2; ++bj) {
                const u32x4 w = xb[gq][bj];
                const f32x4 a = {__builtin_bit_cast(float, w.x << 16), __builtin_bit_cast(float, w.x & 0xffff0000u), __builtin_bit_cast(float, w.y << 16), __builtin_bit_cast(float, w.y & 0xffff0000u)};
                const f32x4 b = {__builtin_bit_cast(float, w.z << 16), __builtin_bit_cast(float, w.z & 0xffff0000u), __builtin_bit_cast(float, w.w << 16), __builtin_bit_cast(float, w.w & 0xffff0000u)};
                *(u32x4*)ED_ADDR(gq, bj) = pack8(a + acc[ai][bj][m][0], b + acc[ai][bj][m][1]);
            }
        }
    }
#undef ED_ADDR
};

template <int MODE> struct EpiGateT {
    static constexpr bool PERM = false, MIDK = false; static constexpr int MIDK_T = 0;
    float* out; const bf16_t* X2B; const bf16_t* ER; const float* gple; const float* bg; const PG8_LAS float* tab;
    __device__ __forceinline__ void midk(AccT&, const Unit&, int, int, int, int) const {}
    struct Pre {};
    __device__ __forceinline__ void unit_begin(const Unit&, PG8_LAS unsigned char*, int, int) const {}
#define EG_ROW(gq) (u.pm * BM + ((gq) >> 2) * HALF + wr * 64 + ((gq) & 3) * 16 + fr)
#define EG_COL(bj, n) (u.pn * BM + (bj) * HALF + wc * 32 + (n) * 16 + fq * 4)
#define EG_PROW(row_) ((size_t)((row_) >> 14) * XPAD + 1 + ((row_) & (SEQ - 1)))
    __device__ __forceinline__ void prefetch(Pre&, const Unit&, int, int, int, int, PG8_LAS unsigned char*, int, int) const {}
    __device__ __forceinline__ void operator()(AccT& acc, Pre& pre, const Unit& u, int wr, int wc, int fr, int fq, PG8_LAS unsigned char*) const {
        const PG8_LAS float* bgt = tab + 1024 + u.ui * 512 + wc * 32 + fq * 4;
        u32x2 yb[4][2][2], eb[4][2][2];
#define EG_LOADH(ai) do { _Pragma("unroll") for (int m = 0; m < 4; ++m) { const int row_ = EG_ROW((ai) * 4 + m); _Pragma("unroll") for (int bj = 0; bj < 2; ++bj) _Pragma("unroll") for (int n = 0; n < 2; ++n) { \
            if (MODE != 2 && MODE != 4) { yb[m][bj][n] = *(const u32x2*)(X2B + EG_PROW(row_) * D + EG_COL(bj, n)); eb[m][bj][n] = *(const u32x2*)(ER + (size_t)row_ * D + EG_COL(bj, n)); } \
            else { yb[m][bj][n] = (u32x2){(unsigned)row_, 1u}; eb[m][bj][n] = yb[m][bj][n]; } } } } while (0)
#define EG_MATH(ai) do { _Pragma("unroll") for (int m = 0; m < 4; ++m) { const float re = tab[u.ui * 256 + (ai) * HALF + wr * 64 + m * 16 + fr]; \
            _Pragma("unroll") for (int bj = 0; bj < 2; ++bj) _Pragma("unroll") for (int n = 0; n < 2; ++n) { \
                const f32x4 bvv = *(const PG8_LAS f32x4*)(bgt + bj * HALF + 16 * n), gvv = *(const PG8_LAS f32x4*)(bgt + 256 + bj * HALF + 16 * n); \
                const u32x2 e2 = eb[m][bj][n], y2 = yb[m][bj][n]; \
                const f32x4 ev = {__builtin_bit_cast(float, e2.x << 16), __builtin_bit_cast(float, e2.x & 0xffff0000u), __builtin_bit_cast(float, e2.y << 16), __builtin_bit_cast(float, e2.y & 0xffff0000u)}; \
                f32x4 y = {__builtin_bit_cast(float, y2.x << 16), __builtin_bit_cast(float, y2.x & 0xffff0000u), __builtin_bit_cast(float, y2.y << 16), __builtin_bit_cast(float, y2.y & 0xffff0000u)}; \
                const f32x4 z = acc[ai][bj][m][n] + bvv; \
                _Pragma("unroll") for (int i = 0; i < 4; ++i) { if (MODE == 4) y[i] += z[i]; else y[i] += __builtin_amdgcn_rcpf(1.0f + __builtin_amdgcn_exp2f(-z[i] * LOG2E)) * ev[i] * re * gvv[i]; } \
                acc[ai][bj][m][n] = y; } } \
            asm volatile("" ::: "memory"); } while (0)
#define EG_STOREH(ai) do { _Pragma("unroll") for (int m = 0; m < 4; ++m) { const size_t row = (size_t)EG_ROW((ai) * 4 + m); _Pragma("unroll") for (int bj = 0; bj < 2; ++bj) _Pragma("unroll") for (int n = 0; n < 2; ++n) { \
            const f32x4 y = acc[ai][bj][m][n]; if (MODE != 1 || y[0] == 1.2345e30f) *(f32x4*)(out + row * D + EG_COL(bj, n)) = y; } } } while (0)
        EG_LOADH(0);
        EG_MATH(0);
        EG_LOADH(1);
        EG_STOREH(0);
        EG_MATH(1);
        EG_STOREH(1);
#undef EG_LOADH
#undef EG_MATH
#undef EG_STOREH
    }
#undef EG_ROW
#undef EG_COL
#undef EG_PROW
};
typedef EpiGateT<0> EpiGate;
}
#ifndef PROBE_ATT
#define PROBE_ATT 0
#endif
namespace attn {
typedef unsigned short bf16_t;
typedef short bf16x8 __attribute__((ext_vector_type(8)));
typedef short s16x4 __attribute__((ext_vector_type(4)));
typedef float f32x16 __attribute__((ext_vector_type(16)));
typedef float f32x2 __attribute__((ext_vector_type(2)));
typedef float f32x4 __attribute__((ext_vector_type(4)));
typedef unsigned u32x4 __attribute__((ext_vector_type(4)));
typedef unsigned u32x2 __attribute__((ext_vector_type(2)));
#define ATT_LAS __attribute__((address_space(3)))
constexpr int NSLOT = 6, NKEY = NSLOT * 64, KROW = 144, KS_BYTES = NKEY * KROW, VPLANE = NKEY * 64, VS_OFF = KS_BYTES, LDS_BYTES = KS_BYTES + 2 * VPLANE;
constexpr int NUNITS = NSEQ * 2 * (SEQ / 64);
__device__ __forceinline__ int crow(int r, int hi) { return (r & 3) + 8 * (r >> 2) + 4 * hi; }
__device__ __forceinline__ s16x4 vtr(const ATT_LAS unsigned char* p) { return __builtin_bit_cast(s16x4, __builtin_amdgcn_ds_read_tr16_b64_v4i16((ATT_LAS s16x4*)p)); }
__device__ __forceinline__ int slot_of(int kb6) { return kb6 >= NSLOT ? kb6 - NSLOT : kb6; }

__device__ __forceinline__ void load_blk(u32x4& rk, u32x4& rv, int uid, int kb, const pg8::bf16_t* KB, const pg8::bf16_t* VB) {
    int tid = threadIdx.x; asm volatile("" : "+v"(tid));
    const int kvh = (uid >> 8) & 1, b = uid >> 9, row = tid >> 3, ch = tid & 7;
    int k = kb * 64 + row; k = k < 0 ? 0 : (k > SEQ - 1 ? SEQ - 1 : k);
    const size_t g = ((size_t)b * SEQ + k) * 128 + kvh * 64 + ch * 8; rk = *(const u32x4*)(KB + g); rv = *(const u32x4*)(VB + g);
}
__device__ __forceinline__ void stash_blk(const u32x4& rk, const u32x4& rv, int slot, ATT_LAS unsigned char* lds) {
    int tid = threadIdx.x; asm volatile("" : "+v"(tid));
    const int row = slot * 64 + (tid >> 3), ch = tid & 7;
    *(ATT_LAS u32x4*)(lds + row * KROW + ch * 16) = rk;
    *(ATT_LAS u32x4*)(lds + VS_OFF + (ch >> 2) * VPLANE + row * 64 + (ch & 3) * 16) = rv;
}
__device__ __forceinline__ void load_q(bf16x8 (&q)[4], int uid, const pg8::bf16_t* MIX) {
    int tid = threadIdx.x; asm volatile("" : "+v"(tid));
    const int lane = tid & 63, r32 = lane & 31, hi = lane >> 5, wid = __builtin_amdgcn_readfirstlane(tid >> 6);
    const int qb = uid & 255, kvh = (uid >> 8) & 1, b = uid >> 9, hq = kvh * 4 + (wid >> 1);
    const size_t tok = (size_t)b * SEQ + qb * 64 + (wid & 1) * 32 + r32;
#pragma unroll
    for (int d0 = 0; d0 < 4; ++d0) q[d0] = *(const bf16x8*)(MIX + tok * D + hq * 64 + d0 * 16 + hi * 8);
}
constexpr int TAB_OFF = LDS_BYTES, TAB_BYTES = 3 * 4 * 64 * 16;
__device__ __forceinline__ void compute(int uid, int next_uid, const bf16x8 (&qf)[4], bf16x8 (&qn)[4], const u32x4& rk, const u32x4& rv, float sink2, float negM, const f32x16& cinit, pg8::bf16_t* MIX, float* ssq_a, ATT_LAS unsigned char* lds) {
    int tid = threadIdx.x; asm volatile("" : "+v"(tid));
    const int lane = tid & 63, r32 = lane & 31, hi = lane >> 5; const int wid = __builtin_amdgcn_readfirstlane(tid >> 6);
    const int qb = uid & 255, kvh = (uid >> 8) & 1, b = uid >> 9;
    const int q0 = qb * 64;
    const int st_lo = qb == 0 ? 4 : (qb == 1 ? 2 : 0), st_hi = qb == 255 ? 6 : (qb == 254 ? 8 : 10);
    const bool edge = qb < 2 || qb >= 254;
    const int base6 = (qb + 4) % NSLOT;
    const int hq = kvh * 4 + (wid >> 1), sb = wid & 1, qi = sb * 32 + r32;
    const size_t tok = (size_t)b * SEQ + q0 + qi;
    const float l = __builtin_amdgcn_exp2f(sink2 + negM);
    f32x16 o0, o1, ls;
#pragma unroll
    for (int r = 0; r < 16; ++r) { o0[r] = 0.f; o1[r] = 0.f; ls[r] = 0.f; }
    const bf16x8 ones = (bf16x8){0x3F80, 0x3F80, 0x3F80, 0x3F80, 0x3F80, 0x3F80, 0x3F80, 0x3F80};
    const ATT_LAS unsigned char* kp = lds + r32 * KROW + hi * 16;
    const ATT_LAS unsigned char* vp = lds + VS_OFF + (4 * hi + ((lane & 15) >> 2)) * 64 + ((lane >> 4) & 1) * 32 + (lane & 3) * 8;
    const ATT_LAS unsigned char* tp = lds + TAB_OFF + lane * 16;
#pragma unroll
    for (int g = 0; g < 3; ++g) {
        f32x16 s[3];
        const int st0 = sb + 3 * g;
        int rb[3];
#pragma unroll
        for (int j = 0; j < 3; ++j) rb[j] = slot_of(base6 + ((st0 + j) >> 1)) * 64 + ((st0 + j) & 1) * 32;
        const int jm = g == 0 ? 0 : (g == 2 ? 2 : -1);
        if (jm >= 0) {
            const bool in = st0 + jm >= st_lo && st0 + jm < st_hi;
            const ATT_LAS unsigned char* tq = tp + (in ? (g == 2 ? 4096 : 0) : 8192);
#pragma unroll
            for (int r4 = 0; r4 < 4; ++r4) { const f32x4 t = *(const ATT_LAS f32x4*)(tq + r4 * 1024); s[jm][4 * r4] = t[0]; s[jm][4 * r4 + 1] = t[1]; s[jm][4 * r4 + 2] = t[2]; s[jm][4 * r4 + 3] = t[3]; }
        }
#pragma unroll
        for (int d0 = 0; d0 < 4; ++d0)
#pragma unroll
            for (int j = 0; j < 3; ++j) {
                const bf16x8 kf = *(const ATT_LAS bf16x8*)(kp + rb[j] * KROW + d0 * 32);
                s[j] = __builtin_amdgcn_mfma_f32_32x32x16_bf16(kf, qf[d0], (d0 == 0 && j != jm) ? cinit : s[j], 0, 0, 0);
            }
        if (edge) {
#pragma unroll
            for (int j = 0; j < 3; ++j)
                if (j != jm && !(st0 + j >= st_lo && st0 + j < st_hi)) {
#pragma unroll
                    for (int r = 0; r < 16; ++r) s[j][r] = -1e30f;
                }
        }
        if (g == 2) load_q(qn, next_uid, MIX);
        __builtin_amdgcn_sched_barrier(0);
#pragma unroll
        for (int r = 0; r < 16; ++r) s[0][r] = __builtin_amdgcn_exp2f(s[0][r]);
#pragma unroll
        for (int j = 0; j < 3; ++j) {
            __builtin_amdgcn_sched_barrier(0);
            asm volatile("s_nop 0");
            bf16x8 pf[2];
#pragma unroll
            for (int ks = 0; ks < 2; ++ks) {
                u32x4 pw;
                pw.x = pg8::cvt_pk_bf16(s[j][8 * ks + 0], s[j][8 * ks + 1]); pw.y = pg8::cvt_pk_bf16(s[j][8 * ks + 2], s[j][8 * ks + 3]);
                pw.z = pg8::cvt_pk_bf16(s[j][8 * ks + 4], s[j][8 * ks + 5]); pw.w = pg8::cvt_pk_bf16(s[j][8 * ks + 6], s[j][8 * ks + 7]);
                pf[ks] = __builtin_bit_cast(bf16x8, pw);
            }
            __builtin_amdgcn_sched_barrier(0);
            if (j < 2) {
#pragma unroll
                for (int r = 0; r < 16; ++r) s[j + 1][r] = __builtin_amdgcn_exp2f(s[j + 1][r]);
            }
#pragma unroll
            for (int ks = 0; ks < 2; ++ks) {
                const ATT_LAS unsigned char* vq = vp + (rb[j] + 16 * ks) * 64;
                const s16x4 a0 = vtr(vq), a1 = vtr(vq + 8 * 64), b0 = vtr(vq + VPLANE), b1 = vtr(vq + VPLANE + 8 * 64);
                const bf16x8 vf0 = (bf16x8){a0[0], a0[1], a0[2], a0[3], a1[0], a1[1], a1[2], a1[3]};
                const bf16x8 vf1 = (bf16x8){b0[0], b0[1], b0[2], b0[3], b1[0], b1[1], b1[2], b1[3]};
                o0 = __builtin_amdgcn_mfma_f32_32x32x16_bf16(vf0, pf[ks], o0, 0, 0, 0);
                o1 = __builtin_amdgcn_mfma_f32_32x32x16_bf16(vf1, pf[ks], o1, 0, 0, 0);
                ls = __builtin_amdgcn_mfma_f32_32x32x16_bf16(ones, pf[ks], ls, 0, 0, 0);
            }
        }
        if (g == 1) stash_blk(rk, rv, slot_of(base6 + 5), lds);
        __builtin_amdgcn_sched_barrier(0);
    }
    const float ltot = l + ls[0], inv = __builtin_amdgcn_rcpf(ltot);
    float ss = 0.f;
#pragma unroll
    for (int r = 0; r < 16; ++r) { o0[r] *= inv; o1[r] *= inv; ss += o0[r] * o0[r] + o1[r] * o1[r]; }
    ss += __shfl_xor(ss, 32);
    ssq_a[tok * 8 + hq] = ss;
    pg8::bf16_t* op = MIX + tok * D + hq * 64 + 4 * hi;
#pragma unroll
    for (int rg = 0; rg < 4; ++rg) {
        u32x2 w0, w1;
        w0.x = pg8::cvt_pk_bf16(o0[4 * rg], o0[4 * rg + 1]); w0.y = pg8::cvt_pk_bf16(o0[4 * rg + 2], o0[4 * rg + 3]);
        w1.x = pg8::cvt_pk_bf16(o1[4 * rg], o1[4 * rg + 1]); w1.y = pg8::cvt_pk_bf16(o1[4 * rg + 2], o1[4 * rg + 3]);
        *(u32x2*)(op + 8 * rg) = w0; *(u32x2*)(op + 32 + 8 * rg) = w1;
    }
}
__device__ __forceinline__ void phase(int u0, int u1, pg8::bf16_t* MIX, const pg8::bf16_t* KB, const pg8::bf16_t* VB, const float* sink, const float* qg, const float* kg, float* ssq_a, ATT_LAS unsigned char* lds, unsigned long long& tacc) {
#define ATT_T(k, sgn) do { if (PROBE_ATT == (k)) { asm volatile("s_waitcnt lgkmcnt(0)" ::: "memory"); tacc sgn __builtin_amdgcn_s_memrealtime(); } } while (0)
    if (u0 >= u1) return;
    const int wq = __builtin_amdgcn_readfirstlane((int)threadIdx.x >> 6) >> 1;
#define ATT_UNI(x) __builtin_bit_cast(float, __builtin_amdgcn_readfirstlane(__builtin_bit_cast(int, (float)(x))))
    const float sk0 = ATT_UNI(sink[wq] * LOG2E), sk1 = ATT_UNI(sink[4 + wq] * LOG2E);
    float gq = fabsf(qg[threadIdx.x & 63]), gk = fabsf(kg[threadIdx.x & 63]);
#pragma unroll
    for (int o = 1; o < 64; o <<= 1) { gq = fmaxf(gq, __shfl_xor(gq, o)); gk = fmaxf(gk, __shfl_xor(gk, o)); }
    const float negM = ATT_UNI(-(64.0f * QSCALE * 1.02f) * gq * gk);
#undef ATT_UNI
    {
        const int lane = threadIdx.x & 63, r32 = lane & 31, hi = lane >> 5, w = __builtin_amdgcn_readfirstlane((int)threadIdx.x >> 6);
        const int tb = w >> 2, r4 = w & 3;
        f32x4 t;
#pragma unroll
        for (int i = 0; i < 4; ++i) { const int c = crow(4 * r4 + i, hi); t[i] = (tb == 0 ? c >= r32 : c <= r32) ? negM : -1e30f; }
        *(ATT_LAS f32x4*)(lds + TAB_OFF + tb * 4096 + r4 * 1024 + lane * 16) = t;
        if (w < 4) *(ATT_LAS f32x4*)(lds + TAB_OFF + 8192 + w * 1024 + lane * 16) = (f32x4){-1e30f, -1e30f, -1e30f, -1e30f};
    }
    f32x16 cinit;
#pragma unroll
    for (int r = 0; r < 16; ++r) cinit[r] = negM;
    int uid = u0;
#pragma unroll 1
    while (uid < u1) {
        const int run_end = (uid | 255) + 1 < u1 ? (uid | 255) + 1 : u1;
        bf16x8 qn[4];
        {
            const int qb = uid & 255, base6 = (qb + 4) % NSLOT;
            u32x4 fk[5], fv[5];
#pragma unroll
            for (int i = 0; i < 5; ++i) load_blk(fk[i], fv[i], uid, qb - 2 + i, KB, VB);
            load_q(qn, uid, MIX);
            asm volatile("s_waitcnt lgkmcnt(0)" ::: "memory"); __builtin_amdgcn_s_barrier(); asm volatile("" ::: "memory");
#pragma unroll
            for (int i = 0; i < 5; ++i) stash_blk(fk[i], fv[i], slot_of(base6 + i), lds);
            __builtin_amdgcn_s_waitcnt(0);
            __builtin_amdgcn_s_barrier(); asm volatile("" ::: "memory");
        }
#pragma unroll 1
        for (; uid < run_end; ++uid) {
            ATT_T(1, -=);
#pragma unroll
            for (int d0 = 0; d0 < 4; ++d0) asm volatile("" : "+v"(qn[d0]));
            u32x4 rk, rv; load_blk(rk, rv, uid, (uid & 255) + 3, KB, VB);
            __builtin_amdgcn_sched_barrier(0);
            bf16x8 qf[4];
#pragma unroll
            for (int d0 = 0; d0 < 4; ++d0) qf[d0] = qn[d0];
            ATT_T(2, -=);
            compute(uid, uid + 1 < u1 ? uid + 1 : uid, qf, qn, rk, rv, ((uid >> 8) & 1) ? sk1 : sk0, negM, cinit, MIX, ssq_a, lds);
            ATT_T(2, +=); ATT_T(3, -=);
            asm volatile("s_waitcnt lgkmcnt(0)" ::: "memory"); __builtin_amdgcn_s_barrier(); asm volatile("" ::: "memory");
            ATT_T(3, +=); ATT_T(1, +=);
        }
    }
}
}
constexpr int NWAVES = 8;
#ifndef MK_N_LAUNCHES
#define MK_N_LAUNCHES 1
#endif
constexpr int N_PHASES = 8;
constexpr int N_LAUNCHES = MK_N_LAUNCHES;

constexpr size_t MiB = 1u << 20;
constexpr size_t WS_CTL = 0, CTL_ZERO_BYTES = 64 * 1024;
constexpr size_t WS_ROPEC = 1 * MiB, WS_ROPES = WS_ROPEC + 512 * 1024;
constexpr size_t WS_TWC = 2 * MiB, WS_TWS = WS_TWC + 64 * 1024;
constexpr size_t WS_DFT1 = WS_TWS + 64 * 1024, WS_DFT2 = WS_DFT1 + 128 * 1024;
constexpr size_t WS_WQKV = 3 * MiB;
constexpr size_t WS_WAB = WS_WQKV + 768 * 1024 * 2;
constexpr size_t WS_WOUT = WS_WAB + 2 * MiB;
constexpr size_t WS_WUP = WS_WOUT + 2 * MiB;
constexpr size_t WS_WDOWN = WS_WUP + 11 * MiB;
constexpr size_t WS_WPLE = WS_WDOWN + (size_t)1024 * 2816 * 2;
constexpr size_t WS_WGATE = WS_WPLE + 512 * 1024;
constexpr size_t WS_WEND = WS_WGATE + 2 * MiB;
static_assert(WS_WEND <= 30 * MiB, "weights region");
constexpr size_t WS_ERAW = 30 * MiB;
constexpr size_t WS_SSQ_A = 126 * MiB, WS_SSQ_F = WS_SSQ_A + (size_t)T * 8 * 4, WS_SSQ_X1 = WS_SSQ_F + (size_t)T * 8 * 4, WS_SSQ_E = WS_SSQ_X1 + (size_t)T * 16 * 4;
static_assert(WS_SSQ_E + (size_t)T * 16 * 4 <= 136 * MiB, "ssq region");
constexpr size_t WS_R1 = 136 * MiB;
constexpr size_t WS_MIX = 234 * MiB;
constexpr size_t WS_KB = 330 * MiB, WS_VB = 342 * MiB;
constexpr size_t WS_W1 = 354 * MiB;
constexpr size_t WS_PB = 450 * MiB;
constexpr size_t WS_ACT = 234 * MiB;
constexpr size_t WS_END = 498 * MiB;
static_assert((size_t)NSEQ * XPAD * D * 2 <= 98 * MiB && WS_ACT + (size_t)T * DFF * 2 <= WS_END && WS_PB + (size_t)T * PLE * 2 <= WS_END, "d_ws map");
constexpr int CW_BAR = 4096;

constexpr int RING_OFF = 0, RING_BYTES = 131072, EPI_OFF = RING_BYTES, EPI_BYTES = 20480;
constexpr int LDSCTL_OFF = EPI_OFF + EPI_BYTES, MISC_OFF = LDSCTL_OFF + 320;
constexpr int LDS_BYTES = LDSCTL_OFF + 1024;
static_assert(attn::TAB_OFF + attn::TAB_BYTES <= RING_BYTES, "attention LDS");

#define GAS __attribute__((address_space(1)))
#define LAS __attribute__((address_space(3)))
typedef unsigned short bf16;
typedef unsigned v4u __attribute__((ext_vector_type(4)));
typedef float f32x4 __attribute__((ext_vector_type(4)));
typedef GAS unsigned gu32;
#define RLX_AGENT __ATOMIC_RELAXED, __HIP_MEMORY_SCOPE_AGENT
#define LDS_WAIT() asm volatile("s_waitcnt lgkmcnt(0)" ::: "memory")
#define VM_WAIT() asm volatile("s_waitcnt vmcnt(0)" ::: "memory")
__device__ __forceinline__ unsigned f2bf(float f) { unsigned u = __builtin_bit_cast(unsigned, f); return (u + 0x7fffu + ((u >> 16) & 1u)) >> 16; }
__device__ __forceinline__ unsigned pk2(float lo, float hi) { return f2bf(lo) | (f2bf(hi) << 16); }

#define XB_TMO      128
#define XB_XCNT(j)  (256  + 64 * (j))
#define XB_XSUB(j)  (1280 + 64 * (j))
#define XB_XGEN(j)  (2304 + 64 * (j))
#define XB_TOP      3328
#define XB_TOPGEN   3392
#define XCD_BAR_WORDS 3456
#define XB_SPIN_CAP (1u << 18)
__device__ __forceinline__ unsigned xb_ld(unsigned* p)              { return __hip_atomic_load(p, __ATOMIC_RELAXED, __HIP_MEMORY_SCOPE_AGENT); }
__device__ __forceinline__ unsigned xb_add(unsigned* p, unsigned v) { return __hip_atomic_fetch_add(p, v, __ATOMIC_RELAXED, __HIP_MEMORY_SCOPE_AGENT); }
__device__ __forceinline__ unsigned xb_xcc_id() { return (unsigned)__builtin_amdgcn_s_getreg((3 << 11) | 20) & 0xFu; }
#define XB_SPIN(cond, bar) do { unsigned _sp = 0; while (cond) { __builtin_amdgcn_s_sleep(1); \
    if ((++_sp & 255u) == 0u) { if (xb_ld(&(bar)[XB_TMO])) break; if (_sp > XB_SPIN_CAP) { atomicAdd(&(bar)[XB_TMO], 1u); break; } } } } while (0)
struct XcdBarrier { unsigned* bar; unsigned x; volatile LAS unsigned* st; };
__device__ __forceinline__ XcdBarrier xcd_barrier_post(unsigned* bar, volatile LAS unsigned* st) {
    XcdBarrier b; b.bar = bar; b.x = xb_xcc_id(); b.st = st;
    if (threadIdx.x == 0) (void)xb_add(&bar[XB_XCNT(b.x)], 1u);
    return b;
}
__device__ __forceinline__ void xcd_barrier_complete(unsigned* bar, unsigned x, unsigned& nloc, unsigned& nx) {
    const unsigned G = gridDim.x * gridDim.y * gridDim.z;
    unsigned sum, cnt, mine, sp = 0u;
    for (;;) {
        sum = 0u; cnt = 0u; mine = 0u;
#pragma unroll
        for (unsigned j = 0; j < 16; ++j) { const unsigned c = xb_ld(&bar[XB_XCNT(j)]); sum += c; cnt += (c > 0u) ? 1u : 0u; mine = (j == x) ? c : mine; }
        if (sum == G) break;
        __builtin_amdgcn_s_sleep(1);
        if ((++sp & 255u) == 0u) { if (xb_ld(&bar[XB_TMO])) break; if (sp > XB_SPIN_CAP) { atomicAdd(&bar[XB_TMO], 1u); break; } }
    }
    nloc = mine > 0u ? mine : 1u; nx = cnt > 0u ? cnt : 1u;
}
__device__ __forceinline__ void xcd_barrier(const XcdBarrier& b) {
    asm volatile("s_waitcnt vmcnt(0)" ::: "memory");
    __syncthreads();
    if (threadIdx.x == 0) {
        unsigned* bar = b.bar;
        __builtin_amdgcn_s_waitcnt(0);
        unsigned nloc = b.st[0], nx = b.st[1];
        if (nloc == 0u) { xcd_barrier_complete(bar, b.x, nloc, nx); b.st[0] = nloc; b.st[1] = nx; }
        const unsigned old = xb_add(&bar[XB_XSUB(b.x)], 1u);
        const unsigned gen = old / nloc;
        if (old + 1u == (gen + 1u) * nloc) {
            __builtin_amdgcn_fence(__ATOMIC_RELEASE, "agent");
            asm volatile("s_waitcnt vmcnt(0)" ::: "memory");
            const unsigned og = xb_add(&bar[XB_TOP], 1u);
            const unsigned tg = og / nx;
            if (og + 1u == (tg + 1u) * nx) xb_add(&bar[XB_TOPGEN], 1u);
            else XB_SPIN(xb_ld(&bar[XB_TOPGEN]) == tg, bar);
            __builtin_amdgcn_fence(__ATOMIC_ACQUIRE, "agent");
            xb_add(&bar[XB_XGEN(b.x)], 1u);
            asm volatile("s_waitcnt vmcnt(0)" ::: "memory");
        } else {
            XB_SPIN(xb_ld(&bar[XB_XGEN(b.x)]) == gen, bar);
            __builtin_amdgcn_fence(__ATOMIC_ACQUIRE, "agent");
            asm volatile("s_waitcnt vmcnt(0)" ::: "memory");
        }
    }
    __syncthreads();
}

__device__ __forceinline__ float wave_sum(float v) {
#pragma unroll
    for (int o = 1; o < 64; o <<= 1) v += __shfl_xor(v, o);
    return v;
}
struct TrItem { const float* W; const float* gk; bf16* WT; int ldw, src_n0, k0, ldt, dst_n0; };
__device__ __forceinline__ void p0_tr_load(f32x4 (&v)[8], float (&gv)[8], const TrItem& t, const float* gfb, int lane) {
    const int nq = (lane & 7) * 4; const float* gp = t.gk ? t.gk : gfb;
#pragma unroll
    for (int i = 0; i < 8; ++i) { const int kk = 8 * i + (lane >> 3); v[i] = *(const f32x4*)(t.W + (size_t)(t.k0 + kk) * t.ldw + t.src_n0 + nq); gv[i] = gp[t.k0 + kk]; }
}
__device__ __forceinline__ void p0_tr_finish(const f32x4 (&v)[8], const float (&gv)[8], const TrItem& t, LAS float* scr, int lane) {
    const int nq = (lane & 7) * 4;
#pragma unroll
    for (int i = 0; i < 8; ++i) { const int kk = 8 * i + (lane >> 3); const f32x4 x = v[i] * (t.gk ? gv[i] : 1.0f); *(LAS f32x4*)(scr + kk * 36 + nq) = x; }
    LDS_WAIT(); asm volatile("" ::: "memory");
    const int c = lane & 7;
#pragma unroll
    for (int j = 0; j < 4; ++j) { const int n = (lane >> 3) + 8 * j; const LAS float* s = scr + (8 * c) * 36 + n;
        v4u o; o.x = pk2(s[0 * 36], s[1 * 36]); o.y = pk2(s[2 * 36], s[3 * 36]); o.z = pk2(s[4 * 36], s[5 * 36]); o.w = pk2(s[6 * 36], s[7 * 36]);
        *(GAS v4u*)(t.WT + (size_t)(t.dst_n0 + n) * t.ldt + t.k0 + 8 * c) = o; }
    LDS_WAIT(); asm volatile("" ::: "memory");
}
__constant__ float c_invf[8] = {1.0f, 0.19392274474868576f, 0.03760603093086393f, 0.007292664737217109f, 0.001414213562373095f, 0.0002742481756762073f, 5.318295896944988e-05f, 1.031338537721246e-05f};

#ifndef P0_SPLIT
#define P0_SPLIT 1
#endif
#ifndef PLE_FIRST
#define PLE_FIRST 0
#endif
#ifndef S1_FIRST
#define S1_FIRST 0
#endif
#ifndef STG
#define STG 0
#endif
__device__ __forceinline__ void stagger(int bx, int us_step) {
    const int g = (bx >> 3) & 3;
    if (STG && g && us_step) { const unsigned long long t0 = __builtin_amdgcn_s_memrealtime(), dt = (unsigned long long)(g * us_step) * 100ull;
        while (__builtin_amdgcn_s_memrealtime() - t0 < dt) __builtin_amdgcn_s_sleep(16); }
}
#ifndef STG_P1A
#define STG_P1A 6
#define STG_P1B 6
#define STG_P1C 3
#define STG_S1 4
#define STG_S2 3
#define STG_P4 8
#define STG_P5 5
#define STG_P6 14
#define STG_P7 8
#endif
struct Args { const float* in[22]; float* out; unsigned char* ws; int ph_lo, ph_hi, li, pad; };

__global__ void __launch_bounds__(NWAVES * 64, 2) mk_fwd(Args args) {
    extern __shared__ __attribute__((aligned(16))) unsigned char lds_raw[];
    LAS unsigned char* lds = (LAS unsigned char*)lds_raw;
    volatile LAS unsigned* MISC = (volatile LAS unsigned*)(lds + MISC_OFF);
    const int tid = threadIdx.x, lane = tid & 63, wave = __builtin_amdgcn_readfirstlane(tid >> 6);
    const int G = gridDim.x, bx = blockIdx.x, vcu = (G % 8 == 0) ? (bx % 8) * (G / 8) + bx / 8 : bx;
    unsigned char* ws = args.ws;
    gu32* ctl = (gu32*)(ws + WS_CTL);
    volatile LAS unsigned long long* PT = (volatile LAS unsigned long long*)(lds + LDSCTL_OFF + 512);
#define INPTR(k) ((const float*)(((unsigned long long)(unsigned)__builtin_amdgcn_readfirstlane((int)(PT[k] >> 32)) << 32) | (unsigned long long)(unsigned)__builtin_amdgcn_readfirstlane((int)(unsigned)PT[k])))
    float* out = args.out;
    float* ropeC = (float*)(ws + WS_ROPEC); float* ropeS = (float*)(ws + WS_ROPES); float* twc = (float*)(ws + WS_TWC); float* tws = (float*)(ws + WS_TWS);
    bf16 *DFT1 = (bf16*)(ws + WS_DFT1), *DFT2 = (bf16*)(ws + WS_DFT2), *WQKV = (bf16*)(ws + WS_WQKV), *WAB = (bf16*)(ws + WS_WAB), *WOUT = (bf16*)(ws + WS_WOUT), *WUP = (bf16*)(ws + WS_WUP),
         *WDOWN = (bf16*)(ws + WS_WDOWN), *WPLE = (bf16*)(ws + WS_WPLE), *WGATE = (bf16*)(ws + WS_WGATE), *ERAW = (bf16*)(ws + WS_ERAW), *HB = (bf16*)(ws + WS_R1), *ZB = (bf16*)(ws + WS_R1),
         *X1B = (bf16*)(ws + WS_R1), *X2B = (bf16*)(ws + WS_R1), *MIX = (bf16*)(ws + WS_MIX), *KB = (bf16*)(ws + WS_KB), *VB = (bf16*)(ws + WS_VB), *W1 = (bf16*)(ws + WS_W1), *PB = (bf16*)(ws + WS_PB),
         *ACT = (bf16*)(ws + WS_ACT);
    float *ssq_a = (float*)(ws + WS_SSQ_A), *ssq_f = (float*)(ws + WS_SSQ_F), *ssq_x1 = (float*)(ws + WS_SSQ_X1), *ssq_e = (float*)(ws + WS_SSQ_E);

    for (int u = tid; u < (LDS_BYTES - LDSCTL_OFF) / 4; u += NWAVES * 64) ((LAS unsigned*)(lds + LDSCTL_OFF))[u] = 0u;
    __syncthreads();
    if (tid == 0) {
#define PTW(k) PT[k] = (unsigned long long)args.in[k]
        PTW(0); PTW(1); PTW(2); PTW(3); PTW(4); PTW(5); PTW(6); PTW(7); PTW(8); PTW(9); PTW(10); PTW(11); PTW(12); PTW(13); PTW(14); PTW(15); PTW(16); PTW(17); PTW(18); PTW(19); PTW(20); PTW(21);
#undef PTW
    }
    __syncthreads();
    XcdBarrier bar; bar.bar = (unsigned*)(ctl + CW_BAR) + args.li * XCD_BAR_WORDS; bar.x = 0; bar.st = nullptr;
    if (N_LAUNCHES != N_PHASES) bar = xcd_barrier_post((unsigned*)(ctl + CW_BAR) + args.li * XCD_BAR_WORDS, MISC + 8);
#define GRID_BAR() do { if (N_LAUNCHES != N_PHASES) xcd_barrier(bar); } while (0)
    const int lo = args.ph_lo, hi = args.ph_hi;
#ifndef PROBE_SEG
#define PROBE_SEG (-1)
#endif
#ifndef PROBE_AMP
#define PROBE_AMP 4
#endif
    unsigned long long ts0 = 0, ts1 = 0, clk0 = 0, clk1 = 0, rt0 = 0, rt1 = 0;
#ifndef PROBE_SUB
#define PROBE_SUB (-1)
#endif
#define SUBSTAMP(idx) do { if (PROBE_SUB >= 0) { if ((idx) == PROBE_SUB) ts0 = __builtin_amdgcn_s_memrealtime(); if ((idx) == PROBE_SUB + 1) ts1 = __builtin_amdgcn_s_memrealtime(); } } while (0)
#define STAMP(idx) do { if (PROBE_SEG >= 0) { if ((idx) == PROBE_SEG) ts0 = __builtin_amdgcn_s_memrealtime(); if ((idx) == PROBE_SEG + 1) ts1 = __builtin_amdgcn_s_memrealtime(); } } while (0)
    STAMP(0);
#ifndef PH_MASK
#define PH_MASK 0xFF
#endif
#define IN(k) (((PH_MASK >> (k)) & 1) && lo <= (k) && (k) < hi)
#define BOTH(k) (IN(k) && IN((k) + 1))
#ifndef REP_MASK
#define REP_MASK 0
#endif
#define REPS(k) (((REP_MASK >> (k)) & 1) ? 2 : 1)
    LAS unsigned char* ring = lds + RING_OFF; LAS unsigned char* epi = lds + EPI_OFF;

    if (IN(0)) { _Pragma("unroll") for (int rep = 0; rep < REPS(0); ++rep) {
        const float *xp = INPTR(0), *xs = INPTR(1), *pp = INPTR(2), *ps = INPTR(3), *attn_norm = INPTR(4), *w_in = INPTR(5), *w_fourier = INPTR(9), *ao_norm = INPTR(10), *fo_norm = INPTR(11),
                    *w_out = INPTR(12), *ffn_norm = INPTR(13), *w_up = INPTR(14), *w_down = INPTR(17), *w_ple = INPTR(18), *w_gate = INPTR(20);
        const int gw = vcu * NWAVES + wave, NGW = G * NWAVES;
        LAS float* scr = (LAS float*)(ring + wave * 16384);
        const bool tables_first = P0_SPLIT && ((bx >> 3) & 1);
        auto p0_stream = [&]() __attribute__((always_inline)) {
        SUBSTAMP(0);
        {
            f32x4 gv[4];
#pragma unroll
            for (int j = 0; j < 4; ++j) gv[j] = ((const GAS f32x4*)attn_norm)[lane + 64 * j];
#define HB_ROW(mrow_, q) (((mrow_) + (q) * NGW) < T ? ((mrow_) + (q) * NGW) : (mrow_))
#define HB_LOAD(V, mrow_) do { _Pragma("unroll") for (int q = 0; q < 4; ++q) { const int r = HB_ROW(mrow_, q); \
                const float* xrow = r < 2 * SEQ ? xp + (size_t)r * D : xs + (size_t)(r - 2 * SEQ) * D; \
                _Pragma("unroll") for (int j = 0; j < 4; ++j) V[q][j] = __builtin_nontemporal_load((const f32x4*)xrow + lane + 64 * j); } } while (0)
#define HB_NORM(V) do { float s[4]; _Pragma("unroll") for (int q = 0; q < 4; ++q) { s[q] = 0.f; \
                _Pragma("unroll") for (int j = 0; j < 4; ++j) s[q] += (V[q][j].x * V[q][j].x + V[q][j].y * V[q][j].y) + (V[q][j].z * V[q][j].z + V[q][j].w * V[q][j].w); } \
            _Pragma("unroll") for (int o = 1; o < 64; o <<= 1) { _Pragma("unroll") for (int q = 0; q < 4; ++q) s[q] += __shfl_xor(s[q], o); } \
            _Pragma("unroll") for (int q = 0; q < 4; ++q) { const float rstd = 1.f / sqrtf(s[q] * (1.f / D) + EPS); _Pragma("unroll") for (int j = 0; j < 4; ++j) V[q][j] = V[q][j] * rstd * gv[j]; } } while (0)
#define HB_STORE(V, mrow_) do { _Pragma("unroll") for (int q = 0; q < 4; ++q) { GAS unsigned long long* o8 = (GAS unsigned long long*)(HB + (size_t)HB_ROW(mrow_, q) * D) + lane; \
                _Pragma("unroll") for (int j = 0; j < 4; ++j) o8[64 * j] = (unsigned long long)pk2(V[q][j].x, V[q][j].y) | ((unsigned long long)pk2(V[q][j].z, V[q][j].w) << 32); } } while (0)
            if (gw < T) {
                f32x4 va[4][4], vb[4][4];
                HB_LOAD(va, gw);
                for (int mrow = gw; mrow < T; mrow += 8 * NGW) {
                    const bool h1 = mrow + 4 * NGW < T, h2 = mrow + 8 * NGW < T;
                    HB_NORM(va);
                    if (h1) HB_LOAD(vb, mrow + 4 * NGW);
                    HB_STORE(va, mrow);
                    if (h1) { HB_NORM(vb); if (h2) HB_LOAD(va, mrow + 8 * NGW); HB_STORE(vb, mrow + 4 * NGW); }
                }
            }
#undef HB_ROW
#undef HB_LOAD
#undef HB_NORM
#undef HB_STORE
        }
        SUBSTAMP(1);
        {
            constexpr size_t NCH = (size_t)T * PLE / 8; const size_t CST = (size_t)NGW * 64;
#define PB_CH(c0_, q) (((c0_) + (size_t)(q) * CST) < NCH ? ((c0_) + (size_t)(q) * CST) : (c0_))
#define PB_LOAD(A_, B_, c0_) do { _Pragma("unroll") for (int q = 0; q < 4; ++q) { const size_t e0 = PB_CH(c0_, q) * 8, row = e0 / PLE; \
                const float* src = row < (size_t)2 * SEQ ? pp + e0 : ps + (e0 - (size_t)2 * SEQ * PLE); \
                A_[q] = __builtin_nontemporal_load((const f32x4*)src); B_[q] = __builtin_nontemporal_load((const f32x4*)(src + 4)); } } while (0)
#define PB_STORE(A_, B_, c0_) do { _Pragma("unroll") for (int q = 0; q < 4; ++q) { const size_t e0 = PB_CH(c0_, q) * 8; \
                v4u o; o.x = pk2(A_[q].x, A_[q].y); o.y = pk2(A_[q].z, A_[q].w); o.z = pk2(B_[q].x, B_[q].y); o.w = pk2(B_[q].z, B_[q].w); *(v4u*)(PB + e0) = o; } } while (0)
            const size_t cfirst = (size_t)gw * 64 + lane;
            if (cfirst < NCH) {
                f32x4 a0[4], b0[4], a1[4], b1[4];
                PB_LOAD(a0, b0, cfirst);
                for (size_t c0 = cfirst; c0 < NCH; c0 += 8 * CST) {
                    const bool h1 = c0 + 4 * CST < NCH, h2 = c0 + 8 * CST < NCH;
                    if (h1) PB_LOAD(a1, b1, c0 + 4 * CST);
                    PB_STORE(a0, b0, c0);
                    if (h1) { if (h2) PB_LOAD(a0, b0, c0 + 8 * CST); PB_STORE(a1, b1, c0 + 4 * CST); }
                }
            }
#undef PB_CH
#undef PB_LOAD
#undef PB_STORE
        }
        SUBSTAMP(2);
        {
            constexpr int I_QKV = 16 * 24, I_OUT = 16 * 32, I_UP = 16 * 176, I_DOWN = 44 * 32, I_PLE = 4 * 32, I_GATE = 16 * 32;
            constexpr int NIT = I_QKV + I_OUT + I_UP + I_DOWN + I_PLE + I_GATE;
            auto decode = [&](int it) -> TrItem {
                int r = it;
                if (r < I_QKV) { const int kb = r / 24, nb = r % 24, n0 = 32 * nb, tile = n0 >> 8, p = n0 & 255, bj = p >> 7, wcc = (p >> 5) & 3;
                    return TrItem{w_in, nullptr, WQKV, INW, tile * 256 + wcc * 64 + bj * 32, 64 * kb, D, n0}; } r -= I_QKV;
                if (r < I_OUT) { const int kb = r / 32, nb = r % 32; return TrItem{w_out, kb < 8 ? ao_norm : fo_norm - 512, WOUT, D, 32 * nb, 64 * kb, D, 32 * nb}; } r -= I_OUT;
                if (r < I_UP) { const int kb = r / 176, nb = r % 176, n0 = 32 * nb, tile = n0 >> 8, p = n0 & 255, bj = p >> 7;
                    return TrItem{w_up, ffn_norm, WUP, 2 * DFF, bj * DFF + tile * 128 + (p & 127), 64 * kb, D, n0}; } r -= I_UP;
                if (r < I_DOWN) { const int kb = r / 32, nb = r % 32; return TrItem{w_down, nullptr, WDOWN, D, 32 * nb, 64 * kb, DFF, 32 * nb}; } r -= I_DOWN;
                if (r < I_PLE) { const int kb = r / 32, nb = r % 32; return TrItem{w_ple, nullptr, WPLE, D, 32 * nb, 64 * kb, PLE, 32 * nb}; } r -= I_PLE;
                { const int kb = r / 32, nb = r % 32; return TrItem{w_gate, nullptr, WGATE, D, 32 * nb, 64 * kb, D, 32 * nb}; }
            };
            for (int it = gw; it < NIT; it += 3 * NGW) {
                f32x4 va[8], vb[8], vc[8]; float ga[8], gb[8], gc[8];
                const bool h1 = it + NGW < NIT, h2 = it + 2 * NGW < NIT;
                const TrItem ta = decode(it), tb = decode(h1 ? it + NGW : it), tc = decode(h2 ? it + 2 * NGW : it);
                p0_tr_load(va, ga, ta, w_down, lane); p0_tr_load(vb, gb, tb, w_down, lane); p0_tr_load(vc, gc, tc, w_down, lane);
                p0_tr_finish(va, ga, ta, scr, lane);
                if (h1) p0_tr_finish(vb, gb, tb, scr, lane);
                if (h2) p0_tr_finish(vc, gc, tc, scr, lane);
            }
        }
        };
        auto p0_tables = [&]() __attribute__((always_inline)) {
        SUBSTAMP(3);
        for (int idx = vcu * 512 + tid; idx < SEQ * 8; idx += G * 512) {
            const int pos = idx >> 3;
            const float ang = (float)pos * c_invf[idx & 7];
            const double a = (double)ang, rr = a - 6.283185307179586476925 * rint(a * 0.15915494309189533577);
            float sn, cs; sincospif((float)(rr * 0.31830988618379067154), &sn, &cs);
            ropeC[idx] = cs; ropeS[idx] = sn;
        }
        for (int idx = vcu * 512 + tid; idx < 128 * 128; idx += G * 512) {
            const int k1 = idx >> 7, n2 = idx & 127; float sn, cs; sincospif(2.0f * (float)(k1 * n2) / 16384.0f, &sn, &cs); twc[idx] = cs; tws[idx] = sn;
        }
        for (int idx = vcu * 512 + tid; idx < 256 * 256; idx += G * 512) {
            const int r = idx >> 8, k = idx & 255, kr = r & 127, im = r >> 7, part = k >> 7, nn = k & 127;
            float sn, cs; sincospif(2.0f * (float)((kr * nn) & 127) / 128.0f, &sn, &cs);
            const float v1 = im == 0 ? (part == 0 ? cs : -sn) : (part == 0 ? -sn : -cs);
            DFT1[idx] = (bf16)f2bf(v1);
            const float v2 = im == 0 ? (part == 0 ? cs : sn) * (1.0f / 1024.0f) : 0.f;
            DFT2[idx] = (bf16)f2bf(v2);
        }
        SUBSTAMP(4);
        __syncthreads();
        {
            LAS float* Ml = (LAS float*)ring; LAS float* Wl = Ml + 64 * 65; LAS float* Fl = Wl + 64 * 65; LAS float* tg = Fl + 64 * 65;
            for (int item = vcu; item < 256; item += G) {
                const int part = item >> 7, g = (item >> 4) & 7, k0 = 64 * (item & 15);
                if (tid < 64) { float sn, cs; sincospif(2.0f * (float)tid / 64.0f, &sn, &cs); tg[tid] = part == 0 ? cs : sn; }
#pragma unroll
                for (int i = 0; i < 8; ++i) { const int idx = tid + 512 * i, r = idx >> 6, c = idx & 63;
                    Wl[r * 65 + c] = w_in[(size_t)(k0 + r) * INW + 768 + 64 * g + c];
                    Fl[r * 65 + c] = w_fourier[(size_t)g * 4096 + idx]; }
                __syncthreads();
                { const int e = tid & 63;
#pragma unroll 1
                  for (int i = 0; i < 8; ++i) { const int c = (tid >> 6) + 8 * i; float a = 0.f;
#pragma unroll 8
                      for (int j = 0; j < 64; ++j) a += tg[(c * j) & 63] * Fl[j * 65 + e];
                      Ml[c * 65 + e] = a; } }
                __syncthreads();
                { const int e = tid >> 3, kc = (tid & 7) * 8; float a[8];
#pragma unroll
                  for (int kk = 0; kk < 8; ++kk) a[kk] = 0.f;
#pragma unroll 2
                  for (int c = 0; c < 64; ++c) { const float mv = Ml[c * 65 + e];
#pragma unroll
                      for (int kk = 0; kk < 8; ++kk) a[kk] += Wl[(kc + kk) * 65 + c] * mv; }
                  v4u o; o.x = pk2(a[0], a[1]); o.y = pk2(a[2], a[3]); o.z = pk2(a[4], a[5]); o.w = pk2(a[6], a[7]);
                  *(v4u*)(WAB + (size_t)(part * 512 + 64 * g + e) * D + k0 + kc) = o; }
                __syncthreads();
            }
        }
        __syncthreads(); };
        if (tables_first) { p0_tables(); p0_stream(); } else { p0_stream(); p0_tables(); } }
        SUBSTAMP(5);
        if (BOTH(0)) GRID_BAR();
        SUBSTAMP(6);
    }
    STAMP(1);

    if (IN(1)) { _Pragma("unroll") for (int rep = 0; rep < REPS(1); ++rep) {
        const bool ple_first = PLE_FIRST && ((bx & 1) != 0);
#define P1C_BODY() do { pg8::SchedPlain S; S.o.init(T / 256, 4, G, bx); S.A = (const char*)PB; S.B = (const char*)WPLE; S.tA = (size_t)256 * PLE * 2; S.tB = (size_t)256 * PLE * 2; \
            const pg8::Geom g{PLE, PLE * 2, PLE * 2, 128 * PLE * 2, 128 * PLE * 2}; const pg8::EpiPle E{ERAW, ssq_e}; \
            pg8::gemm_phase<pg8::EpiPle, pg8::SchedPlain, true>(ring, epi, g, S, E); } while (0)
        if (ple_first) P1C_BODY();
        {
            pg8::SchedPlain S; S.o.init(T / 256, 3, G, bx); S.A = (const char*)HB; S.B = (const char*)WQKV; S.tA = (size_t)256 * D * 2; S.tB = (size_t)256 * D * 2;
            const pg8::Geom g{D, D * 2, D * 2, 128 * D * 2, 128 * D * 2};
            const pg8::EpiQKV E{MIX, KB, VB, INPTR(6), INPTR(7), ropeC, ropeS};
            stagger(bx, STG_P1A); pg8::gemm_phase<pg8::EpiQKV, pg8::SchedPlain, true>(ring, epi, g, S, E);
        }
        {
            pg8::SchedTokGather S; S.o.init(4, T / 256, G, bx); S.A = (const char*)WAB; S.HB = (const char*)HB; S.tA = (size_t)256 * D * 2;
            const pg8::Geom g{D, D * 2, 128 * D * 2, 128 * D * 2, D * 2};
            const pg8::EpiAB E{W1};
            pg8::gemm_phase<pg8::EpiAB, pg8::SchedTokGather, true>(ring, epi, g, S, E);
        }
        if (!ple_first) P1C_BODY();
#undef P1C_BODY
        }
        if (BOTH(1)) GRID_BAR();
    }
    STAMP(2);

    if (IN(2)) {
        const bool s1_first = S1_FIRST && ((bx & 1) != 0);
#define S1_BODY() do { pg8::SchedPlain S; S.o.init(1, NSEQ * 512 * 128 / 256, G, bx); S.A = (const char*)DFT1; S.B = (const char*)W1; S.tA = 0; S.tB = (size_t)256 * 256 * 2; \
            const pg8::Geom g{256, 512, 512, 128 * 512, 128 * 512}; const pg8::EpiS1 E{ZB, twc, tws}; \
            pg8::gemm_phase<pg8::EpiS1, pg8::SchedPlain, true>(ring, epi, g, S, E); } while (0)
        if (s1_first) S1_BODY();
        { const int per = (attn::NUNITS + G - 1) / G, a0 = vcu * per, a1 = a0 + per < attn::NUNITS ? a0 + per : attn::NUNITS;
          attn::phase(a0, a1, MIX, KB, VB, INPTR(8), INPTR(6), INPTR(7), ssq_a, ring, ts1); }
        LDS_WAIT(); __syncthreads();
        STAMP(3);
        if (!s1_first) S1_BODY();
#undef S1_BODY
        if (BOTH(2)) GRID_BAR();
    }
    STAMP(4);

    if (IN(3)) { _Pragma("unroll") for (int rep = 0; rep < REPS(3); ++rep) {
        pg8::SchedPlain S; S.o.init(1, NSEQ * 128 * 512 / 256, G, bx); S.A = (const char*)DFT2; S.B = (const char*)ZB; S.tA = 0; S.tB = (size_t)256 * 256 * 2;
        const pg8::Geom g{256, 512, 512, 128 * 512, 128 * 512};
        const pg8::EpiS2 E{MIX, ssq_f};
        stagger(bx, STG_S2); pg8::gemm_phase<pg8::EpiS2, pg8::SchedPlain, true>(ring, epi, g, S, E); }
        if (BOTH(3)) GRID_BAR();
    }
    STAMP(5);
#ifdef PROBE_XBAR
    for (int xb = 0; xb < PROBE_XBAR; ++xb) GRID_BAR();
#endif

    if (IN(4)) {
        for (int i = vcu * 512 + tid; i < NSEQ * 256 * (D / 8); i += G * 512) {
            const int sq = i / (256 * (D / 8)), rem = i % (256 * (D / 8)), rr = rem / (D / 8), c8 = rem % (D / 8);
            const int prow = rr == 0 ? 0 : SEQ + rr;
            *(v4u*)(X1B + ((size_t)sq * XPAD + prow) * D + c8 * 8) = (v4u){0u, 0u, 0u, 0u};
        }
        _Pragma("unroll") for (int rep = 0; rep < REPS(4); ++rep) {
        pg8::SchedPlain S; S.o.init(T / 256, 4, G, bx); S.A = (const char*)MIX; S.B = (const char*)WOUT; S.tA = (size_t)256 * D * 2; S.tB = (size_t)256 * D * 2;
        const pg8::Geom g{D, D * 2, D * 2, 128 * D * 2, 128 * D * 2};
        {
            LAS float* tab = (LAS float*)epi; pg8::Unit uu;
            for (int i = 0; i < 3 && S.next(i, uu); ++i)
                if (tid < 256) { const size_t row = (size_t)uu.pm * 256 + tid;
                    const f32x4 a0 = *(const f32x4*)(ssq_a + row * 8), a1 = *(const f32x4*)(ssq_a + row * 8 + 4), f0 = *(const f32x4*)(ssq_f + row * 8), f1 = *(const f32x4*)(ssq_f + row * 8 + 4);
                    const float ra = 1.0f / sqrtf(((a0[0] + a0[1]) + (a0[2] + a0[3]) + (a1[0] + a1[1]) + (a1[2] + a1[3])) * (1.0f / 512.0f) + EPS);
                    const float rf = 1.0f / sqrtf(((f0[0] + f0[1]) + (f0[2] + f0[3]) + (f1[0] + f1[1]) + (f1[2] + f1[3])) * (1.0f / 512.0f) + EPS);
                    tab[(i * 256 + tid) * 2] = ra / rf; tab[(i * 256 + tid) * 2 + 1] = rf; }
            LDS_WAIT(); __syncthreads();
        }
        const pg8::EpiOut E{INPTR(0), INPTR(1), X1B, ssq_x1, (const LAS float*)epi, (LAS float*)(epi + 8192)};
        stagger(bx, STG_P4); pg8::gemm_phase<pg8::EpiOut, pg8::SchedPlain, true>(ring, epi, g, S, E); }
        if (BOTH(4)) GRID_BAR();
    }
    STAMP(6);
#ifdef PROBE_CLK
    clk0 = clock64(); rt0 = __builtin_amdgcn_s_memrealtime();
#endif

    if (IN(5)) { _Pragma("unroll") for (int rep = 0; rep < REPS(5); ++rep) {
        pg8::SchedHalo S; S.o.init(NSEQ * UP_TILES, 2 * DFF / 256, G, bx); S.X1B = (const char*)X1B; S.B = (const char*)WUP; S.tB = (size_t)256 * D * 2;
        const pg8::Geom g{D, D * 2, D * 2, 128 * D * 2, 128 * D * 2};
        const pg8::EpiUp E{INPTR(15), INPTR(16), ssq_x1, ACT};
#ifdef PROBE_P5_LITE
        if (rep + 1 < REPS(5)) { const pg8::EpiLite EL{ACT}; pg8::gemm_phase<pg8::EpiLite, pg8::SchedHalo, true>(ring, epi, g, S, EL); GRID_BAR(); } else
#endif
        { stagger(bx, STG_P5); pg8::gemm_phase<pg8::EpiUp, pg8::SchedHalo, true>(ring, epi, g, S, E); } }
        if (BOTH(5)) GRID_BAR();
    }
    STAMP(7);
#ifdef PROBE_CLK
    clk1 = clock64(); rt1 = __builtin_amdgcn_s_memrealtime();
#endif

    if (IN(6)) { {
        pg8::SchedPlain S; S.o.init(T / 256, 4, G, bx); S.A = (const char*)ACT; S.B = (const char*)WDOWN; S.tA = (size_t)256 * DFF * 2; S.tB = (size_t)256 * DFF * 2;
        const pg8::Geom g{DFF, DFF * 2, DFF * 2, 128 * DFF * 2, 128 * DFF * 2};
        const pg8::EpiDown E{X1B};
        stagger(bx, STG_P6); pg8::gemm_phase<pg8::EpiDown, pg8::SchedPlain, true>(ring, epi, g, S, E); }
        if (BOTH(6)) GRID_BAR();
    }
    STAMP(8);

    if (IN(7)) { _Pragma("unroll") for (int rep = 0; rep < REPS(7); ++rep) {
        pg8::SchedPad S; S.o.init(T / 256, 4, G, bx); S.XB = (const char*)X2B; S.B = (const char*)WGATE; S.tB = (size_t)256 * D * 2;
        const pg8::Geom g{D, D * 2, D * 2, 128 * D * 2, 128 * D * 2};
        {
            LAS float* tab = (LAS float*)epi; pg8::Unit uu;
            for (int i = 0; i < 3 && S.next(i, uu); ++i)
                if (tid < 256) { const float* p = ssq_e + ((size_t)uu.pm * 256 + tid) * 16;
                    const f32x4 a = *(const f32x4*)p, b = *(const f32x4*)(p + 4), c = *(const f32x4*)(p + 8), d = *(const f32x4*)(p + 12);
                    tab[1024 + i * 512 + tid] = INPTR(21)[uu.pn * 256 + tid]; tab[1024 + i * 512 + 256 + tid] = INPTR(19)[uu.pn * 256 + tid];
                    tab[i * 256 + tid] = 1.0f / sqrtf((((a[0] + a[1]) + (a[2] + a[3])) + ((b[0] + b[1]) + (b[2] + b[3])) + ((c[0] + c[1]) + (c[2] + c[3])) + ((d[0] + d[1]) + (d[2] + d[3]))) * (1.0f / 1024.0f) + EPS); }
            LDS_WAIT(); __syncthreads();
        }
#ifndef EG_MODE
#define EG_MODE 0
#endif
        if (rep + 1 < REPS(7)) { const pg8::EpiGateT<EG_MODE> E{out, X2B, ERAW, INPTR(19), INPTR(21), (const LAS float*)epi}; pg8::gemm_phase<pg8::EpiGateT<EG_MODE>, pg8::SchedPad, true>(ring, epi, g, S, E); }
        else { const pg8::EpiGate E{out, X2B, ERAW, INPTR(19), INPTR(21), (const LAS float*)epi}; pg8::gemm_phase<pg8::EpiGate, pg8::SchedPad, true>(ring, epi, g, S, E); } }
    }
    STAMP(9);
#ifdef PROBE_CLK
    { const unsigned long long mhz = (clk1 - clk0) * 100ull / (rt1 - rt0), te = __builtin_amdgcn_s_memrealtime(); while (__builtin_amdgcn_s_memrealtime() - te < mhz * 100ull) __builtin_amdgcn_s_sleep(16); }
#endif
    if (PROBE_SEG >= 0 || PROBE_SUB >= 0 || PROBE_ATT > 0) { const unsigned long long te = __builtin_amdgcn_s_memrealtime(), dt = (ts1 - ts0) * PROBE_AMP; while (__builtin_amdgcn_s_memrealtime() - te < dt) __builtin_amdgcn_s_sleep(16); }
#undef IN
#undef BOTH
#undef GRID_BAR
}

extern "C" void kernel_launch(void* const* d_in, const int* in_sizes, int n_in, void* d_out, int out_size, void* d_ws, size_t ws_size, hipStream_t stream) {
    static int grid = 0;
    if (grid == 0) {
        if (n_in != 22 || in_sizes[0] != 2 * SEQ * D || out_size != T * D || ws_size < WS_END) { fprintf(stderr, "kernel_launch: unexpected shapes (n_in %d, in0 %d, out %d, ws %zu); nothing launched\n", n_in, n_in > 0 ? in_sizes[0] : -1, out_size, ws_size); grid = -1; return; }
        int dev = 0, cus = 0, per_cu = 0;
        if (hipGetDevice(&dev) != hipSuccess || hipDeviceGetAttribute(&cus, hipDeviceAttributeMultiprocessorCount, dev) != hipSuccess) { fprintf(stderr, "kernel_launch: device query failed\n"); grid = -1; return; }
        if (hipFuncSetAttribute((const void*)mk_fwd, hipFuncAttributeMaxDynamicSharedMemorySize, LDS_BYTES) != hipSuccess) { fprintf(stderr, "kernel_launch: hipFuncSetAttribute failed\n"); grid = -1; return; }
        if (hipOccupancyMaxActiveBlocksPerMultiprocessor(&per_cu, (const void*)mk_fwd, NWAVES * 64, LDS_BYTES) != hipSuccess || per_cu < 1)
            fprintf(stderr, "kernel_launch: note: occupancy query reports %d workgroups per CU\n", per_cu);
        (void)hipGetLastError();
        if (cus < 256) { fprintf(stderr, "kernel_launch: built for a 256-CU device (found %d CUs); nothing launched\n", cus); grid = -1; return; }
        grid = 256;
    }
    if (grid < 0) return;
    if (hipMemsetAsync((char*)d_ws + WS_CTL, 0, CTL_ZERO_BYTES, stream) != hipSuccess) { fprintf(stderr, "kernel_launch: memset failed\n"); return; }
    Args a{};
    for (int i = 0; i < 22; ++i) a.in[i] = (const float*)d_in[i];
    a.out = (float*)d_out; a.ws = (unsigned char*)d_ws;
    for (int li = 0; li < N_LAUNCHES; ++li) {
        if (N_LAUNCHES == 1) { a.ph_lo = 0; a.ph_hi = N_PHASES; } else { a.ph_lo = li; a.ph_hi = li + 1; }
        a.li = 0;
        hipLaunchKernelGGL(mk_fwd, dim3(grid), dim3(NWAVES * 64), LDS_BYTES, stream, a);
        const hipError_t le = hipPeekAtLastError();
        if (le != hipSuccess) { fprintf(stderr, "kernel_launch: launch %d failed: %s\n", li, hipGetErrorName(le)); break; }
    }
}
```

```cpp
#include <hip/hip_runtime.h>
#include <cstdio>
#include <cstdint>
#include <cmath>
namespace pg8 {
#define PG8_LAS __attribute__((address_space(3)))
typedef unsigned short bf16_t;
typedef short bf16x8 __attribute__((ext_vector_type(8)));
typedef float f32x4 __attribute__((ext_vector_type(4)));
typedef unsigned u32x4 __attribute__((ext_vector_type(4)));
typedef unsigned u32x2 __attribute__((ext_vector_type(2)));
constexpr int BM = 256, BK = 64, HALF = 128, HTB = HALF * BK * 2  , STAGE_BYTES = 8 * HTB, NXCD = 8, WGM = 8;

__host__ __device__ __forceinline__ int lds_byte(int r, int c) { const int st = (r >> 4) * 2 + (c >> 5), rr = r & 15, cc = c & 31, ob = rr * 64 + cc * 2; return st * 1024 + (ob ^ (((ob >> 9) & 1) << 5)); }
__host__ __device__ __forceinline__ void stage_rc(int b, int& R, int& C) { const int st = b / 1024, sb = b % 1024, swz = sb ^ (((sb >> 9) & 1) << 5); R = (st >> 1) * 16 + swz / 64; C = (st & 1) * 32 + (swz % 64) / 2; }
__host__ __device__ __forceinline__ int perm32(int rho) { const int n = rho >> 4, i = rho & 15; return 8 * (i >> 2) + 4 * n + (i & 3); }

struct Unit { int pm, pn, ui; };
struct Geom { int K; unsigned rsA, rsB, hsA, hsB; };

struct TileOrder {
    int nM, nN, nwg, G, c, heavy;
    __device__ void init(int nM_, int nN_, int G_, int c_) { nM = nM_; nN = nN_; nwg = nM * nN; G = G_; c = c_; heavy = 0; }
    __device__ bool next(int i, Unit& u) const {
        long L = (long)i * G + c;
        if (heavy > 0) {
            const int light = G - heavy, r3 = nwg - G - 2 * light;
            if (i == 0) L = c;
            else if (c < heavy || i > 3 || (i == 3 && c - heavy >= r3)) return false;
            else L = G + (long)(i - 1) * light + (c - heavy);
        }
        if (L >= nwg) return false;
        int wgid = (int)L; { const int q = nwg / NXCD, r = nwg % NXCD, xcd = wgid % NXCD, off = wgid / NXCD; wgid = (xcd < r ? xcd * (q + 1) : r * (q + 1) + (xcd - r) * q) + off; }
        const int nig = WGM * nN, gid = wgid / nig, fm = gid * WGM, gsz = (nM - fm) < WGM ? (nM - fm) : WGM;
        u.pm = fm + ((wgid % nig) % gsz); u.pn = (wgid % nig) / gsz; u.ui = i; return true;
    }
};

__device__ __forceinline__ unsigned cvt_pk_bf16(float lo, float hi) { unsigned r; asm volatile("v_cvt_pk_bf16_f32 %0, %1, %2" : "=v"(r) : "v"(lo), "v"(hi)); return r; }
__device__ __forceinline__ u32x4 pack8(const f32x4 a, const f32x4 b) { u32x4 w; w.x = cvt_pk_bf16(a[0], a[1]); w.y = cvt_pk_bf16(a[2], a[3]); w.z = cvt_pk_bf16(b[0], b[1]); w.w = cvt_pk_bf16(b[2], b[3]); return w; }
__device__ __forceinline__ u32x2 pack4(const f32x4 a) { u32x2 w; w.x = cvt_pk_bf16(a[0], a[1]); w.y = cvt_pk_bf16(a[2], a[3]); return w; }

template <class E, class = void> struct PermA { static constexpr bool v = false; };
template <class E> struct PermA<E, decltype((void)E::PERMA)> { static constexpr bool v = E::PERMA; };
template <class E, class = void> struct IsI8 { static constexpr bool v = false; };
template <class E> struct IsI8<E, decltype((void)E::I8)> { static constexpr bool v = E::I8; };
typedef int i32x4 __attribute__((ext_vector_type(4)));
template <class E, class = void> struct PermA8 { static constexpr bool v = false; };
template <class E> struct PermA8<E, decltype((void)E::PERMA8)> { static constexpr bool v = E::PERMA8; };
template <class Epi, class Sched, bool ALIGN_EPI>
__device__ __forceinline__ void gemm_phase(PG8_LAS unsigned char* lds, PG8_LAS unsigned char* lds_epi, const Geom g, const Sched& S, const Epi& E) {
    int tid = threadIdx.x; asm volatile("" : "+v"(tid));
    const int wid = __builtin_amdgcn_readfirstlane(tid >> 6), lane = tid & 63, wr = wid >> 2, wc = wid & 3, fr = lane & 15, fq = lane >> 4;
    const int K = g.K; int nt = K / BK;
    if constexpr (IsI8<Epi>::v) asm volatile("" : "+s"(nt));
    unsigned voffA[2], voffB[2];
#pragma unroll
    for (int i = 0; i < 2; ++i) { int R, C; stage_rc(tid * 16 + i * 8192, R, C); const int Rb = Epi::PERM ? ((R & ~31) + perm32(R & 31)) : R;
        const int Ra = PermA8<Epi>::v ? (128 * (R >> 6) + 8 * (R & 15) + ((R >> 4) & 3)) : PermA<Epi>::v ? ((R & ~63) + 4 * (R & 15) + ((R >> 4) & 3)) : R;
        voffA[i] = (unsigned)Ra * g.rsA + (unsigned)C * 2u; voffB[i] = (unsigned)Rb * g.rsB + (unsigned)C * 2u; }
    const size_t kstep = (size_t)(BK * 2);
    const size_t hsA = g.hsA, hsB = g.hsB;
    const unsigned ldsw = (unsigned)wid * 1024u;
    const int aoff = lds_byte(wr * 64 + fr, fq * 8), boff = lds_byte(wc * 32 + fr, fq * 8);
#define PG8_SA(b, h) (((b) * 2 + (h)) * HTB)
#define PG8_SB(b, h) ((4 + (b) * 2 + (h)) * HTB)
#define PG8_STAGE(bufoff, gbase, voff) do { _Pragma("unroll") for (int _i = 0; _i < 2; ++_i) \
        __builtin_amdgcn_global_load_lds((const unsigned*)((const char*)(gbase) + (voff)[_i]), (PG8_LAS unsigned*)(lds + (bufoff) + ldsw + _i * 8192), 16, 0, 0); } while (0)
#define PG8_LDA(dst, b, h) do { _Pragma("unroll") for (int m = 0; m < 4; ++m) _Pragma("unroll") for (int k = 0; k < 2; ++k) dst[m][k] = *(const PG8_LAS bf16x8*)(lds + PG8_SA(b, h) + aoff + m * 2048 + k * 1024); } while (0)
#define PG8_LDB(dst, b, h) do { _Pragma("unroll") for (int n = 0; n < 2; ++n) _Pragma("unroll") for (int k = 0; k < 2; ++k) dst[n][k] = *(const PG8_LAS bf16x8*)(lds + PG8_SB(b, h) + boff + n * 2048 + k * 1024); } while (0)
#define PG8_MMA(ai, bj, At, Bt) do { __builtin_amdgcn_s_setprio(1); _Pragma("unroll") for (int m = 0; m < 4; ++m) _Pragma("unroll") for (int n = 0; n < 2; ++n) _Pragma("unroll") for (int k = 0; k < 2; ++k) \
        { if constexpr (IsI8<Epi>::v) acc[ai][bj][m][n] = __builtin_bit_cast(f32x4, __builtin_amdgcn_mfma_i32_16x16x64_i8(__builtin_bit_cast(i32x4, Bt[n][k]), __builtin_bit_cast(i32x4, At[m][k]), __builtin_bit_cast(i32x4, acc[ai][bj][m][n]), 0, 0, 0)); \
          else acc[ai][bj][m][n] = __builtin_amdgcn_mfma_f32_16x16x32_bf16(Bt[n][k], At[m][k], acc[ai][bj][m][n], 0, 0, 0); } __builtin_amdgcn_s_setprio(0); } while (0)
#define PG8_WAIT_V(n) asm volatile("s_waitcnt vmcnt(" #n ")" ::: "memory")
#define PG8_WAIT_L(n) asm volatile("s_waitcnt lgkmcnt(" #n ")" ::: "memory")
#define PG8_BAR __builtin_amdgcn_s_barrier()
#define PG8_SCHED __builtin_amdgcn_sched_barrier(0)
    Unit cur, nxt; int ui = 0;
    if (!S.next(0, cur)) return;
    f32x4 acc[2][2][4][2];
#pragma unroll
    for (int a = 0; a < 2; ++a)
#pragma unroll
        for (int b = 0; b < 2; ++b)
#pragma unroll
            for (int m = 0; m < 4; ++m)
#pragma unroll
                for (int n = 0; n < 2; ++n) acc[a][b][m][n] = (f32x4){0.f, 0.f, 0.f, 0.f};
    bf16x8 At[4][2], B0[2][2], B1[2][2];
    typename Epi::Pre pre;
    const char* cA = S.a_base(cur); const char* cB = S.b_base(cur);
    PG8_STAGE(PG8_SB(0, 0), cB, voffB); PG8_STAGE(PG8_SB(0, 1), cB + hsB, voffB); PG8_STAGE(PG8_SA(0, 0), cA, voffA); PG8_STAGE(PG8_SA(0, 1), cA + hsA, voffA);
    if (wr == 1) PG8_BAR;
    PG8_WAIT_V(2); PG8_BAR;
    PG8_STAGE(PG8_SB(1, 0), cB + kstep, voffB); PG8_STAGE(PG8_SA(1, 0), cA + kstep, voffA); PG8_STAGE(PG8_SB(1, 1), cB + hsB + kstep, voffB);
    PG8_WAIT_V(6); PG8_BAR;
    for (;;) {
        const bool has_next = S.next(ui + 1, nxt);
        E.unit_begin(cur, lds_epi, wid, lane);
        const char* nA = has_next ? S.a_base(nxt) : cA; const char* nB = has_next ? S.b_base(nxt) : cB;
#pragma unroll 1
        for (int t = 0; t < nt; t += 2) {
            const bool last = (t == nt - 2);
            const char* a1 = cA + (size_t)(t + 1) * kstep;
            const char* a2 = last ? nA : cA + (size_t)(t + 2) * kstep; const char* b2 = last ? nB : cB + (size_t)(t + 2) * kstep;
            const char* a3 = a2 + kstep; const char* b3 = b2 + kstep;
            if constexpr (Epi::MIDK) { if (t == Epi::MIDK_T) E.midk(acc, cur, wr, wc, fr, fq); }
            if (last) E.prefetch(pre, cur, wr, wc, fr, fq, lds_epi, wid, lane);
            PG8_LDB(B0, 0, 0); PG8_LDB(B1, 0, 1); PG8_SCHED; PG8_LDA(At, 0, 0); PG8_STAGE(PG8_SA(1, 1), a1 + hsA, voffA);
            PG8_WAIT_V(8); PG8_WAIT_L(0); PG8_BAR; PG8_MMA(0, 0, At, B0); PG8_MMA(0, 1, At, B1); PG8_BAR; PG8_SCHED;
            PG8_LDA(At, 0, 1); PG8_STAGE(PG8_SB(0, 0), b2, voffB); PG8_STAGE(PG8_SB(0, 1), b2 + hsB, voffB); PG8_STAGE(PG8_SA(0, 0), a2, voffA);
            PG8_WAIT_V(8); PG8_WAIT_L(0); PG8_BAR; PG8_MMA(1, 0, At, B0); PG8_MMA(1, 1, At, B1); PG8_BAR; PG8_SCHED;
            PG8_LDB(B0, 1, 0); PG8_LDB(B1, 1, 1); PG8_SCHED; PG8_LDA(At, 1, 0); PG8_STAGE(PG8_SA(0, 1), a2 + hsA, voffA);
            PG8_WAIT_V(8); PG8_WAIT_L(0); PG8_BAR; PG8_MMA(0, 0, At, B0); PG8_MMA(0, 1, At, B1); PG8_BAR; PG8_SCHED;
            PG8_LDA(At, 1, 1); PG8_STAGE(PG8_SB(1, 0), b3, voffB); PG8_STAGE(PG8_SB(1, 1), b3 + hsB, voffB); PG8_STAGE(PG8_SA(1, 0), a3, voffA);
            PG8_WAIT_V(8); PG8_WAIT_L(0); PG8_BAR; PG8_MMA(1, 0, At, B0); PG8_MMA(1, 1, At, B1); PG8_BAR; PG8_SCHED;
        }
        if constexpr (ALIGN_EPI) { if (wr == 0) PG8_BAR; }
        E(acc, pre, cur, wr, wc, fr, fq, lds_epi);
        if (!has_next) break;
#pragma unroll
        for (int a = 0; a < 2; ++a)
#pragma unroll
            for (int b = 0; b < 2; ++b)
#pragma unroll
                for (int m = 0; m < 4; ++m)
#pragma unroll
                    for (int n = 0; n < 2; ++n) acc[a][b][m][n] = (f32x4){0.f, 0.f, 0.f, 0.f};
        cur = nxt; cA = nA; cB = nB; ++ui;
        if constexpr (ALIGN_EPI) { if (wr == 1) PG8_BAR; }
    }
    PG8_WAIT_V(0);
    if constexpr (!ALIGN_EPI) { if (wr == 0) PG8_BAR; }
    PG8_BAR;
#undef PG8_SA
#undef PG8_SB
#undef PG8_STAGE
#undef PG8_LDA
#undef PG8_LDB
#undef PG8_MMA
#undef PG8_WAIT_V
#undef PG8_WAIT_L
#undef PG8_BAR
#undef PG8_SCHED
}
}
constexpr int D = 1024, SEQ = 16384, NSEQ = 3, T = NSEQ * SEQ, DFF = 2816, PLE = 256, INW = 1280;
constexpr int XPAD = 16640;
constexpr int UP_TILES = 65;
constexpr float EPS = 1e-6f;
constexpr float LOG2E = 1.4426950408889634f;
constexpr float QSCALE = 0.125f * LOG2E;

namespace pg8 {
struct SchedPlain {
    TileOrder o; const char* A; const char* B; size_t tA, tB;
    __device__ __forceinline__ bool next(int i, Unit& u) const { return o.next(i, u); }
    __device__ __forceinline__ const char* a_base(const Unit& u) const { return A + (size_t)u.pm * tA; }
    __device__ __forceinline__ const char* b_base(const Unit& u) const { return B + (size_t)u.pn * tB; }
};
struct SchedTokGather {
    TileOrder o; const char* A; const char* HB; size_t tA;
    __device__ __forceinline__ bool next(int i, Unit& u) const { return o.next(i, u); }
    __device__ __forceinline__ const char* a_base(const Unit& u) const { return A + (size_t)u.pm * tA; }
    __device__ __forceinline__ const char* b_base(const Unit& u) const { return HB + ((size_t)(u.pn >> 6) * SEQ + 2 * (u.pn & 63)) * (D * 2); }
};
struct SchedS2 {
    TileOrder o; const char* A; const char* B; size_t tB;
    __device__ __forceinline__ bool next(int i, Unit& u) const { return o.next(i, u); }
    __device__ __forceinline__ const char* a_base(const Unit& u) const { return A + (size_t)((u.pn >> 1) & 127) * 65536; }
    __device__ __forceinline__ const char* b_base(const Unit& u) const { return B + (size_t)u.pn * tB; }
};
struct SchedHalo {
    TileOrder o; const char* X1B; const char* B; size_t tB; int rb;
    __device__ __forceinline__ bool next(int i, Unit& u) const { return o.next(i, u); }
    __device__ __forceinline__ const char* a_base(const Unit& u) const { const int s = u.pm / UP_TILES, ti = u.pm % UP_TILES; return X1B + ((size_t)s * XPAD + 254 * ti) * (size_t)rb; }
    __device__ __forceinline__ const char* b_base(const Unit& u) const { return B + (size_t)u.pn * tB; }
};

struct SchedPad {
    TileOrder o; const char* XB; const char* B; size_t tB;
    __device__ __forceinline__ bool next(int i, Unit& u) const { return o.next(i, u); }
    __device__ __forceinline__ const char* a_base(const Unit& u) const { return XB + ((size_t)(u.pm >> 6) * XPAD + 1 + (size_t)(u.pm & 63) * 256) * (D * 2); }
    __device__ __forceinline__ const char* b_base(const Unit& u) const { return B + (size_t)u.pn * tB; }
};

typedef f32x4 AccT[2][2][4][2];
__device__ __forceinline__ float sum4sq(const f32x4 v) { return (v[0] * v[0] + v[1] * v[1]) + (v[2] * v[2] + v[3] * v[3]); }
__device__ __forceinline__ float red_fq(float s) { s += __shfl_xor(s, 16); s += __shfl_xor(s, 32); return s; }
__device__ __forceinline__ float rsq(float ss, float inv_n) { return __builtin_amdgcn_rsqf(ss * inv_n + EPS); }

struct EpiQKV {
    static constexpr bool PERM = true, MIDK = false; static constexpr int MIDK_T = 0;
    bf16_t* MIX; bf16_t* KB; bf16_t* VB; const float* qg; const float* kg; const float* ropeC; const float* ropeS;
    __device__ __forceinline__ void midk(AccT&, const Unit&, int, int, int, int) const {}
    struct Pre {};
    __device__ __forceinline__ void unit_begin(const Unit&, PG8_LAS unsigned char*, int, int) const {}
    __device__ __forceinline__ void prefetch(Pre&, const Unit& u, int, int, int, int, PG8_LAS unsigned char* lds_epi, int wid, int lane) const {
        asm volatile("" : "+v"(lane));
#pragma unroll
        for (int j = 0; j < 2; ++j) { const int i = 2 * wid + j, tbl = i >> 3, chunk = i & 7, rl = chunk * 32 + (lane >> 1), pos = 128 * (rl & 127) + 2 * (u.pm & 63) + (rl >> 7);
            __builtin_amdgcn_global_load_lds((const unsigned*)((tbl ? ropeS : ropeC) + pos * 8 + (lane & 1) * 4), (PG8_LAS unsigned*)(lds_epi + tbl * 8192 + chunk * 1024), 16, 0, 0); }
    }
    __device__ __forceinline__ void operator()(AccT& acc, Pre& pre, const Unit& u, int wr, int wc, int fr, int fq, PG8_LAS unsigned char* lds_epi) const {
        const PG8_LAS float* ropeCl = (const PG8_LAS float*)lds_epi; const PG8_LAS float* ropeSl = (const PG8_LAS float*)(lds_epi + 8192);
        const int hh = u.pn * 4 + wc; const bool isq = hh < 8, nrm = hh < 10;
        f32x4 gn[2][2];
#pragma unroll
        for (int bj = 0; bj < 2; ++bj)
#pragma unroll
            for (int n = 0; n < 2; ++n) { gn[bj][n] = (f32x4){1.f, 1.f, 1.f, 1.f};
                if (nrm) { const int d0 = (bj == 0 && fq < 2) ? 4 * fq + 8 * n : 32 * bj + 8 * fq + 4 * n; gn[bj][n] = *(const f32x4*)((isq ? qg : kg) + d0); if (isq) gn[bj][n] = gn[bj][n] * QSCALE; } }
        bf16_t* dst; int pitch;
        if (isq) { dst = MIX + hh * 64; pitch = D; } else if (nrm) { dst = KB + (hh - 8) * 64; pitch = 128; } else { dst = VB + (hh - 10) * 64; pitch = 128; }
#pragma unroll
        for (int aim = 0; aim < 4; ++aim) {
            const int ai = aim >> 1;
            f32x4 cs[4], sn[4];
            if (nrm) {
#pragma unroll
                for (int m = 2 * (aim & 1); m < 2 * (aim & 1) + 2; ++m) { const int rl = ai * HALF + wr * 64 + m * 16 + fr;
                    cs[m] = *(const PG8_LAS f32x4*)(ropeCl + rl * 8 + 4 * (fq & 1)); sn[m] = *(const PG8_LAS f32x4*)(ropeSl + rl * 8 + 4 * (fq & 1)); }
            }
#pragma unroll
            for (int m = 2 * (aim & 1); m < 2 * (aim & 1) + 2; ++m) {
                const int row = (u.pm >> 6) * SEQ + 128 * (wr * 64 + m * 16 + fr) + 2 * (u.pm & 63) + ai;
                f32x4 v[2][2];
#pragma unroll
                for (int bj = 0; bj < 2; ++bj)
#pragma unroll
                    for (int n = 0; n < 2; ++n) v[bj][n] = acc[ai][bj][m][n];
                if (nrm) {
                    float ss = (sum4sq(v[0][0]) + sum4sq(v[0][1])) + (sum4sq(v[1][0]) + sum4sq(v[1][1]));
                    ss = red_fq(ss);
                    const float rstd = rsq(ss, 1.0f / 64.0f);
#pragma unroll
                    for (int bj = 0; bj < 2; ++bj)
#pragma unroll
                        for (int n = 0; n < 2; ++n) v[bj][n] = v[bj][n] * rstd * gn[bj][n];
                    {   const f32x4 x1 = v[0][0], x2 = v[0][1];
                        const f32x4 r0 = x1 * cs[m] - x2 * sn[m], r1 = x2 * cs[m] + x1 * sn[m];
                        if (fq < 2) { v[0][0] = r0; v[0][1] = r1; } }
                }
#pragma unroll
                for (int bj = 0; bj < 2; ++bj) *(u32x4*)(dst + (size_t)row * pitch + 32 * bj + 8 * fq) = pack8(v[bj][0], v[bj][1]);
            }
        }
    }
};

struct EpiAB {
    static constexpr bool PERM = true, MIDK = false; static constexpr int MIDK_T = 0;
    signed char* W1Q; float* SW;
    __device__ __forceinline__ void midk(AccT&, const Unit&, int, int, int, int) const {}
    struct Pre {};
    __device__ __forceinline__ void unit_begin(const Unit&, PG8_LAS unsigned char*, int, int) const {}
    __device__ __forceinline__ void prefetch(Pre&, const Unit&, int, int, int, int, PG8_LAS unsigned char*, int, int) const {}
    __device__ __forceinline__ void operator()(AccT& acc, Pre& pre, const Unit& u, int wr, int wc, int fr, int fq, PG8_LAS unsigned char* lds_epi) const {
        const int b = u.pn >> 6, j2 = u.pn & 63;
        PG8_LAS float* red = (PG8_LAS float*)lds_epi;
#pragma unroll
        for (int m = 0; m < 4; ++m)
#pragma unroll
            for (int bj = 0; bj < 2; ++bj) {
                float mx = 0.f;
#pragma unroll
                for (int ai = 0; ai < 2; ++ai)
#pragma unroll
                    for (int n = 0; n < 2; ++n)
#pragma unroll
                        for (int i = 0; i < 4; ++i) mx = fmaxf(mx, fabsf(acc[ai][bj][m][n][i]));
                mx = fmaxf(mx, __shfl_xor(mx, 16)); mx = fmaxf(mx, __shfl_xor(mx, 32));
                if (fq == 0) red[wc * 256 + (wr * 64 + m * 16 + fr) * 2 + bj] = mx;
            }
        asm volatile("s_waitcnt lgkmcnt(0)" ::: "memory"); __builtin_amdgcn_s_barrier(); asm volatile("" ::: "memory");
#pragma unroll
        for (int m = 0; m < 4; ++m) {
            const int el = wr * 64 + m * 16 + fr, e = u.pm * 128 + el;
#pragma unroll
            for (int bj = 0; bj < 2; ++bj) {
                const int ri = el * 2 + bj, n2 = 2 * j2 + bj;
                const float g = fmaxf(fmaxf(fmaxf(red[ri], red[256 + ri]), fmaxf(red[512 + ri], red[768 + ri])), 1e-30f);
                const float inv = 127.0f * __builtin_amdgcn_rcpf(g);
                const size_t wrow = (size_t)(b * 512 + e) * 128 + n2;
                if (wc == 0 && fq == 0) SW[wrow] = g * (1.0f / 127.0f);
#pragma unroll
                for (int ai = 0; ai < 2; ++ai) {
                    u32x2 w = (u32x2){0u, 0u};
#pragma unroll
                    for (int i = 0; i < 4; ++i) {
                        w.x = __builtin_amdgcn_cvt_pk_u8_f32(__builtin_rintf(__builtin_fmaf(acc[ai][bj][m][0][i], inv, 128.0f)), i, w.x);
                        w.y = __builtin_amdgcn_cvt_pk_u8_f32(__builtin_rintf(__builtin_fmaf(acc[ai][bj][m][1][i], inv, 128.0f)), i, w.y);
                    }
                    w.x ^= 0x80808080u; w.y ^= 0x80808080u;
                    *(u32x2*)(W1Q + (wrow * 2 + ai) * 128 + 32 * wc + 8 * fq) = w;
                }
            }
        }
    }
};

struct EpiPle {
    static constexpr bool PERM = true, MIDK = false; static constexpr int MIDK_T = 0;
    unsigned char* ERQ; float* ssq; float* scl;
    __device__ __forceinline__ void midk(AccT&, const Unit&, int, int, int, int) const {}
    struct Pre {};
    __device__ __forceinline__ void unit_begin(const Unit&, PG8_LAS unsigned char*, int, int) const {}
    __device__ __forceinline__ void prefetch(Pre&, const Unit&, int, int, int, int, PG8_LAS unsigned char*, int, int) const {}
    __device__ __forceinline__ void operator()(AccT& acc, Pre& pre, const Unit& u, int wr, int wc, int fr, int fq, PG8_LAS unsigned char*) const {
#pragma unroll
        for (int ai = 0; ai < 2; ++ai)
#pragma unroll
            for (int m = 0; m < 4; ++m) {
                const int row = u.pm * BM + ai * HALF + wr * 64 + m * 16 + fr;
                float s = (sum4sq(acc[ai][0][m][0]) + sum4sq(acc[ai][0][m][1])) + (sum4sq(acc[ai][1][m][0]) + sum4sq(acc[ai][1][m][1]));
                s = red_fq(s);
                float mx = 0.f;
#pragma unroll
                for (int bj = 0; bj < 2; ++bj)
#pragma unroll
                    for (int n = 0; n < 2; ++n)
#pragma unroll
                        for (int i = 0; i < 4; ++i) mx = fmaxf(mx, fabsf(acc[ai][bj][m][n][i]));
                mx = fmaxf(mx, __shfl_xor(mx, 16)); mx = fmaxf(mx, __shfl_xor(mx, 32));
                mx = fmaxf(mx, 1e-30f);
                const float inv = 127.0f * __builtin_amdgcn_rcpf(mx);
                if (fq == 0) { ssq[(size_t)row * 16 + u.pn * 4 + wc] = s; scl[(size_t)row * 16 + u.pn * 4 + wc] = mx * (1.0f / 127.0f); }
#pragma unroll
                for (int bj = 0; bj < 2; ++bj) {
                    u32x2 w = (u32x2){0u, 0u};
#pragma unroll
                    for (int i = 0; i < 4; ++i) {
                        w.x = __builtin_amdgcn_cvt_pk_u8_f32(__builtin_rintf(__builtin_fmaf(acc[ai][bj][m][0][i], inv, 128.0f)), i, w.x);
                        w.y = __builtin_amdgcn_cvt_pk_u8_f32(__builtin_rintf(__builtin_fmaf(acc[ai][bj][m][1][i], inv, 128.0f)), i, w.y);
                    }
                    *(u32x2*)(ERQ + (size_t)row * D + u.pn * BM + bj * HALF + wc * 32 + fq * 8) = w;
                }
            }
    }
};

struct EpiS1 {
    static constexpr bool PERM = true, MIDK = false, I8 = true; static constexpr int MIDK_T = 0;
    signed char* ZBQ; float* SZ; const float* SW;
    __device__ __forceinline__ void midk(AccT&, const Unit&, int, int, int, int) const {}
    struct Pre {};
    __device__ __forceinline__ void unit_begin(const Unit&, PG8_LAS unsigned char*, int, int) const {}
    __device__ __forceinline__ void prefetch(Pre&, const Unit&, int, int, int, int, PG8_LAS unsigned char*, int, int) const {}
    __device__ __forceinline__ void operator()(AccT& acc, Pre& pre, const Unit& u, int wr, int wc, int fr, int fq, PG8_LAS unsigned char* lds_epi) const {
        const int b = u.pn >> 8, e0 = 2 * (u.pn & 255);
        asm volatile("" : "+v"(fq), "+v"(fr));
        PG8_LAS float* red = (PG8_LAS float*)lds_epi;
        f32x4 cs[2][2];
#pragma unroll
        for (int bj = 0; bj < 2; ++bj)
#pragma unroll
            for (int n = 0; n < 2; ++n) cs[bj][n] = *(const f32x4*)(SW + (size_t)(b * 512 + e0 + bj) * 128 + 32 * wc + 8 * fq + 4 * n) * (1.0f / 127.0f);
#pragma unroll
        for (int m = 0; m < 4; ++m)
#pragma unroll
            for (int bj = 0; bj < 2; ++bj)
#pragma unroll
                for (int n = 0; n < 2; ++n)
#pragma unroll
                    for (int ai = 0; ai < 2; ++ai) {
                        const i32x4 q = __builtin_bit_cast(i32x4, acc[ai][bj][m][n]);
                        acc[ai][bj][m][n] = (f32x4){(float)q[0], (float)q[1], (float)q[2], (float)q[3]} * cs[bj][n]; }
#pragma unroll
        for (int m = 0; m < 4; ++m)
#pragma unroll
            for (int bj = 0; bj < 2; ++bj) {
                float mx = 0.f;
#pragma unroll
                for (int ai = 0; ai < 2; ++ai)
#pragma unroll
                    for (int n = 0; n < 2; ++n)
#pragma unroll
                        for (int i = 0; i < 4; ++i) mx = fmaxf(mx, fabsf(acc[ai][bj][m][n][i]));
                mx = fmaxf(mx, __shfl_xor(mx, 16)); mx = fmaxf(mx, __shfl_xor(mx, 32));
                if (fq == 0) red[wc * 256 + (wr * 64 + m * 16 + fr) * 2 + bj] = mx;
            }
        asm volatile("s_waitcnt lgkmcnt(0)" ::: "memory"); __builtin_amdgcn_s_barrier(); asm volatile("" ::: "memory");
#pragma unroll
        for (int m = 0; m < 4; ++m) {
            const int k1 = wr * 64 + m * 16 + fr;
#pragma unroll
            for (int bj = 0; bj < 2; ++bj) {
                const int ri = k1 * 2 + bj;
                const float g = fmaxf(fmaxf(fmaxf(red[ri], red[256 + ri]), fmaxf(red[512 + ri], red[768 + ri])), 1e-30f);
                const float inv = 127.0f * __builtin_amdgcn_rcpf(g);
                const size_t zrow = (size_t)(b * 128 + k1) * 512 + (e0 + bj);
                if (wc == 0 && fq == 0) SZ[zrow] = g * (1.0f / 127.0f);
#pragma unroll
                for (int ai = 0; ai < 2; ++ai) {
                    u32x2 w = (u32x2){0u, 0u};
#pragma unroll
                    for (int i = 0; i < 4; ++i) {
                        w.x = __builtin_amdgcn_cvt_pk_u8_f32(__builtin_rintf(__builtin_fmaf(acc[ai][bj][m][0][i], inv, 128.0f)), i, w.x);
                        w.y = __builtin_amdgcn_cvt_pk_u8_f32(__builtin_rintf(__builtin_fmaf(acc[ai][bj][m][1][i], inv, 128.0f)), i, w.y);
                    }
                    w.x ^= 0x80808080u; w.y ^= 0x80808080u;
                    *(u32x2*)(ZBQ + (zrow * 2 + ai) * 128 + 32 * wc + 8 * fq) = w;
                }
            }
        }
    }
};

struct EpiS2 {
    static constexpr bool PERM = true, MIDK = false, I8 = true; static constexpr int MIDK_T = 0;
    bf16_t* MIX; float* ssq; const float* SZ;
    __device__ __forceinline__ void midk(AccT&, const Unit&, int, int, int, int) const {}
    struct Pre {};
    __device__ __forceinline__ void unit_begin(const Unit&, PG8_LAS unsigned char*, int, int) const {}
    __device__ __forceinline__ void prefetch(Pre&, const Unit&, int, int, int, int, PG8_LAS unsigned char*, int, int) const {}
    __device__ __forceinline__ void operator()(AccT& acc, Pre& pre, const Unit& u, int wr, int wc, int fr, int fq, PG8_LAS unsigned char*) const {
        const int eh = u.pn & 1, k1 = (u.pn >> 1) & 127, b = u.pn >> 8;
#pragma unroll
        for (int bj = 0; bj < 2; ++bj)
#pragma unroll
            for (int n = 0; n < 2; ++n) {
                const f32x4 cs = *(const f32x4*)(SZ + (size_t)(b * 128 + k1) * 512 + eh * 256 + bj * HALF + wc * 32 + fq * 8 + n * 4) * (1.0f / (127.0f * 1024.0f));
#pragma unroll
                for (int m = 0; m < 4; ++m) { const i32x4 q = __builtin_bit_cast(i32x4, acc[0][bj][m][n]); acc[0][bj][m][n] = (f32x4){(float)q[0], (float)q[1], (float)q[2], (float)q[3]} * cs; }
            }
#pragma unroll
        for (int m = 0; m < 4; ++m) {
            const int k2 = wr * 64 + m * 16 + fr; const size_t tok = (size_t)b * SEQ + k1 + 128 * k2;
            float s = (sum4sq(acc[0][0][m][0]) + sum4sq(acc[0][0][m][1])) + (sum4sq(acc[0][1][m][0]) + sum4sq(acc[0][1][m][1]));
            s = red_fq(s);
            if (fq == 0) ssq[tok * 8 + eh * 4 + wc] = s;
#pragma unroll
            for (int bj = 0; bj < 2; ++bj) *(u32x4*)(MIX + tok * D + 512 + eh * 256 + bj * HALF + wc * 32 + fq * 8) = pack8(acc[0][bj][m][0], acc[0][bj][m][1]);
        }
    }
};

struct EpiOut {
    static constexpr bool PERM = true, MIDK = true; static constexpr int MIDK_T = 8;
    const bf16_t* HB; const float* gat; bf16_t* X1B; float* ssq_x1; const PG8_LAS float* tab; PG8_LAS float* red; const PG8_LAS float* rmt;
    struct Pre {};
    __device__ __forceinline__ void unit_begin(const Unit&, PG8_LAS unsigned char*, int, int) const {}
    __device__ __forceinline__ void prefetch(Pre&, const Unit&, int, int, int, int, PG8_LAS unsigned char*, int, int) const {}
    __device__ __forceinline__ void midk(AccT& acc, const Unit& u, int wr, int wc, int fr, int fq) const {
#pragma unroll
        for (int ai = 0; ai < 2; ++ai)
#pragma unroll
            for (int m = 0; m < 4; ++m) {
                const float ratio = tab[(u.ui * 256 + ai * HALF + wr * 64 + m * 16 + fr) * 2];
#pragma unroll
                for (int bj = 0; bj < 2; ++bj)
#pragma unroll
                    for (int n = 0; n < 2; ++n) acc[ai][bj][m][n] = acc[ai][bj][m][n] * ratio;
            }
    }
    __device__ __forceinline__ void operator()(AccT& acc, Pre& pre, const Unit& u, int wr, int wc, int fr, int fq, PG8_LAS unsigned char*) const {
        u32x4 hb[2][2];
        f32x4 ig[2][2];
#pragma unroll
        for (int bj = 0; bj < 2; ++bj)
#pragma unroll
            for (int n = 0; n < 2; ++n) { const f32x4 gg = *(const f32x4*)(gat + u.pn * BM + bj * HALF + wc * 32 + fq * 8 + n * 4);
                ig[bj][n] = (f32x4){__builtin_amdgcn_rcpf(gg[0]), __builtin_amdgcn_rcpf(gg[1]), __builtin_amdgcn_rcpf(gg[2]), __builtin_amdgcn_rcpf(gg[3])}; }
#define EO_LOADQ(q) do { _Pragma("unroll") for (int mm = 0; mm < 2; ++mm) { const int row_ = u.pm * BM + ((q) >> 1) * HALF + wr * 64 + (2 * ((q) & 1) + mm) * 16 + fr; \
            const int rp_ = (row_ & ~(SEQ - 1)) | ((row_ & 127) << 7) | ((row_ >> 7) & 127); \
            _Pragma("unroll") for (int bj = 0; bj < 2; ++bj) hb[mm][bj] = *(const u32x4*)(HB + (size_t)rp_ * D + u.pn * BM + bj * HALF + wc * 32 + fq * 8); } } while (0)
#define EO_MATHQ(q) do { _Pragma("unroll") for (int mm = 0; mm < 2; ++mm) { const int ai_ = (q) >> 1, m_ = 2 * ((q) & 1) + mm, rl_ = u.ui * 256 + ai_ * HALF + wr * 64 + m_ * 16 + fr; const float rf = tab[rl_ * 2 + 1], rm = rmt[rl_]; \
            _Pragma("unroll") for (int bj = 0; bj < 2; ++bj) { const u32x4 w_ = hb[mm][bj]; \
                const f32x4 x0 = (f32x4){__builtin_bit_cast(float, w_.x << 16), __builtin_bit_cast(float, w_.x & 0xffff0000u), __builtin_bit_cast(float, w_.y << 16), __builtin_bit_cast(float, w_.y & 0xffff0000u)}; \
                const f32x4 x1 = (f32x4){__builtin_bit_cast(float, w_.z << 16), __builtin_bit_cast(float, w_.z & 0xffff0000u), __builtin_bit_cast(float, w_.w << 16), __builtin_bit_cast(float, w_.w & 0xffff0000u)}; \
                acc[ai_][bj][m_][0] = x0 * ig[bj][0] * rm + acc[ai_][bj][m_][0] * rf; acc[ai_][bj][m_][1] = x1 * ig[bj][1] * rm + acc[ai_][bj][m_][1] * rf; } } \
            asm volatile("" ::: "memory"); } while (0)
#define EO_STOREQ(q) do { _Pragma("unroll") for (int mm = 0; mm < 2; ++mm) { const int ai_ = (q) >> 1, m_ = 2 * ((q) & 1) + mm; const int rl = ai_ * HALF + wr * 64 + m_ * 16 + fr, row = u.pm * BM + rl; \
            const size_t prow = (size_t)(row >> 14) * XPAD + 1 + (row & (SEQ - 1)); float s = 0.f; \
            _Pragma("unroll") for (int bj = 0; bj < 2; ++bj) { const f32x4 a = acc[ai_][bj][m_][0], b = acc[ai_][bj][m_][1]; \
                *(u32x4*)(X1B + prow * D + u.pn * BM + bj * HALF + wc * 32 + fq * 8) = pack8(a, b); s += sum4sq(a) + sum4sq(b); } \
            s = red_fq(s); if (fq == 0) red[wc * 256 + rl] = s; } } while (0)
        EO_LOADQ(0); EO_MATHQ(0);
        EO_LOADQ(1); EO_STOREQ(0); EO_MATHQ(1);
        EO_LOADQ(2); EO_STOREQ(1); EO_MATHQ(2);
        EO_LOADQ(3); EO_STOREQ(2); EO_MATHQ(3);
        EO_STOREQ(3);
#undef EO_LOADQ
#undef EO_MATHQ
#undef EO_STOREQ
        asm volatile("s_waitcnt lgkmcnt(0)" ::: "memory"); __builtin_amdgcn_s_barrier(); asm volatile("" ::: "memory");
        const int tid = threadIdx.x;
        if (tid < 256) ssq_x1[((size_t)u.pm * BM + tid) * 4 + u.pn] = (red[tid] + red[256 + tid]) + (red[512 + tid] + red[768 + tid]);
    }
};


template <int CTRL, bool BC> __device__ __forceinline__ float dpp_mov(float oldv, float src) {
    return __builtin_bit_cast(float, __builtin_amdgcn_update_dpp(__builtin_bit_cast(int, oldv), __builtin_bit_cast(int, src), CTRL, 0xF, 0xF, BC));
}
struct EpiUp {
    static constexpr bool PERM = true, MIDK = false, PERMA8 = true, I8 = true; static constexpr int MIDK_T = 0;
    const float* cw; const float* cb; const float* ssq_x1; bf16_t* ACT;
    static constexpr int OFF_SSQ = 8192, OFF_PAR = 12288;
    struct Pre {};
    __device__ __forceinline__ void midk(AccT&, const Unit&, int, int, int, int) const {}
    __device__ __forceinline__ void prefetch(Pre&, const Unit&, int, int, int, int, PG8_LAS unsigned char*, int, int) const {}
    __device__ __forceinline__ void unit_begin(const Unit& u, PG8_LAS unsigned char* lds_epi, int wid, int lane) const {
        const float* src; unsigned dst;
        if (wid < 4) { const float* arr = wid < 3 ? cw + (size_t)wid * 2 * DFF : cb; src = arr + (lane >> 5) * DFF + u.pn * 128 + (lane & 31) * 4; dst = OFF_PAR + (u.ui & 1) * 4096 + wid * 1024; }
        else { const int sq = u.pm / UP_TILES, ti = u.pm % UP_TILES; const unsigned tk1 = (unsigned)(sq * SEQ + 254 * ti + (wid - 4) * 64 + lane);
            src = (const float*)((const char*)(ssq_x1 - 4) + tk1 * 16u); dst = OFF_SSQ + (wid - 4) * 1024; }
        __builtin_amdgcn_global_load_lds((const unsigned*)src, (PG8_LAS unsigned*)(lds_epi + dst), 16, 0, 0);
    }
    __device__ __forceinline__ void operator()(AccT& acc, Pre&, const Unit& u, int wr, int wc, int fr, int fq, PG8_LAS unsigned char* lds_epi) const {
        const int sq = u.pm / UP_TILES, ti = u.pm % UP_TILES, tok0 = 254 * ti - 1;
        asm volatile("" : "+v"(fq), "+v"(fr));
        PG8_LAS float* H = (PG8_LAS float*)lds_epi;
        const PG8_LAS float* SSQ = (const PG8_LAS float*)(lds_epi + OFF_SSQ);
        const PG8_LAS float* PAR = (const PG8_LAS float*)(lds_epi + OFF_PAR + (u.ui & 1) * 4096);
        {
            f32x4 p[2][4];
#pragma unroll
            for (int ai = 0; ai < 2; ++ai)
#pragma unroll
                for (int m = 0; m < 4; ++m) p[ai][m] = *(const PG8_LAS f32x4*)(SSQ + (wr * 128 + 8 * fr + 4 * ai + m) * 4);
#pragma unroll
            for (int ai = 0; ai < 2; ++ai)
#pragma unroll
                for (int m = 0; m < 4; ++m) {
                    const int tk = tok0 + wr * 128 + 8 * fr + 4 * ai + m;
                    const float rr = __builtin_amdgcn_rsqf((p[ai][m][0] + p[ai][m][1] + p[ai][m][2]) * (1.0f / 1024.0f) + EPS) * p[ai][m][3];
                    const float r2 = (unsigned)tk < (unsigned)SEQ ? rr : 0.f;
#pragma unroll
                    for (int bj = 0; bj < 2; ++bj)
#pragma unroll
                        for (int n = 0; n < 2; ++n) { const i32x4 q_ = __builtin_bit_cast(i32x4, acc[ai][bj][m][n]); acc[ai][bj][m][n] = (f32x4){(float)q_[0], (float)q_[1], (float)q_[2], (float)q_[3]} * r2; }
                }
        }
#pragma unroll
        for (int bj = 0; bj < 2; ++bj)
#pragma unroll
            for (int n = 0; n < 2; ++n) {
                const int col = bj * HALF + wc * 32 + fq * 8 + n * 4;
                if (fr == 0) *(PG8_LAS f32x4*)(H + (wr * 2 + 0) * 256 + col) = acc[0][bj][0][n];
                if (fr == 15) *(PG8_LAS f32x4*)(H + (wr * 2 + 1) * 256 + col) = acc[1][bj][3][n];
            }
        asm volatile("s_waitcnt lgkmcnt(0)" ::: "memory"); __builtin_amdgcn_s_barrier(); asm volatile("" ::: "memory");
        const int chl = wc * 32 + fq * 8;
        u32x2 pk0[8];
#pragma unroll
        for (int n = 0; n < 2; ++n) {
            f32x4 w0[2], w1[2], w2[2], bb[2], hp[2], hn[2];
#pragma unroll
            for (int bj = 0; bj < 2; ++bj) {
                const int pc = bj * 128 + chl + n * 4;
                w0[bj] = *(const PG8_LAS f32x4*)(PAR + pc); w1[bj] = *(const PG8_LAS f32x4*)(PAR + 256 + pc); w2[bj] = *(const PG8_LAS f32x4*)(PAR + 512 + pc); bb[bj] = *(const PG8_LAS f32x4*)(PAR + 768 + pc);
                const int col = bj * HALF + chl + n * 4;
                hp[bj] = wr > 0 ? *(const PG8_LAS f32x4*)(H + ((wr - 1) * 2 + 1) * 256 + col) : (f32x4){0.f, 0.f, 0.f, 0.f};
                hn[bj] = wr < 1 ? *(const PG8_LAS f32x4*)(H + ((wr + 1) * 2 + 0) * 256 + col) : (f32x4){0.f, 0.f, 0.f, 0.f};
            }
            f32x4 pv0[2], nv7[2];
#pragma unroll
            for (int bj = 0; bj < 2; ++bj)
#pragma unroll
                for (int i = 0; i < 4; ++i) {
                    pv0[bj][i] = dpp_mov<0x111, false>(hp[bj][i], acc[1][bj][3][n][i]);
                    nv7[bj][i] = dpp_mov<0x101, false>(hn[bj][i], acc[0][bj][0][n][i]);
                }
#pragma unroll
            for (int r8 = 0; r8 < 8; ++r8) {
                f32x4 hc[2];
#pragma unroll
                for (int bj = 0; bj < 2; ++bj) {
                    const f32x4 pv = r8 > 0 ? acc[(r8 > 0 ? r8 - 1 : 0) >> 2][bj][(r8 > 0 ? r8 - 1 : 0) & 3][n] : pv0[bj];
                    const f32x4 nv = r8 < 7 ? acc[(r8 < 7 ? r8 + 1 : 7) >> 2][bj][(r8 < 7 ? r8 + 1 : 7) & 3][n] : nv7[bj];
                    hc[bj] = __builtin_elementwise_fma(pv, w0[bj], __builtin_elementwise_fma(acc[r8 >> 2][bj][r8 & 3][n], w1[bj], __builtin_elementwise_fma(nv, w2[bj], bb[bj])));
                }
                const f32x4 t = hc[0], gu = hc[0] * hc[1];
                f32x4 ex; ex[0] = __builtin_amdgcn_exp2f(t[0]); ex[1] = __builtin_amdgcn_exp2f(t[1]); ex[2] = __builtin_amdgcn_exp2f(t[2]); ex[3] = __builtin_amdgcn_exp2f(t[3]);
                const f32x4 dn = ex + 1.0f;
                f32x4 rc; rc[0] = __builtin_amdgcn_rcpf(dn[0]); rc[1] = __builtin_amdgcn_rcpf(dn[1]); rc[2] = __builtin_amdgcn_rcpf(dn[2]); rc[3] = __builtin_amdgcn_rcpf(dn[3]);
                const u32x2 pkv = pack4(gu * rc);
                if (n == 0) pk0[r8] = pkv;
                else { const int rl = wr * 128 + 8 * fr + r8, tk = tok0 + rl;
                    if (rl >= 1 && rl <= 254 && tk < SEQ) { u32x4 w; w.x = pk0[r8].x; w.y = pk0[r8].y; w.z = pkv.x; w.w = pkv.y;
                        *(u32x4*)(ACT + ((size_t)sq * SEQ + tk) * DFF + u.pn * 128 + chl) = w; } }
            }
        }
    }
};

struct EpiLite {
    static constexpr bool PERM = true, MIDK = false; static constexpr int MIDK_T = 0;
    bf16_t* O;
    __device__ __forceinline__ void midk(AccT&, const Unit&, int, int, int, int) const {}
    struct Pre {};
    __device__ __forceinline__ void unit_begin(const Unit&, PG8_LAS unsigned char*, int, int) const {}
    __device__ __forceinline__ void prefetch(Pre&, const Unit&, int, int, int, int, PG8_LAS unsigned char*, int, int) const {}
    __device__ __forceinline__ void operator()(AccT& acc, Pre& pre, const Unit& u, int wr, int wc, int fr, int fq, PG8_LAS unsigned char*) const {
#pragma unroll
        for (int ai = 0; ai < 2; ++ai)
#pragma unroll
            for (int m = 0; m < 4; ++m) {
                int row = u.pm * 254 + ai * HALF + wr * 64 + m * 16 + fr; row = row < T - 1 ? row : T - 2;
#pragma unroll
                for (int bj = 0; bj < 2; ++bj) {
#ifdef PROBE_NULL_EPI
                    const u32x4 w = pack8(acc[ai][bj][m][0], acc[ai][bj][m][1]);
                    if (w.x == 0x7fc17fc1u) *(u32x4*)(O + (size_t)row * DFF + u.pn * 128 + bj * HALF + wc * 32 + fq * 8) = w;
#else
                    *(u32x4*)(O + (size_t)row * DFF + u.pn * 128 + bj * HALF + wc * 32 + fq * 8) = pack8(acc[ai][bj][m][0], acc[ai][bj][m][1]);
#endif
                }
            }
    }
};

#ifndef ED_NT
#define ED_NT 0
#endif
struct EpiDown {
    static constexpr bool PERM = true, MIDK = false; static constexpr int MIDK_T = 0;
    bf16_t* XB;
    __device__ __forceinline__ void midk(AccT&, const Unit&, int, int, int, int) const {}
    struct Pre { u32x4 x[2][2]; };
    __device__ __forceinline__ void unit_begin(const Unit&, PG8_LAS unsigned char*, int, int) const {}
#define ED_ADDR(gq, bj) (XB + ((size_t)((u.pm * BM + ((gq) >> 2) * HALF + wr * 64 + ((gq) & 3) * 16 + fr) >> 14) * XPAD + 1 + ((u.pm * BM + ((gq) >> 2) * HALF + wr * 64 + ((gq) & 3) * 16 + fr) & (SEQ - 1))) * D + u.pn * BM + (bj) * HALF + wc * 32 + fq * 8)
    __device__ __forceinline__ void prefetch(Pre& pre, const Unit& u, int wr, int wc, int fr, int fq, PG8_LAS unsigned char*, int, int) const {
#pragma unroll
        for (int gq = 0; gq < 2; ++gq)
#pragma unroll
            for (int bj = 0; bj < 2; ++bj) pre.x[gq][bj] = ED_NT ? __builtin_nontemporal_load((const u32x4*)ED_ADDR(gq, bj)) : *(const u32x4*)ED_ADDR(gq, bj);
    }
    __device__ __forceinline__ void operator()(AccT& acc, Pre& pre, const Unit& u, int wr, int wc, int fr, int fq, PG8_LAS unsigned char*) const {
        u32x4 xb[8][2];
#pragma unroll
        for (int bj = 0; bj < 2; ++bj) { xb[0][bj] = pre.x[0][bj]; xb[1][bj] = pre.x[1][bj]; }
#pragma unroll
        for (int gq = 2; gq < 8; ++gq)
#pragma unroll
            for (int bj = 0; bj < 2; ++bj) xb[gq][bj] = ED_NT ? __builtin_nontemporal_load((const u32x4*)ED_ADDR(gq, bj)) : *(const u32x4*)ED_ADDR(gq, bj);
#pragma unroll
        for (int gq = 0; gq < 8; ++gq) {
            const int ai = gq >> 2, m = gq & 3;
#pragma unroll
            for (int bj = 0; bj < 2; ++bj) {
                const u32x4 w = xb[gq][bj];
                const f32x4 a = {__builtin_bit_cast(float, w.x << 16), __builtin_bit_cast(float, w.x & 0xffff0000u), __builtin_bit_cast(float, w.y << 16), __builtin_bit_cast(float, w.y & 0xffff0000u)};
                const f32x4 b = {__builtin_bit_cast(float, w.z << 16), __builtin_bit_cast(float, w.z & 0xffff0000u), __builtin_bit_cast(float, w.w << 16), __builtin_bit_cast(float, w.w & 0xffff0000u)};
                *(u32x4*)ED_ADDR(gq, bj) = pack8(a + acc[ai][bj][m][0], b + acc[ai][bj][m][1]);
            }
        }
    }
#undef ED_ADDR
};

#ifndef EG_NT
#define EG_NT 0
#endif
template <int MODE> struct EpiGateT {
    static constexpr bool PERM = false, MIDK = false; static constexpr int MIDK_T = 0;
    float* out; const bf16_t* X2B; const unsigned char* ERQ; const float* gple; const float* bg; const PG8_LAS float* tab;
    __device__ __forceinline__ void midk(AccT&, const Unit&, int, int, int, int) const {}
    struct Pre {};
    __device__ __forceinline__ void unit_begin(const Unit&, PG8_LAS unsigned char*, int, int) const {}
#define EG_ROW(gq) (u.pm * BM + ((gq) >> 2) * HALF + wr * 64 + ((gq) & 3) * 16 + fr)
#define EG_COL(bj, n) (u.pn * BM + (bj) * HALF + wc * 32 + (n) * 16 + fq * 4)
#define EG_PROW(row_) ((size_t)((row_) >> 14) * XPAD + 1 + ((row_) & (SEQ - 1)))
    __device__ __forceinline__ void prefetch(Pre&, const Unit&, int, int, int, int, PG8_LAS unsigned char*, int, int) const {}
    __device__ __forceinline__ void operator()(AccT& acc, Pre& pre, const Unit& u, int wr, int wc, int fr, int fq, PG8_LAS unsigned char*) const {
        const PG8_LAS float* bgt = tab + 3072 + u.ui * 512 + wc * 32 + fq * 4;
        u32x2 yb[4][2][2]; unsigned eb[4][2][2];
#define EG_LOADH(ai) do { _Pragma("unroll") for (int m = 0; m < 4; ++m) { const int row_ = EG_ROW((ai) * 4 + m); _Pragma("unroll") for (int bj = 0; bj < 2; ++bj) _Pragma("unroll") for (int n = 0; n < 2; ++n) { \
            if (MODE != 2 && MODE != 4) { yb[m][bj][n] = *(const u32x2*)(X2B + EG_PROW(row_) * D + EG_COL(bj, n)); eb[m][bj][n] = EG_NT ? __builtin_nontemporal_load((const unsigned*)(ERQ + (size_t)row_ * D + EG_COL(bj, n))) : *(const unsigned*)(ERQ + (size_t)row_ * D + EG_COL(bj, n)); } \
            else { yb[m][bj][n] = (u32x2){(unsigned)row_, 1u}; eb[m][bj][n] = (unsigned)row_; } } } } while (0)
#define EG_MATH(ai) do { _Pragma("unroll") for (int m = 0; m < 4; ++m) { const float re = tab[(u.ui * 256 + (ai) * HALF + wr * 64 + m * 16 + fr) * 4 + wc]; \
            _Pragma("unroll") for (int bj = 0; bj < 2; ++bj) _Pragma("unroll") for (int n = 0; n < 2; ++n) { \
                const f32x4 bvv = *(const PG8_LAS f32x4*)(bgt + bj * HALF + 16 * n), gvv = *(const PG8_LAS f32x4*)(bgt + 256 + bj * HALF + 16 * n); \
                const unsigned e1 = eb[m][bj][n]; const u32x2 y2 = yb[m][bj][n]; \
                const f32x4 ev = {(float)(e1 & 0xffu) - 128.0f, (float)((e1 >> 8) & 0xffu) - 128.0f, (float)((e1 >> 16) & 0xffu) - 128.0f, (float)(e1 >> 24) - 128.0f}; \
                f32x4 y = {__builtin_bit_cast(float, y2.x << 16), __builtin_bit_cast(float, y2.x & 0xffff0000u), __builtin_bit_cast(float, y2.y << 16), __builtin_bit_cast(float, y2.y & 0xffff0000u)}; \
                const f32x4 z = acc[ai][bj][m][n] + bvv; \
                _Pragma("unroll") for (int i = 0; i < 4; ++i) { if (MODE == 4) y[i] += z[i]; else y[i] += __builtin_amdgcn_rcpf(1.0f + __builtin_amdgcn_exp2f(-z[i] * LOG2E)) * ev[i] * re * gvv[i]; } \
                acc[ai][bj][m][n] = y; } } \
            asm volatile("" ::: "memory"); } while (0)
#define EG_STOREH(ai) do { _Pragma("unroll") for (int m = 0; m < 4; ++m) { const size_t row = (size_t)EG_ROW((ai) * 4 + m); _Pragma("unroll") for (int bj = 0; bj < 2; ++bj) _Pragma("unroll") for (int n = 0; n < 2; ++n) { \
            const f32x4 y = acc[ai][bj][m][n]; if (MODE != 1 || y[0] == 1.2345e30f) *(f32x4*)(out + row * D + EG_COL(bj, n)) = y; } } } while (0)
        EG_LOADH(0);
        EG_MATH(0);
        EG_LOADH(1);
        EG_STOREH(0);
        EG_MATH(1);
        EG_STOREH(1);
#undef EG_LOADH
#undef EG_MATH
#undef EG_STOREH
    }
#undef EG_ROW
#undef EG_COL
#undef EG_PROW
};
typedef EpiGateT<0> EpiGate;
}
#ifndef PROBE_ATT
#define PROBE_ATT 0
#endif
namespace attn {
typedef unsigned short bf16_t;
typedef short bf16x8 __attribute__((ext_vector_type(8)));
typedef short s16x4 __attribute__((ext_vector_type(4)));
typedef float f32x16 __attribute__((ext_vector_type(16)));
typedef float f32x2 __attribute__((ext_vector_type(2)));
typedef float f32x4 __attribute__((ext_vector_type(4)));
typedef unsigned u32x4 __attribute__((ext_vector_type(4)));
typedef unsigned u32x2 __attribute__((ext_vector_type(2)));
#define ATT_LAS __attribute__((address_space(3)))
constexpr int NSLOT = 6, NKEY = NSLOT * 64, KROW = 144, KS_BYTES = NKEY * KROW, VPLANE = NKEY * 64, VS_OFF = KS_BYTES, LDS_BYTES = KS_BYTES + 2 * VPLANE;
constexpr int NUNITS = NSEQ * 2 * (SEQ / 64);
__device__ __forceinline__ int crow(int r, int hi) { return (r & 3) + 8 * (r >> 2) + 4 * hi; }
__device__ __forceinline__ s16x4 vtr(const ATT_LAS unsigned char* p) { return __builtin_bit_cast(s16x4, __builtin_amdgcn_ds_read_tr16_b64_v4i16((ATT_LAS s16x4*)p)); }
__device__ __forceinline__ int slot_of(int kb6) { return kb6 >= NSLOT ? kb6 - NSLOT : kb6; }

__device__ __forceinline__ void load_blk(u32x4& rk, u32x4& rv, int uid, int kb, const pg8::bf16_t* KB, const pg8::bf16_t* VB) {
    int tid = threadIdx.x; asm volatile("" : "+v"(tid));
    const int kvh = (uid >> 8) & 1, b = uid >> 9, row = tid >> 3, ch = tid & 7;
    int k = kb * 64 + row; k = k < 0 ? 0 : (k > SEQ - 1 ? SEQ - 1 : k);
    const size_t g = ((size_t)b * SEQ + k) * 128 + kvh * 64 + ch * 8; rk = *(const u32x4*)(KB + g); rv = *(const u32x4*)(VB + g);
}
__device__ __forceinline__ void stash_blk(const u32x4& rk, const u32x4& rv, int slot, ATT_LAS unsigned char* lds) {
    int tid = threadIdx.x; asm volatile("" : "+v"(tid));
    const int row = slot * 64 + (tid >> 3), ch = tid & 7;
    *(ATT_LAS u32x4*)(lds + row * KROW + ch * 16) = rk;
    *(ATT_LAS u32x4*)(lds + VS_OFF + (ch >> 2) * VPLANE + row * 64 + (ch & 3) * 16) = rv;
}
__device__ __forceinline__ void load_q(bf16x8 (&q)[4], int uid, const pg8::bf16_t* MIX) {
    int tid = threadIdx.x; asm volatile("" : "+v"(tid));
    const int lane = tid & 63, r32 = lane & 31, hi = lane >> 5, wid = __builtin_amdgcn_readfirstlane(tid >> 6);
    const int qb = uid & 255, kvh = (uid >> 8) & 1, b = uid >> 9, hq = kvh * 4 + (wid >> 1);
    const size_t tok = (size_t)b * SEQ + qb * 64 + (wid & 1) * 32 + r32;
#pragma unroll
    for (int d0 = 0; d0 < 4; ++d0) q[d0] = *(const bf16x8*)(MIX + tok * D + hq * 64 + d0 * 16 + hi * 8);
}
constexpr int TAB_OFF = LDS_BYTES, TAB_BYTES = 3 * 4 * 64 * 16;
__device__ __forceinline__ void compute(int uid, int next_uid, const bf16x8 (&qf)[4], bf16x8 (&qn)[4], const u32x4& rk, const u32x4& rv, float sink2, float negM, const f32x16& cinit, pg8::bf16_t* MIX, float* ssq_a, ATT_LAS unsigned char* lds) {
    int tid = threadIdx.x; asm volatile("" : "+v"(tid));
    const int lane = tid & 63, r32 = lane & 31, hi = lane >> 5; const int wid = __builtin_amdgcn_readfirstlane(tid >> 6);
    const int qb = uid & 255, kvh = (uid >> 8) & 1, b = uid >> 9;
    const int q0 = qb * 64;
    const int st_lo = qb == 0 ? 4 : (qb == 1 ? 2 : 0), st_hi = qb == 255 ? 6 : (qb == 254 ? 8 : 10);
    const bool edge = qb < 2 || qb >= 254;
    const int base6 = (qb + 4) % NSLOT;
    const int hq = kvh * 4 + (wid >> 1), sb = wid & 1, qi = sb * 32 + r32;
    const size_t tok = (size_t)b * SEQ + q0 + qi;
    const float l = __builtin_amdgcn_exp2f(sink2 + negM);
    f32x16 o0, o1, ls;
#pragma unroll
    for (int r = 0; r < 16; ++r) { o0[r] = 0.f; o1[r] = 0.f; ls[r] = 0.f; }
    const bf16x8 ones = (bf16x8){0x3F80, 0x3F80, 0x3F80, 0x3F80, 0x3F80, 0x3F80, 0x3F80, 0x3F80};
    const ATT_LAS unsigned char* kp = lds + r32 * KROW + hi * 16;
    const ATT_LAS unsigned char* vp = lds + VS_OFF + (4 * hi + ((lane & 15) >> 2)) * 64 + ((lane >> 4) & 1) * 32 + (lane & 3) * 8;
    const ATT_LAS unsigned char* tp = lds + TAB_OFF + lane * 16;
#pragma unroll
    for (int g = 0; g < 3; ++g) {
        f32x16 s[3];
        const int st0 = sb + 3 * g;
        int rb[3];
#pragma unroll
        for (int j = 0; j < 3; ++j) rb[j] = slot_of(base6 + ((st0 + j) >> 1)) * 64 + ((st0 + j) & 1) * 32;
        const int jm = g == 0 ? 0 : (g == 2 ? 2 : -1);
        if (jm >= 0) {
            const bool in = st0 + jm >= st_lo && st0 + jm < st_hi;
            const ATT_LAS unsigned char* tq = tp + (in ? (g == 2 ? 4096 : 0) : 8192);
#pragma unroll
            for (int r4 = 0; r4 < 4; ++r4) { const f32x4 t = *(const ATT_LAS f32x4*)(tq + r4 * 1024); s[jm][4 * r4] = t[0]; s[jm][4 * r4 + 1] = t[1]; s[jm][4 * r4 + 2] = t[2]; s[jm][4 * r4 + 3] = t[3]; }
        }
#pragma unroll
        for (int d0 = 0; d0 < 4; ++d0)
#pragma unroll
            for (int j = 0; j < 3; ++j) {
                const bf16x8 kf = *(const ATT_LAS bf16x8*)(kp + rb[j] * KROW + d0 * 32);
                s[j] = __builtin_amdgcn_mfma_f32_32x32x16_bf16(kf, qf[d0], (d0 == 0 && j != jm) ? cinit : s[j], 0, 0, 0);
            }
        if (edge) {
#pragma unroll
            for (int j = 0; j < 3; ++j)
                if (j != jm && !(st0 + j >= st_lo && st0 + j < st_hi)) {
#pragma unroll
                    for (int r = 0; r < 16; ++r) s[j][r] = -1e30f;
                }
        }
        if (g == 2) load_q(qn, next_uid, MIX);
        __builtin_amdgcn_sched_barrier(0);
#pragma unroll
        for (int r = 0; r < 16; ++r) s[0][r] = __builtin_amdgcn_exp2f(s[0][r]);
#pragma unroll
        for (int j = 0; j < 3; ++j) {
            __builtin_amdgcn_sched_barrier(0);
            asm volatile("s_nop 0");
            bf16x8 pf[2];
#pragma unroll
            for (int ks = 0; ks < 2; ++ks) {
                u32x4 pw;
                pw.x = pg8::cvt_pk_bf16(s[j][8 * ks + 0], s[j][8 * ks + 1]); pw.y = pg8::cvt_pk_bf16(s[j][8 * ks + 2], s[j][8 * ks + 3]);
                pw.z = pg8::cvt_pk_bf16(s[j][8 * ks + 4], s[j][8 * ks + 5]); pw.w = pg8::cvt_pk_bf16(s[j][8 * ks + 6], s[j][8 * ks + 7]);
                pf[ks] = __builtin_bit_cast(bf16x8, pw);
            }
            __builtin_amdgcn_sched_barrier(0);
            if (j < 2) {
#pragma unroll
                for (int r = 0; r < 16; ++r) s[j + 1][r] = __builtin_amdgcn_exp2f(s[j + 1][r]);
            }
#pragma unroll
            for (int ks = 0; ks < 2; ++ks) {
                const ATT_LAS unsigned char* vq = vp + (rb[j] + 16 * ks) * 64;
                const s16x4 a0 = vtr(vq), a1 = vtr(vq + 8 * 64), b0 = vtr(vq + VPLANE), b1 = vtr(vq + VPLANE + 8 * 64);
                const bf16x8 vf0 = (bf16x8){a0[0], a0[1], a0[2], a0[3], a1[0], a1[1], a1[2], a1[3]};
                const bf16x8 vf1 = (bf16x8){b0[0], b0[1], b0[2], b0[3], b1[0], b1[1], b1[2], b1[3]};
                o0 = __builtin_amdgcn_mfma_f32_32x32x16_bf16(vf0, pf[ks], o0, 0, 0, 0);
                o1 = __builtin_amdgcn_mfma_f32_32x32x16_bf16(vf1, pf[ks], o1, 0, 0, 0);
                ls = __builtin_amdgcn_mfma_f32_32x32x16_bf16(ones, pf[ks], ls, 0, 0, 0);
            }
        }
        if (g == 1) stash_blk(rk, rv, slot_of(base6 + 5), lds);
        __builtin_amdgcn_sched_barrier(0);
    }
    const float ltot = l + ls[0], inv = __builtin_amdgcn_rcpf(ltot);
    float ss = 0.f;
#pragma unroll
    for (int r = 0; r < 16; ++r) { o0[r] *= inv; o1[r] *= inv; ss += o0[r] * o0[r] + o1[r] * o1[r]; }
    ss += __shfl_xor(ss, 32);
    ssq_a[tok * 8 + hq] = ss;
    pg8::bf16_t* op = MIX + tok * D + hq * 64 + 4 * hi;
#pragma unroll
    for (int rg = 0; rg < 4; ++rg) {
        u32x2 w0, w1;
        w0.x = pg8::cvt_pk_bf16(o0[4 * rg], o0[4 * rg + 1]); w0.y = pg8::cvt_pk_bf16(o0[4 * rg + 2], o0[4 * rg + 3]);
        w1.x = pg8::cvt_pk_bf16(o1[4 * rg], o1[4 * rg + 1]); w1.y = pg8::cvt_pk_bf16(o1[4 * rg + 2], o1[4 * rg + 3]);
        *(u32x2*)(op + 8 * rg) = w0; *(u32x2*)(op + 32 + 8 * rg) = w1;
    }
}
__device__ __forceinline__ void phase(int u0, int u1, pg8::bf16_t* MIX, const pg8::bf16_t* KB, const pg8::bf16_t* VB, const float* sink, const float* qg, const float* kg, float* ssq_a, ATT_LAS unsigned char* lds, unsigned long long& tacc) {
#define ATT_T(k, sgn) do { if (PROBE_ATT == (k)) { asm volatile("s_waitcnt lgkmcnt(0)" ::: "memory"); tacc sgn __builtin_amdgcn_s_memrealtime(); } } while (0)
    if (u0 >= u1) return;
    int uid = u0;
    bf16x8 qn[4]; u32x4 fk[5], fv[5];
#define ATT_RUN_LOADS() do { const int qb_ = uid & 255; _Pragma("unroll") for (int i = 0; i < 5; ++i) load_blk(fk[i], fv[i], uid, qb_ - 2 + i, KB, VB); load_q(qn, uid, MIX); } while (0)
    ATT_RUN_LOADS();
    const int wq = __builtin_amdgcn_readfirstlane((int)threadIdx.x >> 6) >> 1;
#define ATT_UNI(x) __builtin_bit_cast(float, __builtin_amdgcn_readfirstlane(__builtin_bit_cast(int, (float)(x))))
    const float sk0 = ATT_UNI(sink[wq] * LOG2E), sk1 = ATT_UNI(sink[4 + wq] * LOG2E);
    float gq = fabsf(qg[threadIdx.x & 63]), gk = fabsf(kg[threadIdx.x & 63]);
#pragma unroll
    for (int o = 1; o < 64; o <<= 1) { gq = fmaxf(gq, __shfl_xor(gq, o)); gk = fmaxf(gk, __shfl_xor(gk, o)); }
    const float negM = ATT_UNI(-(64.0f * QSCALE * 1.02f) * gq * gk);
#undef ATT_UNI
    {
        const int lane = threadIdx.x & 63, r32 = lane & 31, hi = lane >> 5, w = __builtin_amdgcn_readfirstlane((int)threadIdx.x >> 6);
        const int tb = w >> 2, r4 = w & 3;
        f32x4 t;
#pragma unroll
        for (int i = 0; i < 4; ++i) { const int c = crow(4 * r4 + i, hi); t[i] = (tb == 0 ? c >= r32 : c <= r32) ? negM : -1e30f; }
        *(ATT_LAS f32x4*)(lds + TAB_OFF + tb * 4096 + r4 * 1024 + lane * 16) = t;
        if (w < 4) *(ATT_LAS f32x4*)(lds + TAB_OFF + 8192 + w * 1024 + lane * 16) = (f32x4){-1e30f, -1e30f, -1e30f, -1e30f};
    }
    f32x16 cinit;
#pragma unroll
    for (int r = 0; r < 16; ++r) cinit[r] = negM;
#pragma unroll 1
    for (;;) {
        const int run_end = (uid | 255) + 1 < u1 ? (uid | 255) + 1 : u1;
        {
            const int qb = uid & 255, base6 = (qb + 4) % NSLOT;
            asm volatile("s_waitcnt lgkmcnt(0)" ::: "memory"); __builtin_amdgcn_s_barrier(); asm volatile("" ::: "memory");
#pragma unroll
            for (int i = 0; i < 5; ++i) stash_blk(fk[i], fv[i], slot_of(base6 + i), lds);
            __builtin_amdgcn_s_waitcnt(0);
            __builtin_amdgcn_s_barrier(); asm volatile("" ::: "memory");
        }
#pragma unroll 1
        for (; uid < run_end; ++uid) {
            ATT_T(1, -=);
#pragma unroll
            for (int d0 = 0; d0 < 4; ++d0) asm volatile("" : "+v"(qn[d0]));
            u32x4 rk, rv; load_blk(rk, rv, uid, (uid & 255) + 3, KB, VB);
            __builtin_amdgcn_sched_barrier(0);
            bf16x8 qf[4];
#pragma unroll
            for (int d0 = 0; d0 < 4; ++d0) qf[d0] = qn[d0];
            ATT_T(2, -=);
            compute(uid, uid + 1 < u1 ? uid + 1 : uid, qf, qn, rk, rv, ((uid >> 8) & 1) ? sk1 : sk0, negM, cinit, MIX, ssq_a, lds);
            ATT_T(2, +=); ATT_T(3, -=);
            asm volatile("s_waitcnt lgkmcnt(0)" ::: "memory"); __builtin_amdgcn_s_barrier(); asm volatile("" ::: "memory");
            ATT_T(3, +=); ATT_T(1, +=);
        }
        if (uid >= u1) break;
        ATT_RUN_LOADS();
    }
#undef ATT_RUN_LOADS
}
}
constexpr int NWAVES = 8;
#ifndef MK_N_LAUNCHES
#define MK_N_LAUNCHES 1
#endif
constexpr int N_PHASES = 8;
constexpr int N_LAUNCHES = MK_N_LAUNCHES;

constexpr size_t MiB = 1u << 20;
constexpr size_t WS_CTL = 0, CTL_ZERO_BYTES = 64 * 1024;
constexpr size_t WS_ROPEC = 1 * MiB, WS_ROPES = WS_ROPEC + 512 * 1024;
constexpr size_t WS_TWC = 2 * MiB, WS_TWS = WS_TWC + 64 * 1024;
constexpr size_t WS_DFT1 = WS_TWS + 64 * 1024, WS_DFT2 = WS_DFT1 + 128 * 1024;
constexpr size_t WS_CWS = WS_DFT2 + 128 * 1024;
static_assert(WS_CWS + (size_t)4 * 2 * DFF * 4 <= 3 * MiB, "tables region");
constexpr size_t WS_RMSX = WS_CWS + (size_t)4 * 2 * DFF * 4;
static_assert(WS_RMSX + (size_t)T * 4 <= 3 * MiB, "tables region");
constexpr size_t WS_WQKV = 3 * MiB;
constexpr size_t WS_WAB = WS_WQKV + 768 * 1024 * 2;
constexpr size_t WS_WOUT = WS_WAB + 2 * MiB;
constexpr size_t WS_WUP = WS_WOUT + 2 * MiB;
constexpr size_t WS_WDOWN = WS_WUP + 11 * MiB;
constexpr size_t WS_WPLE = WS_WDOWN + (size_t)1024 * 2816 * 2;
constexpr size_t WS_WGATE = WS_WPLE + 512 * 1024;
constexpr size_t WS_WEND = WS_WGATE + 2 * MiB;
static_assert(WS_WEND <= 30 * MiB, "weights region");
constexpr size_t WS_ERAW = 30 * MiB;
constexpr size_t WS_DFT2K = WS_ERAW + 52 * MiB;
constexpr size_t WS_SCL = WS_ERAW + 48 * MiB;
static_assert(WS_SCL + (size_t)T * 16 * 4 <= WS_DFT2K && WS_DFT2K + 8 * MiB <= 126 * MiB, "e_raw region");
constexpr size_t WS_SSQ_A = 126 * MiB, WS_SSQ_F = WS_SSQ_A + (size_t)T * 8 * 4, WS_SSQ_X1 = WS_SSQ_F + (size_t)T * 8 * 4, WS_SSQ_E = WS_SSQ_X1 + (size_t)T * 16 * 4;
static_assert(WS_SSQ_E + (size_t)T * 16 * 4 <= 136 * MiB, "ssq region");
constexpr size_t WS_R1 = 136 * MiB;
constexpr size_t WS_X1 = 400 * MiB;
constexpr size_t WS_MIX = 234 * MiB;
constexpr size_t WS_KB = 330 * MiB, WS_VB = 342 * MiB;
constexpr size_t WS_W1 = 354 * MiB;
constexpr size_t WS_PB = 450 * MiB;
constexpr size_t WS_ACT = 136 * MiB;
constexpr size_t WS_END = 498 * MiB;
static_assert(WS_X1 + (size_t)NSEQ * XPAD * D * 2 <= WS_END && WS_ACT + (size_t)T * DFF * 2 <= WS_X1 && WS_PB + (size_t)T * PLE * 2 <= WS_END && WS_R1 + (size_t)T * D * 2 <= WS_MIX && (size_t)T * D * 2 <= (size_t)T * D * 4, "d_ws map");
constexpr int CW_BAR = 4096;

constexpr int RING_OFF = 0, RING_BYTES = 131072, EPI_OFF = RING_BYTES, EPI_BYTES = 20480;
constexpr int LDSCTL_OFF = EPI_OFF + EPI_BYTES, MISC_OFF = LDSCTL_OFF + 320;
constexpr int LDS_BYTES = LDSCTL_OFF + 1024;
static_assert(attn::TAB_OFF + attn::TAB_BYTES <= RING_BYTES, "attention LDS");

#define GAS __attribute__((address_space(1)))
#define LAS __attribute__((address_space(3)))
typedef unsigned short bf16;
typedef unsigned v4u __attribute__((ext_vector_type(4)));
typedef float f32x4 __attribute__((ext_vector_type(4)));
typedef GAS unsigned gu32;
#define RLX_AGENT __ATOMIC_RELAXED, __HIP_MEMORY_SCOPE_AGENT
#define LDS_WAIT() asm volatile("s_waitcnt lgkmcnt(0)" ::: "memory")
#define VM_WAIT() asm volatile("s_waitcnt vmcnt(0)" ::: "memory")
__device__ __forceinline__ unsigned f2bf(float f) { unsigned u = __builtin_bit_cast(unsigned, f); return (u + 0x7fffu + ((u >> 16) & 1u)) >> 16; }
__device__ __forceinline__ unsigned pk2(float lo, float hi) { return f2bf(lo) | (f2bf(hi) << 16); }

#define XB_TMO      128
#define XB_XCNT(j)  (256  + 64 * (j))
#define XB_XSUB(j)  (1280 + 64 * (j))
#define XB_XGEN(j)  (2304 + 64 * (j))
#define XB_TOP      3328
#define XB_TOPGEN   3392
#define XCD_BAR_WORDS 3456
#define XB_SPIN_CAP (1u << 18)
#ifndef XB_FAST
#define XB_FAST 1
#endif
__device__ __forceinline__ unsigned xb_ld(unsigned* p)              { return __hip_atomic_load(p, __ATOMIC_RELAXED, __HIP_MEMORY_SCOPE_AGENT); }
__device__ __forceinline__ unsigned xb_add(unsigned* p, unsigned v) { return __hip_atomic_fetch_add(p, v, __ATOMIC_RELAXED, __HIP_MEMORY_SCOPE_AGENT); }
__device__ __forceinline__ unsigned xb_xcc_id() { return (unsigned)__builtin_amdgcn_s_getreg((3 << 11) | 20) & 0xFu; }
#define XB_SPIN(cond, bar) do { unsigned _sp = 0; while (cond) { __builtin_amdgcn_s_sleep(1); \
    if ((++_sp & 255u) == 0u) { if (xb_ld(&(bar)[XB_TMO])) break; if (_sp > XB_SPIN_CAP) { atomicAdd(&(bar)[XB_TMO], 1u); break; } } } } while (0)
struct XcdBarrier { unsigned* bar; unsigned x; volatile LAS unsigned* st; };
__device__ __forceinline__ XcdBarrier xcd_barrier_post(unsigned* bar, volatile LAS unsigned* st) {
    XcdBarrier b; b.bar = bar; b.x = xb_xcc_id(); b.st = st;
    if (threadIdx.x == 0) (void)xb_add(&bar[XB_XCNT(b.x)], 1u);
    return b;
}
__device__ __forceinline__ void xcd_barrier_complete(unsigned* bar, unsigned x, unsigned& nloc, unsigned& nx) {
    const unsigned G = gridDim.x * gridDim.y * gridDim.z;
    unsigned sum, cnt, mine, sp = 0u;
    for (;;) {
        sum = 0u; cnt = 0u; mine = 0u;
#pragma unroll
        for (unsigned j = 0; j < 16; ++j) { const unsigned c = xb_ld(&bar[XB_XCNT(j)]); sum += c; cnt += (c > 0u) ? 1u : 0u; mine = (j == x) ? c : mine; }
        if (sum == G) break;
        __builtin_amdgcn_s_sleep(1);
        if ((++sp & 255u) == 0u) { if (xb_ld(&bar[XB_TMO])) break; if (sp > XB_SPIN_CAP) { atomicAdd(&bar[XB_TMO], 1u); break; } }
    }
    nloc = mine > 0u ? mine : 1u; nx = cnt > 0u ? cnt : 1u;
}
__device__ __forceinline__ void xcd_barrier(const XcdBarrier& b) {
    asm volatile("s_waitcnt vmcnt(0)" ::: "memory");
    __syncthreads();
    if (threadIdx.x == 0) {
        unsigned* bar = b.bar;
        __builtin_amdgcn_s_waitcnt(0);
        unsigned nloc = b.st[0], nx = b.st[1];
        if (nloc == 0u) { xcd_barrier_complete(bar, b.x, nloc, nx); b.st[0] = nloc; b.st[1] = nx; }
        const unsigned old = xb_add(&bar[XB_XSUB(b.x)], 1u);
        const unsigned gen = old / nloc;
        if (old + 1u == (gen + 1u) * nloc) {
            __builtin_amdgcn_fence(__ATOMIC_RELEASE, "agent");
            asm volatile("s_waitcnt vmcnt(0)" ::: "memory");
            const unsigned og = xb_add(&bar[XB_TOP], 1u);
            const unsigned tg = og / nx;
#if XB_FAST
            if (og + 1u != (tg + 1u) * nx) XB_SPIN(xb_ld(&bar[XB_TOP]) < (tg + 1u) * nx, bar);
            __builtin_amdgcn_fence(__ATOMIC_ACQUIRE, "agent");
            (void)xb_add(&bar[XB_XGEN(b.x)], 1u);
#else
            if (og + 1u == (tg + 1u) * nx) xb_add(&bar[XB_TOPGEN], 1u);
            else XB_SPIN(xb_ld(&bar[XB_TOPGEN]) == tg, bar);
            __builtin_amdgcn_fence(__ATOMIC_ACQUIRE, "agent");
            xb_add(&bar[XB_XGEN(b.x)], 1u);
            asm volatile("s_waitcnt vmcnt(0)" ::: "memory");
#endif
        } else {
            XB_SPIN(xb_ld(&bar[XB_XGEN(b.x)]) == gen, bar);
            __builtin_amdgcn_fence(__ATOMIC_ACQUIRE, "agent");
            asm volatile("s_waitcnt vmcnt(0)" ::: "memory");
        }
    }
    __syncthreads();
}

__device__ __forceinline__ float wave_sum(float v) {
#pragma unroll
    for (int o = 1; o < 64; o <<= 1) v += __shfl_xor(v, o);
    return v;
}
struct TrItem { const float* W; const float* gk; bf16* WT; int ldw, src_n0, k0, ldt, dst_n0, perm; };
#ifndef TR_NT
#define TR_NT 0
#endif
__device__ __forceinline__ void p0_tr_load(f32x4 (&v)[8], float (&gv)[8], const TrItem& t, const float* gfb, int lane) {
    const int nq = (lane & 7) * 4; const float* gp = t.gk ? t.gk : gfb;
#pragma unroll
    for (int i = 0; i < 8; ++i) { const int kk = 8 * i + (lane >> 3); v[i] = TR_NT ? __builtin_nontemporal_load((const f32x4*)(t.W + (size_t)(t.k0 + kk) * t.ldw + t.src_n0 + nq)) : *(const f32x4*)(t.W + (size_t)(t.k0 + kk) * t.ldw + t.src_n0 + nq); gv[i] = gp[t.k0 + kk]; }
}
__device__ __forceinline__ void p0_tr_finish(const f32x4 (&v)[8], const float (&gv)[8], const TrItem& t, LAS float* scr, int lane) {
    const int nq = (lane & 7) * 4;
#pragma unroll
    for (int i = 0; i < 8; ++i) { const int kk = 8 * i + (lane >> 3); const f32x4 x = v[i] * (t.gk ? gv[i] : 1.0f); *(LAS f32x4*)(scr + kk * 36 + nq) = x; }
    LDS_WAIT(); asm volatile("" ::: "memory");
    const int c = lane & 7;
#pragma unroll
    for (int j = 0; j < 4; ++j) { const int n = (lane >> 3) + 8 * j; const LAS float* s = scr + (8 * c) * 36 + n;
        v4u o; o.x = pk2(s[0 * 36], s[1 * 36]); o.y = pk2(s[2 * 36], s[3 * 36]); o.z = pk2(s[4 * 36], s[5 * 36]); o.w = pk2(s[6 * 36], s[7 * 36]);
        *(GAS v4u*)(t.WT + (size_t)(t.dst_n0 + ((t.perm && n >= 4 && n < 12) ? (n ^ 12) : n)) * t.ldt + t.k0 + 8 * c) = o; }
    LDS_WAIT(); asm volatile("" ::: "memory");
}
__constant__ float c_invf[8] = {1.0f, 0.19392274474868576f, 0.03760603093086393f, 0.007292664737217109f, 0.001414213562373095f, 0.0002742481756762073f, 5.318295896944988e-05f, 1.031338537721246e-05f};

#ifndef P0_SPLIT
#define P0_SPLIT 1
#endif
#ifndef P1C_HEAVY
#define P1C_HEAVY 64
#endif
#ifndef PBQ
#define PBQ 6
#endif
#ifndef P0_NTS
#define P0_NTS 0
#endif
#ifndef P0_NT
#define P0_NT 1
#endif
#ifndef LATE_W
#define LATE_W 1
#endif
#ifndef PLE_FIRST
#define PLE_FIRST 1
#endif
#ifndef S1_FIRST
#define S1_FIRST 0
#endif
#ifndef STG
#define STG 0
#endif
__device__ __forceinline__ void stagger(int bx, int us_step) {
    const int g = STG == 2 ? (bx & 1) : (bx >> 3) & 3;
    if (STG && g && us_step) { const unsigned long long t0 = __builtin_amdgcn_s_memrealtime(), dt = (unsigned long long)(g * us_step) * 100ull;
        while (__builtin_amdgcn_s_memrealtime() - t0 < dt) __builtin_amdgcn_s_sleep(16); }
}
#ifndef STG_P1A
#define STG_P1A 6
#define STG_P1B 6
#define STG_P1C 3
#define STG_S1 4
#define STG_S2 3
#define STG_P4 8
#define STG_P5 5
#define STG_P6 14
#define STG_P7 8
#endif
struct Args { const float* in[22]; float* out; unsigned char* ws; int ph_lo, ph_hi, li, pad; };

__global__ void __launch_bounds__(NWAVES * 64, 2) mk_fwd(Args args) {
    extern __shared__ __attribute__((aligned(16))) unsigned char lds_raw[];
    LAS unsigned char* lds = (LAS unsigned char*)lds_raw;
    volatile LAS unsigned* MISC = (volatile LAS unsigned*)(lds + MISC_OFF);
    const int tid = threadIdx.x, lane = tid & 63, wave = __builtin_amdgcn_readfirstlane(tid >> 6);
    const int G = gridDim.x, bx = blockIdx.x, vcu = (G % 8 == 0) ? (bx % 8) * (G / 8) + bx / 8 : bx;
    unsigned char* ws = args.ws;
    gu32* ctl = (gu32*)(ws + WS_CTL);
    volatile LAS unsigned long long* PT = (volatile LAS unsigned long long*)(lds + LDSCTL_OFF + 512);
#define INPTR(k) ((const float*)(((unsigned long long)(unsigned)__builtin_amdgcn_readfirstlane((int)(PT[k] >> 32)) << 32) | (unsigned long long)(unsigned)__builtin_amdgcn_readfirstlane((int)(unsigned)PT[k])))
    float* out = args.out;
    float* ropeC = (float*)(ws + WS_ROPEC); float* ropeS = (float*)(ws + WS_ROPES); float* twc = (float*)(ws + WS_TWC); float* tws = (float*)(ws + WS_TWS);
    bf16 *DFT1 = (bf16*)(ws + WS_DFT1), *DFT2 = (bf16*)(ws + WS_DFT2), *WQKV = (bf16*)(ws + WS_WQKV), *WAB = (bf16*)(ws + WS_WAB), *WOUT = (bf16*)(ws + WS_WOUT), *WUP = (bf16*)(ws + WS_WUP),
         *WDOWN = (bf16*)(ws + WS_WDOWN), *WPLE = (bf16*)(ws + WS_WPLE), *WGATE = (bf16*)(ws + WS_WGATE), *HB = (bf16*)(ws + WS_R1), *ZB = (bf16*)args.out,
         *X1B = (bf16*)(ws + WS_X1), *X2B = (bf16*)(ws + WS_X1), *MIX = (bf16*)(ws + WS_MIX), *KB = (bf16*)(ws + WS_KB), *VB = (bf16*)(ws + WS_VB), *W1 = (bf16*)(ws + WS_W1), *PB = (bf16*)(ws + WS_PB),
         *ACT = (bf16*)(ws + WS_ACT);
    float* RMSX = (float*)(ws + WS_RMSX);
#define X1Q ((signed char*)args.out)
#define WUPQ ((signed char*)args.out + 128 * MiB)
#define SWU ((float*)((char*)args.out + 136 * MiB))
    signed char* W1Q = (signed char*)(ws + WS_W1); float* SW = (float*)(ws + WS_W1 + 48 * MiB);
    signed char* ZBQ = (signed char*)args.out; float* SZ = (float*)((char*)args.out + 64 * MiB);
    unsigned char* ERQ = ws + WS_ERAW; float* SCL = (float*)(ws + WS_SCL);
    float *ssq_a = (float*)(ws + WS_SSQ_A), *ssq_f = (float*)(ws + WS_SSQ_F), *ssq_x1 = (float*)(ws + WS_SSQ_X1), *ssq_e = (float*)(ws + WS_SSQ_E);

    for (int u = tid; u < (LDS_BYTES - LDSCTL_OFF) / 4; u += NWAVES * 64) ((LAS unsigned*)(lds + LDSCTL_OFF))[u] = 0u;
    __syncthreads();
    if (tid == 0) {
#define PTW(k) PT[k] = (unsigned long long)args.in[k]
        PTW(0); PTW(1); PTW(2); PTW(3); PTW(4); PTW(5); PTW(6); PTW(7); PTW(8); PTW(9); PTW(10); PTW(11); PTW(12); PTW(13); PTW(14); PTW(15); PTW(16); PTW(17); PTW(18); PTW(19); PTW(20); PTW(21);
#undef PTW
    }
    __syncthreads();
    XcdBarrier bar; bar.bar = (unsigned*)(ctl + CW_BAR) + args.li * XCD_BAR_WORDS; bar.x = 0; bar.st = nullptr;
    if (N_LAUNCHES != N_PHASES) bar = xcd_barrier_post((unsigned*)(ctl + CW_BAR) + args.li * XCD_BAR_WORDS, MISC + 8);
#define GRID_BAR() do { if (N_LAUNCHES != N_PHASES) xcd_barrier(bar); } while (0)
    const int lo = args.ph_lo, hi = args.ph_hi;
#ifndef PROBE_SEG
#define PROBE_SEG (-1)
#endif
#ifndef PROBE_AMP
#define PROBE_AMP 4
#endif
    unsigned long long ts0 = 0, ts1 = 0, clk0 = 0, clk1 = 0, rt0 = 0, rt1 = 0;
#ifndef PROBE_SUB
#define PROBE_SUB (-1)
#endif
#define SUBSTAMP(idx) do { if (PROBE_SUB >= 0) { if ((idx) == PROBE_SUB) ts0 = __builtin_amdgcn_s_memrealtime(); if ((idx) == PROBE_SUB + 1) ts1 = __builtin_amdgcn_s_memrealtime(); } } while (0)
#define STAMP(idx) do { if (PROBE_SEG >= 0) { if ((idx) == PROBE_SEG) ts0 = __builtin_amdgcn_s_memrealtime(); if ((idx) == PROBE_SEG + 1) ts1 = __builtin_amdgcn_s_memrealtime(); } } while (0)
    STAMP(0);
#ifndef PH_MASK
#define PH_MASK 0xFF
#endif
#define IN(k) (((PH_MASK >> (k)) & 1) && lo <= (k) && (k) < hi)
#define BOTH(k) (IN(k) && IN((k) + 1))
#ifndef REP_MASK
#define REP_MASK 0
#endif
#define REPS(k) (((REP_MASK >> (k)) & 1) ? 2 : 1)
    LAS unsigned char* ring = lds + RING_OFF; LAS unsigned char* epi = lds + EPI_OFF;

    if (IN(0)) { _Pragma("unroll") for (int rep = 0; rep < REPS(0); ++rep) {
        int lane = (int)threadIdx.x & 63; asm volatile("" : "+v"(lane));
        const float *xp = INPTR(0), *xs = INPTR(1), *pp = INPTR(2), *ps = INPTR(3), *attn_norm = INPTR(4), *w_in = INPTR(5), *w_fourier = INPTR(9), *ao_norm = INPTR(10), *fo_norm = INPTR(11),
                    *w_out = INPTR(12), *ffn_norm = INPTR(13), *w_up = INPTR(14), *w_down = INPTR(17), *w_ple = INPTR(18), *w_gate = INPTR(20);
        const int gw = vcu * NWAVES + wave, NGW = G * NWAVES;
        LAS float* scr = (LAS float*)(ring + wave * 16384);
        const bool tables_first = P0_SPLIT == 1 ? (((bx >> 3) & 1) != 0) : P0_SPLIT == 2 ? (((bx >> 3) & 3) == 1) : P0_SPLIT == 3 ? (((bx >> 3) & 3) != 0) : false;
        auto p0_stream = [&]() __attribute__((always_inline)) {
        SUBSTAMP(0);
        {
            f32x4 gv[4];
#pragma unroll
            for (int j = 0; j < 4; ++j) gv[j] = ((const GAS f32x4*)attn_norm)[lane + 64 * j];
#define HB_ROW(mrow_, q) (((mrow_) + (q) * NGW) < T ? ((mrow_) + (q) * NGW) : (mrow_))
#define HB_LOAD(V, mrow_) do { _Pragma("unroll") for (int q = 0; q < 4; ++q) { const int r = HB_ROW(mrow_, q); \
                const float* xrow = r < 2 * SEQ ? xp + (size_t)r * D : xs + (size_t)(r - 2 * SEQ) * D; \
                _Pragma("unroll") for (int j = 0; j < 4; ++j) V[q][j] = P0_NT ? __builtin_nontemporal_load((const f32x4*)xrow + lane + 64 * j) : *((const f32x4*)xrow + lane + 64 * j); } } while (0)
#define HB_NORM(V, mrow_) do { float s[4]; _Pragma("unroll") for (int q = 0; q < 4; ++q) { s[q] = 0.f; \
                _Pragma("unroll") for (int j = 0; j < 4; ++j) s[q] += (V[q][j].x * V[q][j].x + V[q][j].y * V[q][j].y) + (V[q][j].z * V[q][j].z + V[q][j].w * V[q][j].w); } \
            _Pragma("unroll") for (int o = 1; o < 64; o <<= 1) { _Pragma("unroll") for (int q = 0; q < 4; ++q) s[q] += __shfl_xor(s[q], o); } \
            _Pragma("unroll") for (int q = 0; q < 4; ++q) { const float ms_ = s[q] * (1.f / D) + EPS, rstd = 1.f / sqrtf(ms_); if (lane == 0) RMSX[HB_ROW(mrow_, q)] = ms_ * rstd;     \
                _Pragma("unroll") for (int j = 0; j < 4; ++j) V[q][j] = V[q][j] * rstd * gv[j]; } } while (0)
#define HB_STORE(V, mrow_) do { _Pragma("unroll") for (int q = 0; q < 4; ++q) { const int r_ = HB_ROW(mrow_, q), rp_ = (r_ & ~(SEQ - 1)) | ((r_ & 127) << 7) | ((r_ >> 7) & 127);     \
                GAS unsigned long long* o8 = (GAS unsigned long long*)(HB + (size_t)rp_ * D) + lane; \
                _Pragma("unroll") for (int j = 0; j < 4; ++j) { const unsigned long long w_ = (unsigned long long)pk2(V[q][j].x, V[q][j].y) | ((unsigned long long)pk2(V[q][j].z, V[q][j].w) << 32); if (P0_NTS & 1) __builtin_nontemporal_store(w_, o8 + 64 * j); else o8[64 * j] = w_; } } } while (0)
            if (gw < T) {
                f32x4 va[4][4], vb[4][4];
                HB_LOAD(va, gw);
                for (int mrow = gw; mrow < T; mrow += 8 * NGW) {
                    const bool h1 = mrow + 4 * NGW < T, h2 = mrow + 8 * NGW < T;
                    HB_NORM(va, mrow);
                    if (h1) HB_LOAD(vb, mrow + 4 * NGW);
                    HB_STORE(va, mrow);
                    if (h1) { HB_NORM(vb, mrow + 4 * NGW); if (h2) HB_LOAD(va, mrow + 8 * NGW); HB_STORE(vb, mrow + 4 * NGW); }
                }
            }
#undef HB_ROW
#undef HB_LOAD
#undef HB_NORM
#undef HB_STORE
        }
        SUBSTAMP(1);
        {
            constexpr size_t NCH = (size_t)T * PLE / 8; const size_t CST = (size_t)NGW * 64;
#define PB_CH(c0_, q) (((c0_) + (size_t)(q) * CST) < NCH ? ((c0_) + (size_t)(q) * CST) : (c0_))
#define PB_LOAD(A_, B_, c0_) do { _Pragma("unroll") for (int q = 0; q < PBQ; ++q) { const size_t e0 = PB_CH(c0_, q) * 8, row = e0 / PLE; \
                const float* src = row < (size_t)2 * SEQ ? pp + e0 : ps + (e0 - (size_t)2 * SEQ * PLE); \
                A_[q] = P0_NT ? __builtin_nontemporal_load((const f32x4*)src) : *(const f32x4*)src; B_[q] = P0_NT ? __builtin_nontemporal_load((const f32x4*)(src + 4)) : *(const f32x4*)(src + 4); } } while (0)
#define PB_STORE(A_, B_, c0_) do { _Pragma("unroll") for (int q = 0; q < PBQ; ++q) { const size_t e0 = PB_CH(c0_, q) * 8; \
                v4u o; o.x = pk2(A_[q].x, A_[q].y); o.y = pk2(A_[q].z, A_[q].w); o.z = pk2(B_[q].x, B_[q].y); o.w = pk2(B_[q].z, B_[q].w); if (P0_NTS & 2) __builtin_nontemporal_store(o, (v4u*)(PB + e0)); else *(v4u*)(PB + e0) = o; } } while (0)
            const size_t cfirst = (size_t)gw * 64 + lane;
            if (cfirst < NCH) {
                f32x4 a0[PBQ], b0[PBQ], a1[PBQ], b1[PBQ];
                PB_LOAD(a0, b0, cfirst);
                for (size_t c0 = cfirst; c0 < NCH; c0 += 2 * PBQ * CST) {
                    const bool h1 = c0 + PBQ * CST < NCH, h2 = c0 + 2 * PBQ * CST < NCH;
                    if (h1) PB_LOAD(a1, b1, c0 + PBQ * CST);
                    PB_STORE(a0, b0, c0);
                    if (h1) { if (h2) PB_LOAD(a0, b0, c0 + 2 * PBQ * CST); PB_STORE(a1, b1, c0 + PBQ * CST); }
                }
            }
#undef PB_CH
#undef PB_LOAD
#undef PB_STORE
        }
        SUBSTAMP(2);
        {
            constexpr int I_QKV = 16 * 24, I_OUT = 16 * 32, I_UP = 16 * 176, I_DOWN = LATE_W ? 0 : 44 * 32, I_PLE = 4 * 32, I_GATE = LATE_W ? 0 : 16 * 32;
            constexpr int NIT = I_QKV + I_OUT + I_UP + I_DOWN + I_PLE + I_GATE;
            auto decode = [&](int it) -> TrItem {
                int r = it;
                if (r < I_QKV) { const int kb = r / 24, nb = r % 24, n0 = 32 * nb, tile = n0 >> 8, p = n0 & 255, bj = p >> 7, wcc = (p >> 5) & 3;
                    return TrItem{w_in, nullptr, WQKV, INW, tile * 256 + wcc * 64 + bj * 32, 64 * kb, D, n0, (4 * tile + wcc < 10 && bj == 0) ? 1 : 0}; } r -= I_QKV;
                if (r < I_OUT) { const int kb = r / 32, nb = r % 32; return TrItem{w_out, kb < 8 ? ao_norm : fo_norm - 512, WOUT, D, 32 * nb, 64 * kb, D, 32 * nb}; } r -= I_OUT;
                if (r < I_UP) { const int kb = r / 176, nb = r % 176, n0 = 32 * nb, tile = n0 >> 8, p = n0 & 255, bj = p >> 7;
                    return TrItem{w_up, ffn_norm, WUP, 2 * DFF, bj * DFF + tile * 128 + (p & 127), 64 * kb, D, n0}; } r -= I_UP;
                if (r < I_DOWN) { const int kb = r / 32, nb = r % 32; return TrItem{w_down, nullptr, WDOWN, D, 32 * nb, 64 * kb, DFF, 32 * nb}; } r -= I_DOWN;
                if (r < I_PLE) { const int kb = r / 32, nb = r % 32; return TrItem{w_ple, nullptr, WPLE, D, 32 * nb, 64 * kb, PLE, 32 * nb}; } r -= I_PLE;
                { const int kb = r / 32, nb = r % 32; return TrItem{w_gate, nullptr, WGATE, D, 32 * nb, 64 * kb, D, 32 * nb}; }
            };
            for (int it = gw; it < NIT; it += 3 * NGW) {
                f32x4 va[8], vb[8], vc[8]; float ga[8], gb[8], gc[8];
                const bool h1 = it + NGW < NIT, h2 = it + 2 * NGW < NIT;
                const TrItem ta = decode(it), tb = decode(h1 ? it + NGW : it), tc = decode(h2 ? it + 2 * NGW : it);
                p0_tr_load(va, ga, ta, w_down, lane); p0_tr_load(vb, gb, tb, w_down, lane); p0_tr_load(vc, gc, tc, w_down, lane);
                p0_tr_finish(va, ga, ta, scr, lane);
                if (h1) p0_tr_finish(vb, gb, tb, scr, lane);
                if (h2) p0_tr_finish(vc, gc, tc, scr, lane);
            }
        }
        };
        auto p0_tables = [&]() __attribute__((always_inline)) {
        SUBSTAMP(3);
        for (int idx = vcu * 512 + tid; idx < SEQ * 8; idx += G * 512) {
            const int pos = idx >> 3;
            const float ang = (float)pos * c_invf[idx & 7];
            const double a = (double)ang, rr = a - 6.283185307179586476925 * rint(a * 0.15915494309189533577);
            float sn, cs; sincospif((float)(rr * 0.31830988618379067154), &sn, &cs);
            ropeC[idx] = cs; ropeS[idx] = sn;
        }
        { const float* conv_w = INPTR(15); const float* conv_b = INPTR(16); float* cws = (float*)(ws + WS_CWS);
          for (int idx = vcu * 512 + tid; idx < 4 * 2 * DFF; idx += G * 512) { const int a = idx / (2 * DFF), c = idx - a * (2 * DFF);
              cws[idx] = (a < 3 ? conv_w[idx] : conv_b[c]) * (c < DFF ? -LOG2E : -1.0f / LOG2E); } }
        for (int idx = vcu * 512 + tid; idx < 256 * 256; idx += G * 512) {
            const int r = idx >> 8, k = idx & 255, kr = r & 127, im = r >> 7, part = k >> 7, nn = k & 127;
            float sn, cs; sincospif(2.0f * (float)((kr * nn) & 127) / 128.0f, &sn, &cs);
            const float v1 = im == 0 ? (part == 0 ? cs : -sn) : (part == 0 ? -sn : -cs);
            ((signed char*)DFT1)[idx] = (signed char)(int)__builtin_rintf(127.0f * v1);
        }
        {
            signed char* d2k = (signed char*)(ws + WS_DFT2K);
            for (int idx = vcu * 512 + tid; idx < 128 * 128 * 32; idx += G * 512) {
                const int k1 = idx >> 12, k2 = (idx >> 5) & 127, n4 = (idx & 31) * 4;
                unsigned wc_ = 0u, ws_ = 0u;
#pragma unroll
                for (int i = 0; i < 4; ++i) { const float rev = (float)(((n4 + i) * (k1 + 128 * k2)) & 16383) * (1.0f / 16384.0f); const float sn = __builtin_amdgcn_sinf(rev), cs = __builtin_amdgcn_cosf(rev);
                    wc_ |= ((unsigned)(int)__builtin_rintf(127.0f * cs) & 0xffu) << (8 * i); ws_ |= ((unsigned)(int)__builtin_rintf(127.0f * sn) & 0xffu) << (8 * i); }
                signed char* row = d2k + ((size_t)k1 * 256 + k2) * 256;
                *(unsigned*)(row + n4) = wc_; *(unsigned*)(row + 128 + n4) = ws_;
            }
            for (int idx = vcu * 512 + tid; idx < 128 * 128 * 16; idx += G * 512) {
                const int k1 = idx >> 11, rem = idx & 2047;
                *(v4u*)(d2k + ((size_t)k1 * 256 + 128) * 256 + rem * 16) = (v4u){0u, 0u, 0u, 0u};
            }
        }
        SUBSTAMP(4);
        __syncthreads();
        {
            LAS float* Ml = (LAS float*)ring; LAS float* Wl = Ml + 64 * 65; LAS float* Fl = Wl + 64 * 65; LAS float* tg = Fl + 64 * 65;
            for (int item = vcu; item < 256; item += G) {
                const int part = item >> 7, g = (item >> 4) & 7, k0 = 64 * (item & 15);
                if (tid < 64) { float sn, cs; sincospif(2.0f * (float)tid / 64.0f, &sn, &cs); tg[tid] = part == 0 ? cs : sn; }
#pragma unroll
                for (int i = 0; i < 8; ++i) { const int idx = tid + 512 * i, r = idx >> 6, c = idx & 63;
                    Wl[r * 65 + c] = w_in[(size_t)(k0 + r) * INW + 768 + 64 * g + c];
                    Fl[r * 65 + c] = w_fourier[(size_t)g * 4096 + idx]; }
                __syncthreads();
                { const int e = tid & 63;
#pragma unroll 1
                  for (int i = 0; i < 8; ++i) { const int c = (tid >> 6) + 8 * i; float a = 0.f;
#pragma unroll 8
                      for (int j = 0; j < 64; ++j) a += tg[(c * j) & 63] * Fl[j * 65 + e];
                      Ml[c * 65 + e] = a; } }
                __syncthreads();
                { const int e = tid >> 3, kc = (tid & 7) * 8; float a[8];
#pragma unroll
                  for (int kk = 0; kk < 8; ++kk) a[kk] = 0.f;
#pragma unroll 2
                  for (int c = 0; c < 64; ++c) { const float mv = Ml[c * 65 + e];
#pragma unroll
                      for (int kk = 0; kk < 8; ++kk) a[kk] += Wl[(kc + kk) * 65 + c] * mv; }
                  v4u o; o.x = pk2(a[0], a[1]); o.y = pk2(a[2], a[3]); o.z = pk2(a[4], a[5]); o.w = pk2(a[6], a[7]);
                  { const int ch = 64 * g + e; *(v4u*)(WAB + (size_t)((ch >> 7) * 256 + part * 128 + (ch & 127)) * D + k0 + kc) = o; } }
                __syncthreads();
            }
        }
        __syncthreads(); };
        if (tables_first) { p0_tables(); p0_stream(); } else { p0_stream(); p0_tables(); } }
        SUBSTAMP(5);
        if (BOTH(0)) GRID_BAR();
        SUBSTAMP(6);
    }
    STAMP(1);

    if (IN(1)) { _Pragma("unroll") for (int rep = 0; rep < REPS(1); ++rep) {
        const bool ple_first = PLE_FIRST && ((bx & 1) != 0);
#define P1C_BODY() do { pg8::SchedPlain S; S.o.init(T / 256, 4, G, bx); if (P1C_HEAVY && G == 256) S.o.heavy = P1C_HEAVY; S.A = (const char*)PB; S.B = (const char*)WPLE; S.tA = (size_t)256 * PLE * 2; S.tB = (size_t)256 * PLE * 2; \
            const pg8::Geom g{PLE, PLE * 2, PLE * 2, 128 * PLE * 2, 128 * PLE * 2}; const pg8::EpiPle E{ERQ, ssq_e, SCL}; \
            pg8::gemm_phase<pg8::EpiPle, pg8::SchedPlain, true>(ring, epi, g, S, E); } while (0)
        if (ple_first) P1C_BODY();
        {
            pg8::SchedPlain S; S.o.init(T / 256, 3, G, bx); S.A = (const char*)HB; S.B = (const char*)WQKV; S.tA = (size_t)256 * D * 2; S.tB = (size_t)256 * D * 2;
            const pg8::Geom g{D, D * 2, D * 2, 128 * D * 2, 128 * D * 2};
            const pg8::EpiQKV E{MIX, KB, VB, INPTR(6), INPTR(7), ropeC, ropeS};
            stagger(bx, STG_P1A); pg8::gemm_phase<pg8::EpiQKV, pg8::SchedPlain, true>(ring, epi, g, S, E);
        }
        {
            pg8::SchedPlain S; S.o.init(4, T / 256, G, bx); S.A = (const char*)WAB; S.B = (const char*)HB; S.tA = (size_t)256 * D * 2; S.tB = (size_t)256 * D * 2;
            const pg8::Geom g{D, D * 2, D * 2, 128 * D * 2, 128 * D * 2};
            const pg8::EpiAB E{W1Q, SW};
            pg8::gemm_phase<pg8::EpiAB, pg8::SchedPlain, true>(ring, epi, g, S, E);
        }
        if (!ple_first) P1C_BODY();
        if (G != 256 || bx >= 64) {
            float* cws = (float*)(ws + WS_CWS);
            const int w0row_ = (G == 256 ? bx - 64 : bx) * NWAVES + wave, wstep_ = (G == 256 ? 192 : G) * NWAVES;
            int lane = (int)threadIdx.x & 63; asm volatile("" : "+v"(lane));
            v4u n0 = (v4u){0u, 0u, 0u, 0u}, n1 = n0;
            if (w0row_ < 2 * DFF) { const bf16* s0 = WUP + (size_t)(w0row_) * D; n0 = *(const v4u*)(s0 + lane * 16); n1 = *(const v4u*)(s0 + lane * 16 + 8); }
            for (int n = w0row_; n < 2 * DFF; n += wstep_) {
                const v4u w0 = n0, w1 = n1;
                { const int nn = n + wstep_ < 2 * DFF ? n + wstep_ : n; const bf16* s1 = WUP + (size_t)nn * D; n0 = *(const v4u*)(s1 + lane * 16); n1 = *(const v4u*)(s1 + lane * 16 + 8); }
                float v[16];
#define WQ_UNP(w_, o_) do { v[o_] = __builtin_bit_cast(float, (w_).x << 16); v[o_ + 1] = __builtin_bit_cast(float, (w_).x & 0xffff0000u); v[o_ + 2] = __builtin_bit_cast(float, (w_).y << 16); v[o_ + 3] = __builtin_bit_cast(float, (w_).y & 0xffff0000u); \
                v[o_ + 4] = __builtin_bit_cast(float, (w_).z << 16); v[o_ + 5] = __builtin_bit_cast(float, (w_).z & 0xffff0000u); v[o_ + 6] = __builtin_bit_cast(float, (w_).w << 16); v[o_ + 7] = __builtin_bit_cast(float, (w_).w & 0xffff0000u); } while (0)
                WQ_UNP(w0, 0); WQ_UNP(w1, 8);
#undef WQ_UNP
                float mx = 0.f;
#pragma unroll
                for (int i = 0; i < 16; ++i) mx = fmaxf(mx, fabsf(v[i]));
#pragma unroll
                for (int o = 1; o < 64; o <<= 1) mx = fmaxf(mx, __shfl_xor(mx, o));
                mx = fmaxf(mx, 1e-30f);
                const float inv = 127.0f * __builtin_amdgcn_rcpf(mx);
                v4u q;
#define WQ_PK(o_) ((__builtin_amdgcn_cvt_pk_u8_f32(__builtin_rintf(__builtin_fmaf(v[o_ + 3], inv, 128.0f)), 3, __builtin_amdgcn_cvt_pk_u8_f32(__builtin_rintf(__builtin_fmaf(v[o_ + 2], inv, 128.0f)), 2, \
                    __builtin_amdgcn_cvt_pk_u8_f32(__builtin_rintf(__builtin_fmaf(v[o_ + 1], inv, 128.0f)), 1, __builtin_amdgcn_cvt_pk_u8_f32(__builtin_rintf(__builtin_fmaf(v[o_], inv, 128.0f)), 0, 0u))))) ^ 0x80808080u)
                q.x = WQ_PK(0); q.y = WQ_PK(4); q.z = WQ_PK(8); q.w = WQ_PK(12);
#undef WQ_PK
                *(v4u*)(WUPQ + (size_t)n * D + lane * 16) = q;
                if (lane < 3) { const int tile = n >> 8, p = n & 255, ch = (p >> 7) * DFF + tile * 128 + (p & 127); cws[lane * 2 * DFF + ch] *= mx * (1.0f / 127.0f); }
            }
        }
#undef P1C_BODY
        }
        if (BOTH(1)) GRID_BAR();
    }
    STAMP(2);

    if (IN(2)) {
        const bool s1_first = S1_FIRST && ((bx & 1) != 0);
#define S1_BODY() do { pg8::SchedPlain S; S.o.init(1, NSEQ * 512 * 128 / 256, G, bx); S.A = (const char*)DFT1; S.B = (const char*)W1Q; S.tA = 0; S.tB = (size_t)256 * 256; \
            const pg8::Geom g{128, 256, 256, 128 * 256, 128 * 256}; const pg8::EpiS1 E{ZBQ, SZ, SW}; \
            pg8::gemm_phase<pg8::EpiS1, pg8::SchedPlain, true>(ring, epi, g, S, E); } while (0)
        if (s1_first) S1_BODY();
        { const int per = (attn::NUNITS + G - 1) / G, a0 = vcu * per, a1 = a0 + per < attn::NUNITS ? a0 + per : attn::NUNITS;
          attn::phase(a0, a1, MIX, KB, VB, INPTR(8), INPTR(6), INPTR(7), ssq_a, ring, ts1); }
        LDS_WAIT(); __syncthreads();
        STAMP(3);
        if (!s1_first) S1_BODY();
#undef S1_BODY
        if (BOTH(2)) GRID_BAR();
    }
    STAMP(4);

    if (IN(3)) { _Pragma("unroll") for (int rep = 0; rep < REPS(3); ++rep) {
        pg8::SchedS2 S; S.o.init(1, NSEQ * 128 * 512 / 256, G, bx); S.A = (const char*)(ws + WS_DFT2K); S.B = (const char*)ZBQ; S.tB = (size_t)256 * 256;
        const pg8::Geom g{128, 256, 256, 128 * 256, 128 * 256};
        const pg8::EpiS2 E{MIX, ssq_f, SZ};
        stagger(bx, STG_S2); pg8::gemm_phase<pg8::EpiS2, pg8::SchedS2, true>(ring, epi, g, S, E); }
        if (BOTH(3)) GRID_BAR();
    }
    STAMP(5);
#ifdef PROBE_XBAR
    for (int xb = 0; xb < PROBE_XBAR; ++xb) GRID_BAR();
#endif

    if (IN(4)) {
        for (int i = vcu * 512 + tid; i < NSEQ * 256 * (D / 8); i += G * 512) {
            const int sq = i / (256 * (D / 8)), rem = i % (256 * (D / 8)), rr = rem / (D / 8), c8 = rem % (D / 8);
            const int prow = rr == 0 ? 0 : SEQ + rr;
            *(v4u*)(X1B + ((size_t)sq * XPAD + prow) * D + c8 * 8) = (v4u){0u, 0u, 0u, 0u};
        }
        _Pragma("unroll") for (int rep = 0; rep < REPS(4); ++rep) {
        pg8::SchedPlain S; S.o.init(T / 256, 4, G, bx); S.A = (const char*)MIX; S.B = (const char*)WOUT; S.tA = (size_t)256 * D * 2; S.tB = (size_t)256 * D * 2;
        const pg8::Geom g{D, D * 2, D * 2, 128 * D * 2, 128 * D * 2};
        {
            LAS float* tab = (LAS float*)epi; pg8::Unit uu;
            for (int i = 0; i < 3 && S.next(i, uu); ++i)
                if (tid < 256) { const size_t row = (size_t)uu.pm * 256 + tid;
                    const f32x4 a0 = *(const f32x4*)(ssq_a + row * 8), a1 = *(const f32x4*)(ssq_a + row * 8 + 4), f0 = *(const f32x4*)(ssq_f + row * 8), f1 = *(const f32x4*)(ssq_f + row * 8 + 4);
                    const float ra = 1.0f / sqrtf(((a0[0] + a0[1]) + (a0[2] + a0[3]) + (a1[0] + a1[1]) + (a1[2] + a1[3])) * (1.0f / 512.0f) + EPS);
                    const float rf = 1.0f / sqrtf(((f0[0] + f0[1]) + (f0[2] + f0[3]) + (f1[0] + f1[1]) + (f1[2] + f1[3])) * (1.0f / 512.0f) + EPS);
                    tab[(i * 256 + tid) * 2] = ra / rf; tab[(i * 256 + tid) * 2 + 1] = rf; ((LAS float*)(epi + 12288))[i * 256 + tid] = RMSX[row]; }
            LDS_WAIT(); __syncthreads();
        }
        const pg8::EpiOut E{HB, INPTR(4), X1B, ssq_x1, (const LAS float*)epi, (LAS float*)(epi + 8192), (const LAS float*)(epi + 12288)};
        stagger(bx, STG_P4); pg8::gemm_phase<pg8::EpiOut, pg8::SchedPlain, true>(ring, epi, g, S, E); }
        if (BOTH(4)) GRID_BAR();
    }
    STAMP(6);
#ifdef PROBE_CLK
    clk0 = clock64(); rt0 = __builtin_amdgcn_s_memrealtime();
#endif

    if (IN(5)) { _Pragma("unroll") for (int rep = 0; rep < REPS(5); ++rep) {
        STAMP(60);
        {
            const int gw = vcu * NWAVES + wave, NGW = G * NWAVES; int tq = (int)threadIdx.x; asm volatile("" : "+v"(tq)); const int lane = tq & 63;
            for (int i = vcu * 512 + tq; i < NSEQ * 256 * (D / 16); i += G * 512) {
                const int sq = i / (256 * (D / 16)), rem = i % (256 * (D / 16)), rr = rem / (D / 16), c16 = rem % (D / 16);
                const int prow = rr == 0 ? 0 : SEQ + rr;
                *(v4u*)(X1Q + ((size_t)sq * XPAD + prow) * D + c16 * 16) = (v4u){0u, 0u, 0u, 0u};
            }
#define X1_PROW(t_) ((size_t)((t_) >> 14) * XPAD + 1 + ((t_) & (SEQ - 1)))
#ifndef X1_ROWS
#define X1_ROWS 4
#endif
            if (gw < T) {
                v4u n0[X1_ROWS], n1[X1_ROWS]; f32x4 np[X1_ROWS];
#ifndef X1_NT
#define X1_NT 0
#endif
#ifndef X1_ORDER
#define X1_ORDER 0
#endif
                auto x1_row = [&](int lin) -> int { if (!(X1_ORDER && G == 256 && T == 24 * NGW)) return lin;
                    const int k = lin / NGW, gv = lin % NGW, cu = gv / NWAVES, wv = gv % NWAVES; return ((24 * (cu & 7) + 23 - k) << 8) + (cu >> 3) * NWAVES + wv; };
#define X1_LD(j_, t_) do { const int tn_ = x1_row((t_) < T ? (t_) : gw); const bf16* s_ = X1B + X1_PROW(tn_) * D; n0[j_] = X1_NT ? __builtin_nontemporal_load((const v4u*)(s_ + lane * 16)) : *(const v4u*)(s_ + lane * 16); n1[j_] = X1_NT ? __builtin_nontemporal_load((const v4u*)(s_ + lane * 16 + 8)) : *(const v4u*)(s_ + lane * 16 + 8); np[j_] = *(const f32x4*)(ssq_x1 + (size_t)tn_ * 4); } while (0)
                _Pragma("unroll") for (int j = 0; j < X1_ROWS; ++j) X1_LD(j, gw + j * NGW);
                for (int t = gw; t < T; t += X1_ROWS * NGW) {
                    v4u w0[X1_ROWS], w1[X1_ROWS]; f32x4 pp_[X1_ROWS];
                    _Pragma("unroll") for (int j = 0; j < X1_ROWS; ++j) { w0[j] = n0[j]; w1[j] = n1[j]; pp_[j] = np[j]; }
                    _Pragma("unroll") for (int j = 0; j < X1_ROWS; ++j) X1_LD(j, t + (X1_ROWS + j) * NGW);
                    _Pragma("unroll") for (int j = 0; j < X1_ROWS; ++j) { const int tl = t + j * NGW; if (tl < T) { const int tj = x1_row(tl);
                        const size_t prow = X1_PROW(tj);
                        float v[16];
#define WQ_UNP(w_, o_) do { v[o_] = __builtin_bit_cast(float, (w_).x << 16); v[o_ + 1] = __builtin_bit_cast(float, (w_).x & 0xffff0000u); v[o_ + 2] = __builtin_bit_cast(float, (w_).y << 16); v[o_ + 3] = __builtin_bit_cast(float, (w_).y & 0xffff0000u); \
                        v[o_ + 4] = __builtin_bit_cast(float, (w_).z << 16); v[o_ + 5] = __builtin_bit_cast(float, (w_).z & 0xffff0000u); v[o_ + 6] = __builtin_bit_cast(float, (w_).w << 16); v[o_ + 7] = __builtin_bit_cast(float, (w_).w & 0xffff0000u); } while (0)
                        WQ_UNP(w0[j], 0); WQ_UNP(w1[j], 8);
#undef WQ_UNP
                        float mx = 0.f;
                        _Pragma("unroll") for (int i = 0; i < 16; ++i) mx = fmaxf(mx, fabsf(v[i]));
                        _Pragma("unroll") for (int o = 1; o < 64; o <<= 1) mx = fmaxf(mx, __shfl_xor(mx, o));
                        mx = fmaxf(mx, 1e-30f);
                        const float inv = 127.0f * __builtin_amdgcn_rcpf(mx);
                        v4u q;
#define WQ_PK(o_) ((__builtin_amdgcn_cvt_pk_u8_f32(__builtin_rintf(__builtin_fmaf(v[o_ + 3], inv, 128.0f)), 3, __builtin_amdgcn_cvt_pk_u8_f32(__builtin_rintf(__builtin_fmaf(v[o_ + 2], inv, 128.0f)), 2, \
                        __builtin_amdgcn_cvt_pk_u8_f32(__builtin_rintf(__builtin_fmaf(v[o_ + 1], inv, 128.0f)), 1, __builtin_amdgcn_cvt_pk_u8_f32(__builtin_rintf(__builtin_fmaf(v[o_], inv, 128.0f)), 0, 0u))))) ^ 0x80808080u)
                        q.x = WQ_PK(0); q.y = WQ_PK(4); q.z = WQ_PK(8); q.w = WQ_PK(12);
#undef WQ_PK
                        *(v4u*)(X1Q + prow * D + lane * 16) = q;
                        const f32x4 p = pp_[j];
                        if (lane == 0) *(f32x4*)(ssq_x1 + (size_t)tj * 4) = (f32x4){(p[0] + p[1]) + (p[2] + p[3]), 0.f, 0.f, mx * (1.0f / 127.0f)};
                    } }
                }
#undef X1_LD
            }
#undef X1_PROW
            STAMP(61);
            GRID_BAR();
            STAMP(62);
        }
        pg8::SchedHalo S; S.o.init(NSEQ * UP_TILES, 2 * DFF / 256, G, bx); S.X1B = (const char*)X1Q; S.B = (const char*)WUPQ; S.tB = (size_t)256 * D; S.rb = D;
        const pg8::Geom g{D / 2, D, D, 4 * D, 128 * D};
        const pg8::EpiUp E{(const float*)(ws + WS_CWS), (const float*)(ws + WS_CWS) + 3 * 2 * DFF, ssq_x1, ACT};
#ifdef PROBE_P5_LITE
        if (rep + 1 < REPS(5)) { const pg8::EpiLite EL{ACT}; pg8::gemm_phase<pg8::EpiLite, pg8::SchedHalo, true>(ring, epi, g, S, EL); GRID_BAR(); } else
#endif
        { stagger(bx, STG_P5); pg8::gemm_phase<pg8::EpiUp, pg8::SchedHalo, true>(ring, epi, g, S, E); } }
        if (LATE_W && bx >= 194) {
            const float* w_down = INPTR(17); const float* w_gate = INPTR(20);
            LAS float* scr = (LAS float*)(ring + wave * 16384);
            int ln = (int)threadIdx.x & 63; asm volatile("" : "+v"(ln));
            for (int it = (bx - 194) * NWAVES + wave; it < 44 * 32 + 16 * 32; it += (256 - 194) * NWAVES) {
                const int r = it < 44 * 32 ? it : it - 44 * 32, kb = r / 32, nb = r % 32;
                const TrItem t = it < 44 * 32 ? TrItem{w_down, nullptr, WDOWN, D, 32 * nb, 64 * kb, DFF, 32 * nb, 0} : TrItem{w_gate, nullptr, WGATE, D, 32 * nb, 64 * kb, D, 32 * nb, 0};
                f32x4 va[8]; float ga[8];
                p0_tr_load(va, ga, t, w_down, ln); p0_tr_finish(va, ga, t, scr, ln);
            }
        }
        if (BOTH(5)) GRID_BAR();
    }
    STAMP(7);
#ifdef PROBE_CLK
    clk1 = clock64(); rt1 = __builtin_amdgcn_s_memrealtime();
#endif

    if (IN(6)) { {
        pg8::SchedPlain S; S.o.init(T / 256, 4, G, bx); S.A = (const char*)ACT; S.B = (const char*)WDOWN; S.tA = (size_t)256 * DFF * 2; S.tB = (size_t)256 * DFF * 2;
        const pg8::Geom g{DFF, DFF * 2, DFF * 2, 128 * DFF * 2, 128 * DFF * 2};
        const pg8::EpiDown E{X1B};
        stagger(bx, STG_P6); pg8::gemm_phase<pg8::EpiDown, pg8::SchedPlain, true>(ring, epi, g, S, E); }
        if (BOTH(6)) GRID_BAR();
    }
    STAMP(8);

    if (IN(7)) { _Pragma("unroll") for (int rep = 0; rep < REPS(7); ++rep) {
        pg8::SchedPad S; S.o.init(T / 256, 4, G, bx); S.XB = (const char*)X2B; S.B = (const char*)WGATE; S.tB = (size_t)256 * D * 2;
        const pg8::Geom g{D, D * 2, D * 2, 128 * D * 2, 128 * D * 2};
        {
            LAS float* tab = (LAS float*)epi; pg8::Unit uu;
            for (int i = 0; i < 3 && S.next(i, uu); ++i)
                if (tid < 256) { const float* p = ssq_e + ((size_t)uu.pm * 256 + tid) * 16;
                    const f32x4 a = *(const f32x4*)p, b = *(const f32x4*)(p + 4), c = *(const f32x4*)(p + 8), d = *(const f32x4*)(p + 12);
                    tab[3072 + i * 512 + tid] = INPTR(21)[uu.pn * 256 + tid]; tab[3072 + i * 512 + 256 + tid] = INPTR(19)[uu.pn * 256 + tid];
                    const float re = 1.0f / sqrtf((((a[0] + a[1]) + (a[2] + a[3])) + ((b[0] + b[1]) + (b[2] + b[3])) + ((c[0] + c[1]) + (c[2] + c[3])) + ((d[0] + d[1]) + (d[2] + d[3]))) * (1.0f / 1024.0f) + EPS);
                    const f32x4 sc = *(const f32x4*)(SCL + ((size_t)uu.pm * 256 + tid) * 16 + uu.pn * 4);
                    *(LAS f32x4*)(tab + (i * 256 + tid) * 4) = sc * re; }
            LDS_WAIT(); __syncthreads();
        }
#ifndef EG_MODE
#define EG_MODE 0
#endif
        if (rep + 1 < REPS(7)) { const pg8::EpiGateT<EG_MODE> E{out, X2B, ERQ, INPTR(19), INPTR(21), (const LAS float*)epi}; pg8::gemm_phase<pg8::EpiGateT<EG_MODE>, pg8::SchedPad, true>(ring, epi, g, S, E); }
        else { const pg8::EpiGate E{out, X2B, ERQ, INPTR(19), INPTR(21), (const LAS float*)epi}; stagger(bx, STG_P7); pg8::gemm_phase<pg8::EpiGate, pg8::SchedPad, true>(ring, epi, g, S, E); } }
    }
    STAMP(9);
#ifdef PROBE_CLK
    { const unsigned long long mhz = (clk1 - clk0) * 100ull / (rt1 - rt0), te = __builtin_amdgcn_s_memrealtime(); while (__builtin_amdgcn_s_memrealtime() - te < mhz * 100ull) __builtin_amdgcn_s_sleep(16); }
#endif
    if (PROBE_SEG >= 0 || PROBE_SUB >= 0 || PROBE_ATT > 0) { const unsigned long long te = __builtin_amdgcn_s_memrealtime(), dt = (ts1 - ts0) * PROBE_AMP; while (__builtin_amdgcn_s_memrealtime() - te < dt) __builtin_amdgcn_s_sleep(16); }
#undef IN
#undef BOTH
#undef GRID_BAR
}

extern "C" void kernel_launch(void* const* d_in, const int* in_sizes, int n_in, void* d_out, int out_size, void* d_ws, size_t ws_size, hipStream_t stream) {
    static int grid = 0;
    if (grid == 0) {
        if (n_in != 22 || in_sizes[0] != 2 * SEQ * D || out_size != T * D || ws_size < WS_END) { fprintf(stderr, "kernel_launch: unexpected shapes (n_in %d, in0 %d, out %d, ws %zu); nothing launched\n", n_in, n_in > 0 ? in_sizes[0] : -1, out_size, ws_size); grid = -1; return; }
        int dev = 0, cus = 0, per_cu = 0;
        if (hipGetDevice(&dev) != hipSuccess || hipDeviceGetAttribute(&cus, hipDeviceAttributeMultiprocessorCount, dev) != hipSuccess) { fprintf(stderr, "kernel_launch: device query failed\n"); grid = -1; return; }
        if (hipFuncSetAttribute((const void*)mk_fwd, hipFuncAttributeMaxDynamicSharedMemorySize, LDS_BYTES) != hipSuccess) { fprintf(stderr, "kernel_launch: hipFuncSetAttribute failed\n"); grid = -1; return; }
        if (hipOccupancyMaxActiveBlocksPerMultiprocessor(&per_cu, (const void*)mk_fwd, NWAVES * 64, LDS_BYTES) != hipSuccess || per_cu < 1)
            fprintf(stderr, "kernel_launch: note: occupancy query reports %d workgroups per CU\n", per_cu);
        (void)hipGetLastError();
        if (cus < 256) { fprintf(stderr, "kernel_launch: built for a 256-CU device (found %d CUs); nothing launched\n", cus); grid = -1; return; }
        grid = 256;
    }
    if (grid < 0) return;
    if (hipMemsetAsync((char*)d_ws + WS_CTL, 0, CTL_ZERO_BYTES, stream) != hipSuccess) { fprintf(stderr, "kernel_launch: memset failed\n"); return; }
#ifdef PROBE_MS2
    for (int r = 0; r < PROBE_MS2; ++r) (void)hipMemsetAsync((char*)d_ws + WS_CTL, 0, CTL_ZERO_BYTES, stream);
#endif
    Args a{};
    for (int i = 0; i < 22; ++i) a.in[i] = (const float*)d_in[i];
    a.out = (float*)d_out; a.ws = (unsigned char*)d_ws;
    for (int li = 0; li < N_LAUNCHES; ++li) {
        if (N_LAUNCHES == 1) { a.ph_lo = 0; a.ph_hi = N_PHASES; } else { a.ph_lo = li; a.ph_hi = li + 1; }
        a.li = 0;
        hipLaunchKernelGGL(mk_fwd, dim3(grid), dim3(NWAVES * 64), LDS_BYTES, stream, a);
        const hipError_t le = hipPeekAtLastError();
        if (le != hipSuccess) { fprintf(stderr, "kernel_launch: launch %d failed: %s\n", li, hipGetErrorName(le)); break; }
    }
}
```
